# Optimizing an MI355X kernel written in HIP

```python
import jax
import jax.numpy as jnp
from jax import lax
import numpy as np

D_MODEL = 2048
BATCH = 4
SEQ = 4096
DEPTH = 2

N_EVEN = (DEPTH + 1) // 2
N_ODD = DEPTH // 2
CHUNK = 128
CONV_W = 4
EPS = 1e-6
F32 = jnp.float32

RET_HEADS = 8
RET_DIM = 128
RET_WIDTH = RET_HEADS * RET_DIM
ROPE_BASE = 10000.0
SSD_HEAD_DIM = 64
SSD_HEADS = 16
SSD_WIDTH = SSD_HEADS * SSD_HEAD_DIM
SSD_GROUPS = 2
SSD_HPG = SSD_HEADS // SSD_GROUPS
SSD_STATE = 128
SSD_CONV_CH = SSD_WIDTH + 2 * SSD_GROUPS * SSD_STATE
IN0_SPLITS = [RET_WIDTH, 2 * RET_WIDTH, 3 * RET_WIDTH, 4 * RET_WIDTH, 4 * RET_WIDTH + SSD_WIDTH, 4 * RET_WIDTH + SSD_WIDTH + SSD_CONV_CH]
IN0_WIDTH = IN0_SPLITS[-1] + SSD_HEADS
MIX0_WIDTH = RET_WIDTH + SSD_WIDTH
MLSTM_HEADS = 4
MLSTM_DIM = 384
MLSTM_WIDTH = MLSTM_HEADS * MLSTM_DIM
S5_GROUP = 16
S5_GROUPS = 32
S5_WIDTH = S5_GROUP * S5_GROUPS
S5_STATE = 64
IN1_SPLITS = [MLSTM_WIDTH, 2 * MLSTM_WIDTH, 3 * MLSTM_WIDTH, 4 * MLSTM_WIDTH, 4 * MLSTM_WIDTH + MLSTM_HEADS, 4 * MLSTM_WIDTH + 2 * MLSTM_HEADS]
IN1_WIDTH = IN1_SPLITS[-1] + S5_WIDTH
MIX1_WIDTH = MLSTM_WIDTH + S5_WIDTH
MOE_GROUPS = 4
EXPERTS_PER_GROUP = 8
N_EXPERTS = MOE_GROUPS * EXPERTS_PER_GROUP
MOE_TOP_K = 2
EXPERT_FF = 512
MOE_BLOCK = 128

kernel_name = 'hybrid_ret_ssd_mlstm_s5_hmoe'


def rms_norm(x, g):
    xf = x.astype(F32)
    y = xf * lax.rsqrt(jnp.mean(xf * xf, axis=-1, keepdims=True) + EPS)
    return (y * g.astype(F32)).astype(x.dtype)


def head_layer_norm(t, g):
    tf = t.astype(F32)
    mu = jnp.mean(tf, axis=-1, keepdims=True)
    var = jnp.mean(jnp.square(tf - mu), axis=-1, keepdims=True)
    return (tf - mu) * lax.rsqrt(var + EPS) * g.astype(F32)


def causal_dwconv(x, w, b):
    y = lax.conv_general_dilated(x, w[:, None, :], window_strides=(1,), padding=[(CONV_W - 1, 0)], dimension_numbers=('NWC', 'WIO', 'NWC'), feature_group_count=x.shape[-1])
    return y + b


def to_chunks(t):
    b, l = t.shape[:2]
    return jnp.moveaxis(t.reshape((b, l // CHUNK, CHUNK) + t.shape[2:]), 1, 0)


def from_chunks(t):
    c, b = t.shape[:2]
    return jnp.moveaxis(t, 0, 1).reshape((b, c * CHUNK) + t.shape[3:])


def causal_mask():
    return jnp.tril(jnp.ones((CHUNK, CHUNK), dtype=bool))


def rotary(t):
    l, d = t.shape[1], t.shape[-1]
    inv = 1.0 / (ROPE_BASE ** (jnp.arange(0, d, 2, dtype=F32) / d))
    ang = jnp.arange(l, dtype=F32)[:, None] * inv[None, :]
    cos = jnp.cos(ang)[None, :, None, :]
    sin = jnp.sin(ang)[None, :, None, :]
    t1, t2 = jnp.split(t, 2, axis=-1)
    return jnp.concatenate([t1 * cos - t2 * sin, t1 * sin + t2 * cos], axis=-1)


def retention(q, k, v, g, norm_g):
    b = q.shape[0]
    q = rotary(q.astype(F32))
    k = rotary(k.astype(F32)) * RET_DIM ** -0.5
    v = v.astype(F32)
    log_gamma = jnp.log1p(-jnp.exp2(-5.0 - jnp.arange(RET_HEADS, dtype=F32)))
    pos = jnp.arange(CHUNK, dtype=F32)
    rel = pos[:, None] - pos[None, :]
    decay = jnp.where(rel >= 0, jnp.exp(log_gamma[:, None, None] * jnp.maximum(rel, 0.0)), 0.0)
    q_decay = jnp.exp(log_gamma[None, :] * (pos[:, None] + 1.0))
    k_decay = jnp.exp(log_gamma[None, :] * (CHUNK - 1.0 - pos[:, None]))
    chunk_decay = jnp.exp(log_gamma * CHUNK)

    def step(state, inp):
        qc, kc, vc = inp
        scores = jnp.einsum('blhd,bshd->bhls', qc, kc) * decay
        intra = jnp.einsum('bhls,bshe->blhe', scores, vc)
        inter = jnp.einsum('blhd,bhde->blhe', qc, state) * q_decay[None, :, :, None]
        new_state = chunk_decay[None, :, None, None] * state + jnp.einsum('bshd,sh,bshe->bhde', kc, k_decay, vc)
        return new_state, intra + inter

    state0 = jnp.zeros((b, RET_HEADS, RET_DIM, RET_DIM), F32)
    _, out = lax.scan(step, state0, (to_chunks(q), to_chunks(k), to_chunks(v)))
    return jax.nn.silu(g.astype(F32)) * head_layer_norm(from_chunks(out), norm_g)


def ssd(xbc, z, dt_raw, conv_w, conv_b, dt_bias, a_log, d_skip, norm_g):
    b, l, _ = z.shape
    xbc = jax.nn.silu(causal_dwconv(xbc, conv_w, conv_b)).astype(F32)
    gn = SSD_GROUPS * SSD_STATE
    xs = xbc[..., :SSD_WIDTH].reshape(b, l, SSD_GROUPS, SSD_HPG, SSD_HEAD_DIM)
    bm = xbc[..., SSD_WIDTH:SSD_WIDTH + gn].reshape(b, l, SSD_GROUPS, SSD_STATE)
    cm = xbc[..., SSD_WIDTH + gn:].reshape(b, l, SSD_GROUPS, SSD_STATE)
    dt = jax.nn.softplus(dt_raw.astype(F32) + dt_bias.astype(F32)).reshape(b, l, SSD_GROUPS, SSD_HPG)
    da = dt * (-jnp.exp(a_log.astype(F32))).reshape(SSD_GROUPS, SSD_HPG)
    xdt = xs * dt[..., None]
    mask = causal_mask()[None, :, :, None, None]

    def step(state, inp):
        xc, dac, bc, cc = inp
        a_cum = jnp.cumsum(dac, axis=1)
        seg = jnp.exp(jnp.where(mask, a_cum[:, :, None] - a_cum[:, None, :], -jnp.inf))
        cb = jnp.einsum('blgn,bsgn->blsg', cc, bc)
        intra = jnp.einsum('blsg,blsgr,bsgrp->blgrp', cb, seg, xc)
        inter = jnp.einsum('blgn,bgrpn->blgrp', cc, state) * jnp.exp(a_cum)[..., None]
        to_end = jnp.exp(a_cum[:, -1:] - a_cum)
        new_state = jnp.exp(a_cum[:, -1])[..., None, None] * state + jnp.einsum('bsgn,bsgr,bsgrp->bgrpn', bc, to_end, xc)
        return new_state, intra + inter

    state0 = jnp.zeros((b, SSD_GROUPS, SSD_HPG, SSD_HEAD_DIM, SSD_STATE), F32)
    _, y = lax.scan(step, state0, (to_chunks(xdt), to_chunks(da), to_chunks(bm), to_chunks(cm)))
    y = from_chunks(y) + d_skip.astype(F32).reshape(SSD_GROUPS, SSD_HPG)[..., None] * xs
    y = y.reshape(b, l, SSD_WIDTH) * jax.nn.silu(z.astype(F32))
    y = y.reshape(b, l, SSD_GROUPS, SSD_WIDTH // SSD_GROUPS)
    y = y * lax.rsqrt(jnp.mean(y * y, axis=-1, keepdims=True) + EPS)
    return y.reshape(b, l, SSD_WIDTH) * norm_g.astype(F32)


def mlstm(q, k, v, o, i_pre, f_pre, norm_g):
    b = q.shape[0]
    q = q.astype(F32) * MLSTM_DIM ** -0.5
    k = k.astype(F32)
    v = v.astype(F32)
    ig = i_pre.astype(F32)
    lf = jax.nn.log_sigmoid(f_pre.astype(F32))
    mask = causal_mask()[None, :, :, None]

    def step(carry, inp):
        c_st, n_st, m_st = carry
        qc, kc, vc, igc, lfc = inp
        bcum = jnp.cumsum(lfc, axis=1)
        log_d = jnp.where(mask, bcum[:, :, None, :] - bcum[:, None, :, :] + igc[:, None, :, :], -jnp.inf)
        m_inter = bcum + m_st[:, None, :]
        m_t = jnp.maximum(jnp.max(log_d, axis=2), m_inter)
        scores = jnp.einsum('blhd,bshd->blsh', qc, kc) * jnp.exp(log_d - m_t[:, :, None, :])
        inter_scale = jnp.exp(m_inter - m_t)
        num = jnp.einsum('blsh,bshe->blhe', scores, vc) + inter_scale[..., None] * jnp.einsum('blhd,bhde->blhe', qc, c_st)
        den = jnp.sum(scores, axis=2) + inter_scale * jnp.einsum('blhd,bhd->blh', qc, n_st)
        h = num / jnp.maximum(jnp.abs(den), jnp.exp(-m_t))[..., None]
        b_last = bcum[:, -1]
        w_log = b_last[:, None] - bcum + igc
        m_new = jnp.maximum(b_last + m_st, jnp.max(w_log, axis=1))
        w = jnp.exp(w_log - m_new[:, None])
        prev_scale = jnp.exp(b_last + m_st - m_new)
        c_new = prev_scale[..., None, None] * c_st + jnp.einsum('bsh,bshd,bshe->bhde', w, kc, vc)
        n_new = prev_scale[..., None] * n_st + jnp.einsum('bsh,bshd->bhd', w, kc)
        return (c_new, n_new, m_new), h

    carry0 = (jnp.zeros((b, MLSTM_HEADS, MLSTM_DIM, MLSTM_DIM), F32), jnp.zeros((b, MLSTM_HEADS, MLSTM_DIM), F32), jnp.full((b, MLSTM_HEADS), -jnp.inf, F32))
    _, h = lax.scan(step, carry0, (to_chunks(q), to_chunks(k), to_chunks(v), to_chunks(ig), to_chunks(lf)))
    return jax.nn.sigmoid(o.astype(F32)) * head_layer_norm(from_chunks(h), norm_g)


def complex_affine_combine(first, second):
    a1r, a1i, b1r, b1i = first
    a2r, a2i, b2r, b2i = second
    return (a2r * a1r - a2i * a1i, a2r * a1i + a2i * a1r, a2r * b1r - a2i * b1i + b2r, a2r * b1i + a2i * b1r + b2i)


def s5(u, a_re, a_im, log_dt, b_re, b_im, c_re, c_im, d_skip, w_glu, b_glu):
    bsz, l, _ = u.shape
    uf = u.astype(F32).reshape(bsz, l, S5_GROUPS, S5_GROUP)
    a_re = a_re.astype(F32)
    a_im = a_im.astype(F32)
    dt = jnp.exp(log_dt.astype(F32))[:, None]
    mag = jnp.exp(a_re * dt)
    abar_re = mag * jnp.cos(a_im * dt)
    abar_im = mag * jnp.sin(a_im * dt)
    den = a_re * a_re + a_im * a_im
    nr = abar_re - 1.0
    coef_re = (nr * a_re + abar_im * a_im) / den
    coef_im = (abar_im * a_re - nr * a_im) / den
    b_re = b_re.astype(F32)
    b_im = b_im.astype(F32)
    bbar_re = coef_re[..., None] * b_re - coef_im[..., None] * b_im
    bbar_im = coef_re[..., None] * b_im + coef_im[..., None] * b_re
    bu_re = jnp.einsum('gnc,blgc->blgn', bbar_re, uf)
    bu_im = jnp.einsum('gnc,blgc->blgn', bbar_im, uf)
    elems = (jnp.broadcast_to(abar_re, bu_re.shape), jnp.broadcast_to(abar_im, bu_im.shape), bu_re, bu_im)
    _, _, s_re, s_im = lax.associative_scan(complex_affine_combine, elems, axis=1)
    y = jnp.einsum('gcn,blgn->blgc', c_re.astype(F32), s_re) - jnp.einsum('gcn,blgn->blgc', c_im.astype(F32), s_im) + d_skip.astype(F32) * uf
    y = jax.nn.gelu(y.reshape(bsz, l, S5_WIDTH))
    val, gate = jnp.split(y @ w_glu.astype(F32) + b_glu.astype(F32), 2, axis=-1)
    return val * jax.nn.sigmoid(gate)


def expert_ffn(xb, wg, wu, wd):
    return (jax.nn.silu(xb @ wg) * (xb @ wu)) @ wd


def hier_moe(x, router_g, router_g_b, router_e, router_e_b, w_gate, w_up, w_down):
    b, l, d = x.shape
    xf = x.reshape(-1, d)
    t = xf.shape[0]
    g_prob = jax.nn.softmax((xf @ router_g + router_g_b).astype(F32), axis=-1)
    g_w, g_idx = lax.top_k(g_prob, 1)
    e_logits = (xf @ router_e + router_e_b).astype(F32).reshape(t, MOE_GROUPS, EXPERTS_PER_GROUP)
    sel = jnp.broadcast_to(g_idx[:, :, None], (t, 1, EXPERTS_PER_GROUP))
    e_in_group = jnp.take_along_axis(e_logits, sel, axis=1)[:, 0]
    top_logit, top_j = lax.top_k(e_in_group, MOE_TOP_K)
    top_w = jax.nn.softmax(top_logit, axis=-1) * g_w
    flat_e = (g_idx * EXPERTS_PER_GROUP + top_j).reshape(-1)
    n_slots = t * MOE_TOP_K
    order = jnp.argsort(flat_e)
    sorted_e = flat_e[order]
    counts = jnp.bincount(flat_e, length=N_EXPERTS)
    padded = (counts + MOE_BLOCK - 1) // MOE_BLOCK * MOE_BLOCK
    pad_end = jnp.cumsum(padded)
    pad_start = pad_end - padded
    start = jnp.cumsum(counts) - counts
    dest = pad_start[sorted_e] + jnp.arange(n_slots) - start[sorted_e]
    n_blocks = (n_slots + N_EXPERTS * (MOE_BLOCK - 1) + MOE_BLOCK - 1) // MOE_BLOCK
    n_rows = n_blocks * MOE_BLOCK
    tok = order // MOE_TOP_K
    buf = jnp.zeros((n_rows, d), x.dtype).at[dest].set(xf[tok])
    block_expert = jnp.minimum(jnp.searchsorted(pad_end, jnp.arange(n_blocks) * MOE_BLOCK, side='right'), N_EXPERTS - 1)

    def run_block(args):
        xb, e = args
        return expert_ffn(xb, w_gate[e], w_up[e], w_down[e])

    out_buf = lax.map(run_block, (buf.reshape(n_blocks, MOE_BLOCK, d), block_expert)).reshape(n_rows, d)
    y_slot = out_buf[dest] * top_w.reshape(-1)[order][:, None].astype(x.dtype)
    return jax.ops.segment_sum(y_slot, tok, num_segments=t).reshape(b, l, d)


def even_mixer(h, w_in, ret_norm, conv_w, conv_b, dt_bias, a_log, d_skip, ssd_norm, w_out):
    b, l, _ = h.shape
    q, k, v, g, z, xbc, dt_raw = jnp.split(h @ w_in, IN0_SPLITS, axis=-1)

    def heads(t):
        return t.reshape(b, l, RET_HEADS, RET_DIM)

    a_out = retention(heads(q), heads(k), heads(v), heads(g), ret_norm).reshape(b, l, RET_WIDTH)
    b_out = ssd(xbc, z, dt_raw, conv_w, conv_b, dt_bias, a_log, d_skip, ssd_norm)
    mixed = jnp.concatenate([a_out, b_out], axis=-1).astype(h.dtype)
    return mixed @ w_out


def odd_mixer(h, w_in, conv_w, conv_b, i_bias, f_bias, norm_g, a_re, a_im, log_dt, b_re, b_im, c_re, c_im, d_skip, w_glu, b_glu, w_out):
    b, l, _ = h.shape
    q, k, v, o, i_pre, f_pre, u = jnp.split(h @ w_in, IN1_SPLITS, axis=-1)
    qk = jax.nn.silu(causal_dwconv(jnp.concatenate([q, k], axis=-1), conv_w, conv_b))
    q, k = jnp.split(qk, 2, axis=-1)

    def heads(t):
        return t.reshape(b, l, MLSTM_HEADS, MLSTM_DIM)

    c_out = mlstm(heads(q), heads(k), heads(v), heads(o), i_pre + i_bias, f_pre + f_bias, norm_g).reshape(b, l, MLSTM_WIDTH)
    d_out = s5(u, a_re, a_im, log_dt, b_re, b_im, c_re, c_im, d_skip, w_glu, b_glu)
    mixed = jnp.concatenate([c_out, d_out], axis=-1).astype(h.dtype)
    return mixed @ w_out


def setup_inputs(seed: int = 0) -> dict:
    key = jax.random.key(seed)
    ks = iter(jax.random.split(key, 64))

    def nrm(shape, scale):
        return jax.random.normal(next(ks), shape, F32) * scale

    def gain(shape):
        return 1.0 + nrm(shape, 0.02)

    def unif(shape, lo, hi):
        return jax.random.uniform(next(ks), shape, F32, lo, hi)

    log_dt_lo, log_dt_hi = float(np.log(1e-3)), float(np.log(1e-1))
    ssd_dt = jnp.exp(unif((N_EVEN, SSD_HEADS), log_dt_lo, log_dt_hi))
    return {
        'x': nrm((BATCH, SEQ, D_MODEL), 1.0),
        'even_norm': gain((N_EVEN, D_MODEL)),
        'even_w_in': nrm((N_EVEN, D_MODEL, IN0_WIDTH), D_MODEL ** -0.5),
        'ret_norm': gain((N_EVEN, RET_HEADS, RET_DIM)),
        'ssd_conv_w': nrm((N_EVEN, CONV_W, SSD_CONV_CH), CONV_W ** -0.5),
        'ssd_conv_b': nrm((N_EVEN, SSD_CONV_CH), 0.02),
        'ssd_dt_bias': ssd_dt + jnp.log(-jnp.expm1(-ssd_dt)),
        'ssd_a_log': jnp.log(unif((N_EVEN, SSD_HEADS), 1.0, 16.0)),
        'ssd_d': gain((N_EVEN, SSD_HEADS)),
        'ssd_norm': gain((N_EVEN, SSD_WIDTH)),
        'even_w_out': nrm((N_EVEN, MIX0_WIDTH, D_MODEL), MIX0_WIDTH ** -0.5),
        'odd_norm': gain((N_ODD, D_MODEL)),
        'odd_w_in': nrm((N_ODD, D_MODEL, IN1_WIDTH), D_MODEL ** -0.5),
        'mlstm_conv_w': nrm((N_ODD, CONV_W, 2 * MLSTM_WIDTH), CONV_W ** -0.5),
        'mlstm_conv_b': nrm((N_ODD, 2 * MLSTM_WIDTH), 0.02),
        'mlstm_i_bias': nrm((N_ODD, MLSTM_HEADS), 0.1),
        'mlstm_f_bias': jnp.linspace(3.0, 6.0, MLSTM_HEADS, dtype=F32)[None, :] + nrm((N_ODD, MLSTM_HEADS), 0.02),
        'mlstm_norm': gain((N_ODD, MLSTM_HEADS, MLSTM_DIM)),
        's5_a_re': -0.5 + nrm((N_ODD, S5_GROUPS, S5_STATE), 0.01),
        's5_a_im': jnp.pi * jnp.arange(S5_STATE, dtype=F32) + nrm((N_ODD, S5_GROUPS, S5_STATE), 0.01),
        's5_log_dt': unif((N_ODD, S5_GROUPS), log_dt_lo, log_dt_hi),
        's5_b_re': nrm((N_ODD, S5_GROUPS, S5_STATE, S5_GROUP), (2 * S5_GROUP) ** -0.5),
        's5_b_im': nrm((N_ODD, S5_GROUPS, S5_STATE, S5_GROUP), (2 * S5_GROUP) ** -0.5),
        's5_c_re': nrm((N_ODD, S5_GROUPS, S5_GROUP, S5_STATE), S5_STATE ** -0.5),
        's5_c_im': nrm((N_ODD, S5_GROUPS, S5_GROUP, S5_STATE), S5_STATE ** -0.5),
        's5_d': nrm((N_ODD, S5_GROUPS, S5_GROUP), 1.0),
        's5_w_glu': nrm((N_ODD, S5_WIDTH, 2 * S5_WIDTH), S5_WIDTH ** -0.5),
        's5_b_glu': nrm((N_ODD, 2 * S5_WIDTH), 0.02),
        'odd_w_out': nrm((N_ODD, MIX1_WIDTH, D_MODEL), MIX1_WIDTH ** -0.5),
        'moe_norm': gain((DEPTH, D_MODEL)),
        'moe_router_g': nrm((DEPTH, D_MODEL, MOE_GROUPS), D_MODEL ** -0.5),
        'moe_router_g_b': nrm((DEPTH, MOE_GROUPS), 0.01),
        'moe_router_e': nrm((DEPTH, D_MODEL, N_EXPERTS), D_MODEL ** -0.5),
        'moe_router_e_b': nrm((DEPTH, N_EXPERTS), 0.01),
        'moe_w_gate': nrm((DEPTH, N_EXPERTS, D_MODEL, EXPERT_FF), D_MODEL ** -0.5),
        'moe_w_up': nrm((DEPTH, N_EXPERTS, D_MODEL, EXPERT_FF), D_MODEL ** -0.5),
        'moe_w_down': nrm((DEPTH, N_EXPERTS, EXPERT_FF, D_MODEL), EXPERT_FF ** -0.5),
        'final_norm': gain((D_MODEL,)),
    }


def reference(x, even_norm, even_w_in, ret_norm, ssd_conv_w, ssd_conv_b, ssd_dt_bias, ssd_a_log, ssd_d, ssd_norm, even_w_out, odd_norm, odd_w_in, mlstm_conv_w, mlstm_conv_b, mlstm_i_bias, mlstm_f_bias, mlstm_norm, s5_a_re, s5_a_im, s5_log_dt, s5_b_re, s5_b_im, s5_c_re, s5_c_im, s5_d, s5_w_glu, s5_b_glu, odd_w_out, moe_norm, moe_router_g, moe_router_g_b, moe_router_e, moe_router_e_b, moe_w_gate, moe_w_up, moe_w_down, final_norm):
    h = x
    for layer in range(DEPTH):
        i = layer // 2
        if layer % 2 == 0:
            h = h + even_mixer(rms_norm(h, even_norm[i]), even_w_in[i], ret_norm[i], ssd_conv_w[i], ssd_conv_b[i], ssd_dt_bias[i], ssd_a_log[i], ssd_d[i], ssd_norm[i], even_w_out[i])
        else:
            h = h + odd_mixer(rms_norm(h, odd_norm[i]), odd_w_in[i], mlstm_conv_w[i], mlstm_conv_b[i], mlstm_i_bias[i], mlstm_f_bias[i], mlstm_norm[i], s5_a_re[i], s5_a_im[i], s5_log_dt[i], s5_b_re[i], s5_b_im[i], s5_c_re[i], s5_c_im[i], s5_d[i], s5_w_glu[i], s5_b_glu[i], odd_w_out[i])
        h = h + hier_moe(rms_norm(h, moe_norm[layer]), moe_router_g[layer], moe_router_g_b[layer], moe_router_e[layer], moe_router_e_b[layer], moe_w_gate[layer], moe_w_up[layer], moe_w_down[layer])
    return rms_norm(h, final_norm)
```

```cpp
#include <hip/hip_runtime.h>
#include <cstdio>
#include <cstdint>

#ifndef MK_SINGLE
#define MK_SINGLE 0
#endif
#ifndef DBG
#define DBG 0
#endif

#define DI __device__ __forceinline__
#define LAS __attribute__((address_space(3)))
typedef unsigned short bf16_t;
typedef short bf16x8 __attribute__((ext_vector_type(8)));
typedef float f32x4 __attribute__((ext_vector_type(4)));
typedef float f32x2 __attribute__((ext_vector_type(2)));
typedef unsigned u32x4 __attribute__((ext_vector_type(4)));
typedef unsigned u32x2 __attribute__((ext_vector_type(2)));
typedef LAS unsigned char* ldsp;

constexpr int T = 16384, D = 2048, SEQ = 4096, NC = 32;
constexpr int PLD = 6912;
constexpr int N0 = 6672, N1 = 6664;
constexpr int P0_K = 1024, P0_V = 2048, P0_G = 3072, P0_Z = 4096, P0_XBC = 5120, P0_DT = 6656;
constexpr int P1_K = 1536, P1_V = 3072, P1_O = 4608, P1_I = 6144, P1_F = 6148, P1_U = 6152;
constexpr float EPS = 1e-6f;
constexpr int NPHASE = 20;

constexpr size_t MiB = 1u << 20;
constexpr size_t WS_CTL = 0, CTL_BYTES = 1 * MiB;
constexpr size_t WS_COS = 1 * MiB, WS_SIN = 2 * MiB;
constexpr size_t WS_RT = 3 * MiB;
constexpr size_t WS_S5T = 4 * MiB;
constexpr size_t WS_SMALL = 5 * MiB;
constexpr size_t WS_WIN0 = 8 * MiB, WS_WOUT0 = 35 * MiB, WS_WIN1 = 43 * MiB, WS_WOUT1 = 70 * MiB, WS_WGLU = 78 * MiB;
constexpr size_t WS_WGU = 80 * MiB, WS_WD = 208 * MiB;
constexpr size_t WS_XN = 272 * MiB, WS_MIX = 336 * MiB, WS_HID = 400 * MiB, WS_PROJ = 440 * MiB, WS_Y = WS_PROJ;
constexpr size_t WS_STATE = 656 * MiB;
constexpr size_t WS_RET_DS = WS_STATE, WS_RET_S = WS_STATE + 64 * MiB, WS_SSD_DS = WS_STATE + 96 * MiB, WS_SSD_S = WS_STATE + 160 * MiB;
constexpr size_t WS_MC = WS_STATE;
constexpr size_t WS_MN = WS_STATE + 144 * MiB;
constexpr size_t WS_S5E = WS_STATE + 146 * MiB;
constexpr size_t WS_Y5 = WS_STATE + 150 * MiB;
constexpr size_t WS_LIST = 856 * MiB;
constexpr size_t WS_SLOT = 858 * MiB;
constexpr size_t WS_END = 860 * MiB;
constexpr int CW_BAR = 4096;
constexpr int CW_CNT = 16384;

constexpr int LDS_TAB = 131072;
constexpr int LDS_CTL = 146944;
constexpr int LDS_BYTES = 147456;

typedef __bf16 bf16x2_t __attribute__((ext_vector_type(2)));
DI unsigned pk2(float lo, float hi) { const f32x2 v = {lo, hi}; const bf16x2_t r = __builtin_convertvector(v, bf16x2_t); return __builtin_bit_cast(unsigned, r); }
DI float bflo(unsigned w) { return __uint_as_float(w << 16); }
DI float bfhi(unsigned w) { return __uint_as_float(w & 0xffff0000u); }
DI float bf2f(bf16_t b) { return __uint_as_float(((unsigned)b) << 16); }
DI bf16_t f2bf(float f) { return (bf16_t)(pk2(f, 0.f) & 0xffffu); }
DI float sigmoid_(float x) { return __builtin_amdgcn_rcpf(1.f + __expf(-x)); }
DI float silu_(float x) { return x * sigmoid_(x); }
DI float softplus_(float x) { return x > 20.f ? x : log1pf(__expf(x)); }
DI float logsigmoid_(float x) { return -softplus_(-x); }
DI float gelu_(float x) { const float u = 0.7978845608f * (x + 0.044715f * x * x * x); const float t = 1.f - 2.f * __builtin_amdgcn_rcpf(1.f + __expf(2.f * u)); return 0.5f * x * (1.f + t); }
DI float wsum(float v) {
#pragma unroll
    for (int o = 1; o < 64; o <<= 1) v += __shfl_xor(v, o);
    return v; }
DI float wmax(float v) {
#pragma unroll
    for (int o = 1; o < 64; o <<= 1) v = fmaxf(v, __shfl_xor(v, o));
    return v; }
DI void unpack8(const u32x4 v, float (&f)[8]) { f[0] = bflo(v.x); f[1] = bfhi(v.x); f[2] = bflo(v.y); f[3] = bfhi(v.y); f[4] = bflo(v.z); f[5] = bfhi(v.z); f[6] = bflo(v.w); f[7] = bfhi(v.w); }
DI u32x4 pack8(const float (&f)[8]) { u32x4 o; o.x = pk2(f[0], f[1]); o.y = pk2(f[2], f[3]); o.z = pk2(f[4], f[5]); o.w = pk2(f[6], f[7]); return o; }
#define LDS_WAIT() asm volatile("s_waitcnt lgkmcnt(0)" ::: "memory")
DI void wscan_sum(float a0, float a1, int lane, float& c0, float& c1) {
    const float s = a0 + a1; float x = s;
#pragma unroll
    for (int o = 1; o < 64; o <<= 1) { const float y = __shfl_up(x, o); if (lane >= o) x += y; }
    const float ex = x - s; c0 = ex + a0; c1 = c0 + a1; }
DI void wscan_max(float a0, float a1, int lane, float& c0, float& c1) {
    const float s = fmaxf(a0, a1); float x = s;
#pragma unroll
    for (int o = 1; o < 64; o <<= 1) { const float y = __shfl_up(x, o); if (lane >= o) x = fmaxf(x, y); }
    float ex = __shfl_up(x, 1); if (lane == 0) ex = -INFINITY;
    c0 = fmaxf(ex, a0); c1 = fmaxf(c0, a1); }

namespace pg8 {
constexpr int BM = 256, BK = 64, HALF = 128, HTB = HALF * BK * 2, STAGE_BYTES = 8 * HTB;
DI int lds_byte(int r, int c) { const int st = (r >> 4) * 2 + (c >> 5), rr = r & 15, cc = c & 31, ob = rr * 64 + cc * 2; return st * 1024 + (ob ^ (((ob >> 9) & 1) << 5)); }
DI void stage_rc(int b, int& R, int& C) { const int st = b / 1024, sb = b % 1024, swz = sb ^ (((sb >> 9) & 1) << 5); R = (st >> 1) * 16 + swz / 64; C = (st & 1) * 32 + (swz % 64) / 2; }
DI int perm32(int rho) { const int n = rho >> 4, i = rho & 15; return 8 * (i >> 2) + 4 * n + (i & 3); }
struct Unit { const char* A; const char* B; int row0, col0, aux; };
typedef f32x4 Acc[2][2][4][2];

template <class Epi, class Sched, bool GATHER>
DI void gemm_phase(ldsp lds, const int K, const int lda, const int ldb, const Sched& S, const Epi& E) {
    const int tid = threadIdx.x, wid = __builtin_amdgcn_readfirstlane(tid >> 6), lane = tid & 63, wr = wid >> 2, wc = wid & 3, fr = lane & 15, fq = lane >> 4;
    const int nt = K / BK;
    unsigned voffA[2], voffB[2]; int RA[2], CA[2];
#pragma unroll
    for (int i = 0; i < 2; ++i) { int R, C; stage_rc(tid * 16 + i * 8192, R, C); const int Rb = Epi::PERM ? ((R & ~31) + perm32(R & 31)) : R;
        RA[i] = R; CA[i] = C; voffA[i] = (unsigned)(R * lda + C) * 2u; voffB[i] = (unsigned)(Rb * ldb + C) * 2u; }
    const unsigned hstepA = (unsigned)HALF * (unsigned)lda * 2u, hstepB = (unsigned)HALF * (unsigned)ldb * 2u;
    const size_t kstep = (size_t)(BK * 2);
    const unsigned ldsw = (unsigned)wid * 1024u;
    const int aoff = lds_byte(wr * 64 + fr, fq * 8), boff = lds_byte(wc * 32 + fr, fq * 8);
    unsigned vc[2][2], vn[2][2];
#define PG8_SA(b, h) (((b) * 2 + (h)) * HTB)
#define PG8_SB(b, h) ((4 + (b) * 2 + (h)) * HTB)
#define PG8_AOFF(h, i, NX) (GATHER ? ((NX) ? vn[h][i] : vc[h][i]) : (voffA[i] + (unsigned)(h) * hstepA))
#define PG8_STAGE_A(bufoff, gbase, h, NX) do { _Pragma("unroll") for (int _i = 0; _i < 2; ++_i) \
        __builtin_amdgcn_global_load_lds((const unsigned*)((const char*)(gbase) + PG8_AOFF(h, _i, NX)), (LAS unsigned*)(lds + (bufoff) + ldsw + _i * 8192), 16, 0, 0); } while (0)
#define PG8_STAGE_B(bufoff, gbase) do { _Pragma("unroll") for (int _i = 0; _i < 2; ++_i) \
        __builtin_amdgcn_global_load_lds((const unsigned*)((const char*)(gbase) + voffB[_i]), (LAS unsigned*)(lds + (bufoff) + ldsw + _i * 8192), 16, 0, 0); } while (0)
#define PG8_LDA(dst, b, h) do { _Pragma("unroll") for (int m = 0; m < 4; ++m) _Pragma("unroll") for (int k = 0; k < 2; ++k) dst[m][k] = *(const LAS bf16x8*)(lds + PG8_SA(b, h) + aoff + m * 2048 + k * 1024); } while (0)
#define PG8_LDB(dst, b, h) do { _Pragma("unroll") for (int n = 0; n < 2; ++n) _Pragma("unroll") for (int k = 0; k < 2; ++k) dst[n][k] = *(const LAS bf16x8*)(lds + PG8_SB(b, h) + boff + n * 2048 + k * 1024); } while (0)
#define PG8_MMA(ai, bj, At, Bt) do { __builtin_amdgcn_s_setprio(1); _Pragma("unroll") for (int m = 0; m < 4; ++m) _Pragma("unroll") for (int n = 0; n < 2; ++n) _Pragma("unroll") for (int k = 0; k < 2; ++k) \
        acc[ai][bj][m][n] = __builtin_amdgcn_mfma_f32_16x16x32_bf16(Bt[n][k], At[m][k], acc[ai][bj][m][n], 0, 0, 0); __builtin_amdgcn_s_setprio(0); } while (0)
#define PG8_WAIT_V(n) asm volatile("s_waitcnt vmcnt(" #n ")" ::: "memory")
#define PG8_WAIT_L(n) asm volatile("s_waitcnt lgkmcnt(" #n ")" ::: "memory")
#define PG8_BAR __builtin_amdgcn_s_barrier()
#define PG8_SCHED __builtin_amdgcn_sched_barrier(0)
    Unit cur, nxt; int ui = 0;
    if (!S.next(0, cur)) return;
    Acc acc;
#pragma unroll
    for (int a = 0; a < 2; ++a)
#pragma unroll
        for (int b = 0; b < 2; ++b)
#pragma unroll
            for (int m = 0; m < 4; ++m)
#pragma unroll
                for (int n = 0; n < 2; ++n) acc[a][b][m][n] = (f32x4){0.f, 0.f, 0.f, 0.f};
    bf16x8 At[4][2], B0[2][2], B1[2][2];
    const char* cA = cur.A; const char* cB = cur.B;
    if constexpr (GATHER) {
#pragma unroll
        for (int h = 0; h < 2; ++h)
#pragma unroll
            for (int i = 0; i < 2; ++i) { vc[h][i] = ((unsigned)S.grow(cur, RA[i] + 128 * h) * (unsigned)lda + (unsigned)CA[i]) * 2u; vn[h][i] = vc[h][i]; }
    }
    PG8_STAGE_B(PG8_SB(0, 0), cB); PG8_STAGE_B(PG8_SB(0, 1), cB + hstepB); PG8_STAGE_A(PG8_SA(0, 0), cA, 0, false); PG8_STAGE_A(PG8_SA(0, 1), cA, 1, false);
    if (wr == 1) PG8_BAR;
    PG8_WAIT_V(2); PG8_BAR;
    PG8_STAGE_B(PG8_SB(1, 0), cB + kstep); PG8_STAGE_A(PG8_SA(1, 0), cA + kstep, 0, false); PG8_STAGE_B(PG8_SB(1, 1), cB + hstepB + kstep);
    PG8_WAIT_V(6); PG8_BAR;
    for (;;) {
        const bool has_next = S.next(ui + 1, nxt);
        const char* nA = has_next ? nxt.A : cA; const char* nB = has_next ? nxt.B : cB;
        if constexpr (GATHER) {
            if (has_next) {
#pragma unroll
                for (int h = 0; h < 2; ++h)
#pragma unroll
                    for (int i = 0; i < 2; ++i) vn[h][i] = ((unsigned)S.grow(nxt, RA[i] + 128 * h) * (unsigned)lda + (unsigned)CA[i]) * 2u;
            }
        }
        for (int t = 0; t < nt; t += 2) {
            const bool last = (t == nt - 2);
            const char* a1 = cA + (size_t)(t + 1) * kstep;
            const char* a2 = last ? nA : cA + (size_t)(t + 2) * kstep; const char* b2 = last ? nB : cB + (size_t)(t + 2) * kstep;
            const char* a3 = a2 + kstep; const char* b3 = b2 + kstep;
            PG8_LDB(B0, 0, 0); PG8_LDB(B1, 0, 1); PG8_SCHED; PG8_LDA(At, 0, 0); PG8_STAGE_A(PG8_SA(1, 1), a1, 1, false);
            PG8_WAIT_V(8); PG8_WAIT_L(0); PG8_BAR; PG8_MMA(0, 0, At, B0); PG8_MMA(0, 1, At, B1); PG8_BAR; PG8_SCHED;
            PG8_LDA(At, 0, 1); PG8_STAGE_B(PG8_SB(0, 0), b2); PG8_STAGE_B(PG8_SB(0, 1), b2 + hstepB); PG8_STAGE_A(PG8_SA(0, 0), a2, 0, last);
            PG8_WAIT_V(8); PG8_WAIT_L(0); PG8_BAR; PG8_MMA(1, 0, At, B0); PG8_MMA(1, 1, At, B1); PG8_BAR; PG8_SCHED;
            PG8_LDB(B0, 1, 0); PG8_LDB(B1, 1, 1); PG8_SCHED; PG8_LDA(At, 1, 0); PG8_STAGE_A(PG8_SA(0, 1), a2, 1, last);
            PG8_WAIT_V(8); PG8_WAIT_L(0); PG8_BAR; PG8_MMA(0, 0, At, B0); PG8_MMA(0, 1, At, B1); PG8_BAR; PG8_SCHED;
            PG8_LDA(At, 1, 1); PG8_STAGE_B(PG8_SB(1, 0), b3); PG8_STAGE_B(PG8_SB(1, 1), b3 + hstepB); PG8_STAGE_A(PG8_SA(1, 0), a3, 0, last);
            PG8_WAIT_V(8); PG8_WAIT_L(0); PG8_BAR; PG8_MMA(1, 0, At, B0); PG8_MMA(1, 1, At, B1); PG8_BAR; PG8_SCHED;
        }
        if (wr == 0) PG8_BAR;
        E(acc, cur, wr, wc, fr, fq);
        if (!has_next) break;
#pragma unroll
        for (int a = 0; a < 2; ++a)
#pragma unroll
            for (int b = 0; b < 2; ++b)
#pragma unroll
                for (int m = 0; m < 4; ++m)
#pragma unroll
                    for (int n = 0; n < 2; ++n) acc[a][b][m][n] = (f32x4){0.f, 0.f, 0.f, 0.f};
        cur = nxt; cA = nA; cB = nB; ++ui;
        if constexpr (GATHER) {
#pragma unroll
            for (int h = 0; h < 2; ++h)
#pragma unroll
                for (int i = 0; i < 2; ++i) vc[h][i] = vn[h][i];
        }
        if (wr == 1) PG8_BAR;
    }
    PG8_WAIT_V(0);
    PG8_BAR;
#undef PG8_SA
#undef PG8_SB
#undef PG8_AOFF
#undef PG8_STAGE_A
#undef PG8_STAGE_B
#undef PG8_LDA
#undef PG8_LDB
#undef PG8_MMA
#undef PG8_WAIT_V
#undef PG8_WAIT_L
#undef PG8_BAR
#undef PG8_SCHED
}

struct Tile2D {
    const char* A; const char* B; int nM, nN, nwg, G, c; size_t tA, tB;
    DI void init(const void* A_, const void* B_, int M, int N, int lda, int ldb, int G_, int c_) { A = (const char*)A_; B = (const char*)B_; nM = M / 256; nN = N / 256; nwg = nM * nN; G = G_; c = c_; tA = (size_t)256 * lda * 2; tB = (size_t)256 * ldb * 2; }
    DI bool next(int i, Unit& u) const {
        const long L = (long)i * G + c; if (L >= nwg) return false;
        int wgid = (int)L; { const int q = nwg / 8, r = nwg % 8, xcd = wgid % 8, off = wgid / 8; wgid = (xcd < r ? xcd * (q + 1) : r * (q + 1) + (xcd - r) * q) + off; }
        const int nig = 8 * nN, gid = wgid / nig, fm = gid * 8, gsz = (nM - fm) < 8 ? (nM - fm) : 8;
        const int pm = fm + ((wgid % nig) % gsz), pn = (wgid % nig) / gsz;
        u.A = A + (size_t)pm * tA; u.B = B + (size_t)pn * tB; u.row0 = pm * 256; u.col0 = pn * 256; u.aux = 0; return true;
    }
    DI int grow(const Unit&, int) const { return 0; }
};
struct GluOrder { Tile2D t; DI bool next(int i, Unit& u) const { if (!t.next(i, u)) return false; u.col0 >>= 1; return true; } DI int grow(const Unit&, int) const { return 0; } };
struct MoeGU {
    const char* XN; const char* W; const LAS int* tile_e; const LAS int* gtab; int nunits, G, c;
    DI bool next(int i, Unit& u) const {
        const int L = i * G + c; if (L >= nunits || i >= 4) return false;
        const int gm = L >> 2, j = L & 3, e = tile_e[gm];
        u.A = XN; u.B = W + ((size_t)e * 1024 + (size_t)j * 256) * 2048 * 2; u.row0 = gm * 256; u.col0 = j * 128; u.aux = i; return true;
    }
    DI int grow(const Unit& u, int r) const { return gtab[u.aux * 256 + r]; }
};
struct MoeDown {
    const char* HID; const char* W; const LAS int* tile_e; int nunits, G, c;
    DI bool next(int i, Unit& u) const {
        const int L = i * G + c; if (L >= nunits) return false;
        const int gm = L >> 3, pn = L & 7, e = tile_e[gm];
        u.A = HID + (size_t)gm * 256 * 512 * 2; u.B = W + ((size_t)e * 2048 + (size_t)pn * 256) * 512 * 2; u.row0 = gm * 256; u.col0 = pn * 256; u.aux = e; return true;
    }
    DI int grow(const Unit&, int) const { return 0; }
};

struct EpiBf16 {
    static constexpr bool PERM = true;
    bf16_t* O; int ldc;
    DI void operator()(const Acc& acc, const Unit& u, int wr, int wc, int fr, int fq) const {
#pragma unroll
        for (int ai = 0; ai < 2; ++ai)
#pragma unroll
            for (int m = 0; m < 4; ++m) { bf16_t* rowp = O + (size_t)(u.row0 + ai * HALF + wr * 64 + m * 16 + fr) * ldc + u.col0 + wc * 32 + 8 * fq;
#pragma unroll
                for (int bj = 0; bj < 2; ++bj) { const f32x4 v0 = acc[ai][bj][m][0], v1 = acc[ai][bj][m][1];
                    u32x4 w; w.x = pk2(v0[0], v0[1]); w.y = pk2(v0[2], v0[3]); w.z = pk2(v1[0], v1[1]); w.w = pk2(v1[2], v1[3]);
                    *(u32x4*)(rowp + bj * HALF) = w; } }
    }
};
struct EpiResF32 {
    static constexpr bool PERM = false;
    const float* res; float* out; int ldc;
    DI void operator()(const Acc& acc, const Unit& u, int wr, int wc, int fr, int fq) const {
#pragma unroll
        for (int ai = 0; ai < 2; ++ai)
#pragma unroll
            for (int m = 0; m < 4; ++m) { const size_t off = (size_t)(u.row0 + ai * HALF + wr * 64 + m * 16 + fr) * ldc + u.col0 + wc * 32 + 4 * fq;
#pragma unroll
                for (int bj = 0; bj < 2; ++bj)
#pragma unroll
                    for (int n = 0; n < 2; ++n) { const f32x4 r = *(const f32x4*)(res + off + bj * HALF + n * 16); *(f32x4*)(out + off + bj * HALF + n * 16) = r + acc[ai][bj][m][n]; } }
    }
};
struct EpiGateUp {
    static constexpr bool PERM = true;
    bf16_t* O; int ldc;
    DI void operator()(const Acc& acc, const Unit& u, int wr, int wc, int fr, int fq) const {
#pragma unroll
        for (int ai = 0; ai < 2; ++ai)
#pragma unroll
            for (int m = 0; m < 4; ++m) { bf16_t* rowp = O + (size_t)(u.row0 + ai * HALF + wr * 64 + m * 16 + fr) * ldc + u.col0 + wc * 32 + 8 * fq;
                float o[8];
#pragma unroll
                for (int n = 0; n < 2; ++n)
#pragma unroll
                    for (int j = 0; j < 4; ++j) o[n * 4 + j] = silu_(acc[ai][0][m][n][j]) * acc[ai][1][m][n][j];
                *(u32x4*)rowp = pack8(o); }
    }
};
struct EpiGlu {
    static constexpr bool PERM = true;
    bf16_t* O; int ldc; const float* bias;
    DI void operator()(const Acc& acc, const Unit& u, int wr, int wc, int fr, int fq) const {
        const int cb = u.col0 + wc * 32 + 8 * fq;
        float bv[8], bg[8];
#pragma unroll
        for (int j = 0; j < 8; ++j) { bv[j] = bias[cb + j]; bg[j] = bias[512 + cb + j]; }
#pragma unroll
        for (int ai = 0; ai < 2; ++ai)
#pragma unroll
            for (int m = 0; m < 4; ++m) { bf16_t* rowp = O + (size_t)(u.row0 + ai * HALF + wr * 64 + m * 16 + fr) * ldc + cb;
                float o[8];
#pragma unroll
                for (int n = 0; n < 2; ++n)
#pragma unroll
                    for (int j = 0; j < 4; ++j) o[n * 4 + j] = (acc[ai][0][m][n][j] + bv[n * 4 + j]) * sigmoid_(acc[ai][1][m][n][j] + bg[n * 4 + j]);
                *(u32x4*)rowp = pack8(o); }
    }
};
}

#define XB_TMO      128
#define XB_XCNT(j)  (256  + 64 * (j))
#define XB_XSUB(j)  (1280 + 64 * (j))
#define XB_XGEN(j)  (2304 + 64 * (j))
#define XB_TOP      3328
#define XB_TOPGEN   3392
#define XCD_BAR_WORDS 3456
#define XB_SPIN_CAP (1u << 18)
__device__ __forceinline__ unsigned xb_ld(unsigned* p)              { return __hip_atomic_load(p, __ATOMIC_RELAXED, __HIP_MEMORY_SCOPE_AGENT); }
__device__ __forceinline__ unsigned xb_add(unsigned* p, unsigned v) { return __hip_atomic_fetch_add(p, v, __ATOMIC_RELAXED, __HIP_MEMORY_SCOPE_AGENT); }
__device__ __forceinline__ unsigned xb_xcc_id() { return (unsigned)__builtin_amdgcn_s_getreg((3 << 11) | 20) & 0xFu; }
#define XB_SPIN(cond, bar) do { unsigned _sp = 0; while (cond) { __builtin_amdgcn_s_sleep(1); \
    if ((++_sp & 255u) == 0u) { if (xb_ld(&(bar)[XB_TMO])) break; if (_sp > XB_SPIN_CAP) { atomicAdd(&(bar)[XB_TMO], 1u); break; } } } } while (0)
struct XcdBarrier { unsigned* bar; unsigned x; volatile LAS unsigned* st; };
__device__ __forceinline__ XcdBarrier xcd_barrier_post(unsigned* bar, volatile LAS unsigned* st) {
    XcdBarrier b; b.bar = bar; b.x = xb_xcc_id(); b.st = st;
    if (threadIdx.x == 0) (void)xb_add(&bar[XB_XCNT(b.x)], 1u);
    return b;
}
__device__ __forceinline__ void xcd_barrier_complete(unsigned* bar, unsigned x, unsigned& nloc, unsigned& nx) {
    const unsigned G = gridDim.x * gridDim.y * gridDim.z;
    unsigned sum, cnt, mine, sp = 0u;
    for (;;) {
        sum = 0u; cnt = 0u; mine = 0u;
#pragma unroll
        for (unsigned j = 0; j < 16; ++j) { const unsigned c = xb_ld(&bar[XB_XCNT(j)]); sum += c; cnt += (c > 0u) ? 1u : 0u; mine = (j == x) ? c : mine; }
        if (sum == G) break;
        __builtin_amdgcn_s_sleep(1);
        if ((++sp & 255u) == 0u) { if (xb_ld(&bar[XB_TMO])) break; if (sp > XB_SPIN_CAP) { atomicAdd(&bar[XB_TMO], 1u); break; } }
    }
    nloc = mine > 0u ? mine : 1u; nx = cnt > 0u ? cnt : 1u;
}
__device__ __forceinline__ void xcd_barrier(const XcdBarrier& b) {
    asm volatile("s_waitcnt vmcnt(0)" ::: "memory");
    __syncthreads();
    if (threadIdx.x == 0) {
        unsigned* bar = b.bar;
        __builtin_amdgcn_s_waitcnt(0);
        unsigned nloc = b.st[0], nx = b.st[1];
        if (nloc == 0u) { xcd_barrier_complete(bar, b.x, nloc, nx); b.st[0] = nloc; b.st[1] = nx; }
        const unsigned old = xb_add(&bar[XB_XSUB(b.x)], 1u);
        const unsigned gen = old / nloc;
        if (old + 1u == (gen + 1u) * nloc) {
            __builtin_amdgcn_fence(__ATOMIC_RELEASE, "agent");
            asm volatile("s_waitcnt vmcnt(0)" ::: "memory");
            const unsigned og = xb_add(&bar[XB_TOP], 1u);
            const unsigned tg = og / nx;
            if (og + 1u == (tg + 1u) * nx) xb_add(&bar[XB_TOPGEN], 1u);
            else XB_SPIN(xb_ld(&bar[XB_TOPGEN]) == tg, bar);
            __builtin_amdgcn_fence(__ATOMIC_ACQUIRE, "agent");
            xb_add(&bar[XB_XGEN(b.x)], 1u);
            asm volatile("s_waitcnt vmcnt(0)" ::: "memory");
        } else {
            XB_SPIN(xb_ld(&bar[XB_XGEN(b.x)]) == gen, bar);
            __builtin_amdgcn_fence(__ATOMIC_ACQUIRE, "agent");
            asm volatile("s_waitcnt vmcnt(0)" ::: "memory");
        }
    }
    __syncthreads();
}

struct Args { const float* in[38]; float* out; unsigned char* ws; int ph_lo, ph_hi; };
enum { I_X = 0, I_EVEN_NORM, I_EVEN_WIN, I_RET_NORM, I_SSD_CONVW, I_SSD_CONVB, I_SSD_DTB, I_SSD_ALOG, I_SSD_D, I_SSD_NORM, I_EVEN_WOUT, I_ODD_NORM, I_ODD_WIN, I_ML_CONVW, I_ML_CONVB,
       I_ML_IB, I_ML_FB, I_ML_NORM, I_S5_ARE, I_S5_AIM, I_S5_LOGDT, I_S5_BRE, I_S5_BIM, I_S5_CRE, I_S5_CIM, I_S5_D, I_S5_WGLU, I_S5_BGLU, I_ODD_WOUT, I_MOE_NORM, I_MOE_RG, I_MOE_RGB,
       I_MOE_RE, I_MOE_REB, I_MOE_WG, I_MOE_WU, I_MOE_WD, I_FINAL_NORM };

struct Frame { ldsp lds; int tid, lane, wave, G, bx; unsigned char* ws; };

template <int NT, int KS>
DI void mma16(f32x4 (&acc)[NT], ldsp Arows, int pitchA, ldsp Bt, int pitchB, int fr, int fq, int nt_lim = NT, int ks_lim = KS) {
#pragma unroll
    for (int ks = 0; ks < KS; ++ks) {
        if (ks < ks_lim) {
            const bf16x8 a = *(const LAS bf16x8*)(Arows + fr * pitchA + (ks * 32 + fq * 8) * 2);
#pragma unroll
            for (int nt = 0; nt < NT; ++nt)
                if (nt < nt_lim) { const bf16x8 b = *(const LAS bf16x8*)(Bt + (nt * 16 + fr) * pitchB + (ks * 32 + fq * 8) * 2);
                    acc[nt] = __builtin_amdgcn_mfma_f32_16x16x32_bf16(b, a, acc[nt], 0, 0, 0); }
        }
    }
}
template <int NT> DI void zero_acc(f32x4 (&acc)[NT]) {
#pragma unroll
    for (int i = 0; i < NT; ++i) acc[i] = (f32x4){0.f, 0.f, 0.f, 0.f}; }

DI void conv8(const bf16_t* P, int pos, const float* cw, int C, const float* cb, float (&y)[8]) {
    const f32x4 b0 = *(const f32x4*)cb, b1 = *(const f32x4*)(cb + 4);
    y[0] = b0[0]; y[1] = b0[1]; y[2] = b0[2]; y[3] = b0[3]; y[4] = b1[0]; y[5] = b1[1]; y[6] = b1[2]; y[7] = b1[3];
#pragma unroll
    for (int tap = 0; tap < 4; ++tap) {
        if (pos - 3 + tap >= 0) {
            const u32x4 xv = *(const u32x4*)(P + (ptrdiff_t)(tap - 3) * PLD); float x[8]; unpack8(xv, x);
            const f32x4 w0 = *(const f32x4*)(cw + tap * C), w1 = *(const f32x4*)(cw + tap * C + 4);
            y[0] += w0[0] * x[0]; y[1] += w0[1] * x[1]; y[2] += w0[2] * x[2]; y[3] += w0[3] * x[3];
            y[4] += w1[0] * x[4]; y[5] += w1[1] * x[5]; y[6] += w1[2] * x[6]; y[7] += w1[3] * x[7];
        }
    }
}

DI void tr_item(const float* W, int N, bf16_t* WT, int ldt, int k0, int n0, int drow0, LAS float* scr, int lane) {
    const int n = n0 + (lane & 31);
#pragma unroll 8
    for (int i = 0; i < 32; ++i) { const int kk = 2 * i + (lane >> 5); scr[kk * 33 + (lane & 31)] = (n < N) ? W[(size_t)(k0 + kk) * N + n] : 0.f; }
    LDS_WAIT();
    const int c = lane & 7;
#pragma unroll
    for (int j = 0; j < 4; ++j) { const int nn = (lane >> 3) + 8 * j; const LAS float* s = scr + (8 * c) * 33 + nn;
        u32x4 o; o.x = pk2(s[0 * 33], s[1 * 33]); o.y = pk2(s[2 * 33], s[3 * 33]); o.z = pk2(s[4 * 33], s[5 * 33]); o.w = pk2(s[6 * 33], s[7 * 33]);
        *(u32x4*)(WT + (size_t)(drow0 + nn) * ldt + k0 + 8 * c) = o; }
    LDS_WAIT();
}
DI void moe_convert(const Frame& F, const Args& a, int layer) {
    LAS float* scr = (LAS float*)(F.lds + F.wave * 16384);
    const int gw = F.bx * 8 + F.wave, NGW = F.G * 8;
    bf16_t* Wgu = (bf16_t*)(F.ws + WS_WGU); bf16_t* Wd = (bf16_t*)(F.ws + WS_WD);
    for (int it = gw; it < 3 * 16384; it += NGW) {
        const int mat = it >> 14, r = it & 16383, e = r >> 9, q = r & 511;
        if (mat < 2) { const int kb = q >> 4, nb = q & 15, n0 = nb * 32;
            const float* src = a.in[mat == 0 ? I_MOE_WG : I_MOE_WU] + (size_t)(layer * 32 + e) * 2048 * 512;
            tr_item(src, 512, Wgu + (size_t)e * 1024 * 2048, 2048, kb * 64, n0, (n0 >> 7) * 256 + (mat ? 128 : 0) + (n0 & 127), scr, F.lane);
        } else { const int kb = q >> 6, nb = q & 63, n0 = nb * 32;
            const float* src = a.in[I_MOE_WD] + (size_t)(layer * 32 + e) * 512 * 2048;
            tr_item(src, 2048, Wd + (size_t)e * 2048 * 512, 512, kb * 64, n0, n0, scr, F.lane); }
    }
}
DI void norm_row_bf16(const float* xr, const float* g, bf16_t* o, int lane) {
    f32x4 v[8]; float ss = 0.f;
#pragma unroll
    for (int j = 0; j < 8; ++j) { v[j] = *(const f32x4*)(xr + (lane + 64 * j) * 4); ss += v[j][0] * v[j][0] + v[j][1] * v[j][1] + v[j][2] * v[j][2] + v[j][3] * v[j][3]; }
    const float rstd = rsqrtf(wsum(ss) * (1.f / D) + EPS);
#pragma unroll
    for (int j = 0; j < 8; ++j) { const f32x4 gg = *(const f32x4*)(g + (lane + 64 * j) * 4);
        u32x2 w; w.x = pk2(v[j][0] * rstd * gg[0], v[j][1] * rstd * gg[1]); w.y = pk2(v[j][2] * rstd * gg[2], v[j][3] * rstd * gg[3]);
        *(u32x2*)(o + (lane + 64 * j) * 4) = w; }
}
DI void phase_prologue(const Frame& F, const Args& a) {
    LAS float* scr = (LAS float*)(F.lds + F.wave * 16384);
    const int gw = F.bx * 8 + F.wave, NGW = F.G * 8;
    bf16_t* Win0 = (bf16_t*)(F.ws + WS_WIN0); bf16_t* Wout0 = (bf16_t*)(F.ws + WS_WOUT0); bf16_t* Win1 = (bf16_t*)(F.ws + WS_WIN1); bf16_t* Wout1 = (bf16_t*)(F.ws + WS_WOUT1); bf16_t* Wglu = (bf16_t*)(F.ws + WS_WGLU);
    constexpr int I_IN = 32 * 209, I_OUT = 32 * 64, I_GLU = 8 * 32;
    for (int it = gw; it < 2 * I_IN + 2 * I_OUT + I_GLU; it += NGW) {
        int r = it;
        if (r < I_IN) { tr_item(a.in[I_EVEN_WIN], N0, Win0, 2048, (r / 209) * 64, (r % 209) * 32, (r % 209) * 32, scr, F.lane); continue; } r -= I_IN;
        if (r < I_IN) { tr_item(a.in[I_ODD_WIN], N1, Win1, 2048, (r / 209) * 64, (r % 209) * 32, (r % 209) * 32, scr, F.lane); continue; } r -= I_IN;
        if (r < I_OUT) { tr_item(a.in[I_EVEN_WOUT], 2048, Wout0, 2048, (r >> 6) * 64, (r & 63) * 32, (r & 63) * 32, scr, F.lane); continue; } r -= I_OUT;
        if (r < I_OUT) { tr_item(a.in[I_ODD_WOUT], 2048, Wout1, 2048, (r >> 6) * 64, (r & 63) * 32, (r & 63) * 32, scr, F.lane); continue; } r -= I_OUT;
        { const int kb = r >> 5, nb = r & 31, n0 = nb * 32, nn = n0 & 511;
          tr_item(a.in[I_S5_WGLU], 1024, Wglu, 512, kb * 64, n0, (nn >> 7) * 256 + (n0 >= 512 ? 128 : 0) + (nn & 127), scr, F.lane); }
    }
    moe_convert(F, a, 0);
    const int gt = F.bx * 512 + F.tid, NT_ = F.G * 512;
    for (int i = gt; i < 2 * 224 * 256; i += NT_) { const int l = i / (224 * 256), r = i % (224 * 256); *(u32x4*)((l ? Win1 : Win0) + (size_t)6688 * 2048 + (size_t)r * 8) = (u32x4){0u, 0u, 0u, 0u}; }
    float* COS = (float*)(F.ws + WS_COS); float* SIN = (float*)(F.ws + WS_SIN);
    for (int i = gt; i < 4096 * 64; i += NT_) { const int pos = i >> 6, k = i & 63; const float inv = 1.0f / powf(10000.f, (float)(2 * k) / 128.f); const float ang = (float)pos * inv; COS[i] = cosf(ang); SIN[i] = sinf(ang); }
    float* RT = (float*)(F.ws + WS_RT);
    for (int i = gt; i < 2 * 48 * 2048; i += NT_) { const int l = i / (48 * 2048), r = i % (48 * 2048), j = r >> 11, k = r & 2047; const float g = a.in[I_MOE_NORM][l * 2048 + k];
        float w = 0.f; if (j < 4) w = a.in[I_MOE_RG][(size_t)(l * 2048 + k) * 4 + j]; else if (j < 36) w = a.in[I_MOE_RE][(size_t)(l * 2048 + k) * 32 + (j - 4)];
        RT[i] = g * w; }
    { f32x2* ABAR = (f32x2*)(F.ws + WS_S5T); f32x2* A128 = ABAR + 2048; float* BBAR = (float*)(F.ws + WS_S5T + 32768);
      for (int i = gt; i < 2048; i += NT_) { const int g = i >> 6;
          const double dt = exp((double)a.in[I_S5_LOGDT][g]), are = a.in[I_S5_ARE][i], aim = a.in[I_S5_AIM][i];
          const double mag = exp(are * dt), br = mag * cos(aim * dt), bi = mag * sin(aim * dt);
          const double m128 = exp(128.0 * are * dt);
          ABAR[i] = (f32x2){(float)br, (float)bi}; A128[i] = (f32x2){(float)(m128 * cos(128.0 * aim * dt)), (float)(m128 * sin(128.0 * aim * dt))};
          const double den = are * are + aim * aim, nr = br - 1.0, cr = (nr * are + bi * aim) / den, ci = (bi * are - nr * aim) / den;
          for (int c = 0; c < 16; ++c) { const double bre = a.in[I_S5_BRE][(size_t)i * 16 + c], bim = a.in[I_S5_BIM][(size_t)i * 16 + c];
              BBAR[(size_t)i * 32 + c] = (float)(cr * bre - ci * bim); BBAR[(size_t)i * 32 + 16 + c] = (float)(cr * bim + ci * bre); } } }
    bf16_t* XN = (bf16_t*)(F.ws + WS_XN);
    for (int m = gw; m < T; m += NGW) norm_row_bf16(a.in[I_X] + (size_t)m * D, a.in[I_EVEN_NORM], XN + (size_t)m * D, F.lane);
}

DI float ret_loggamma(int h) { return log1pf(-exp2f(-5.f - (float)h)); }
DI void rot8(const bf16_t* p, const float* cs, const float* sn, float scale, float (&r1)[8], float (&r2)[8]) {
    float a[8], b[8]; unpack8(*(const u32x4*)p, a); unpack8(*(const u32x4*)(p + 64), b);
    const f32x4 c0 = *(const f32x4*)cs, c1 = *(const f32x4*)(cs + 4), s0 = *(const f32x4*)sn, s1 = *(const f32x4*)(sn + 4);
    const float c[8] = {c0[0], c0[1], c0[2], c0[3], c1[0], c1[1], c1[2], c1[3]}, s[8] = {s0[0], s0[1], s0[2], s0[3], s1[0], s1[1], s1[2], s1[3]};
#pragma unroll
    for (int j = 0; j < 8; ++j) { r1[j] = (a[j] * c[j] - b[j] * s[j]) * scale; r2[j] = (a[j] * s[j] + b[j] * c[j]) * scale; }
}
constexpr int PT = 272;

DI void ret_local_unit(const Frame& F_, const Args& a, int u) {
    Frame F = F_; { int tz = F_.tid; asm volatile("" : "+v"(tz)); F.tid = tz; F.lane = tz & 63; }
    const int b = u >> 8, c = (u >> 3) & 31, h = u & 7;
    const bf16_t* P = (const bf16_t*)(F.ws + WS_PROJ) + (size_t)(b * SEQ + c * 128) * PLD;
    const float* COS = (const float*)(F.ws + WS_COS); const float* SIN = (const float*)(F.ws + WS_SIN);
    ldsp KT = F.lds, VT = F.lds + 34816;
    const float lg = ret_loggamma(h);
#pragma unroll
    for (int i = 0; i < 2; ++i) { const int item = F.tid + 512 * i, s = item >> 3, d0 = (item & 7) * 8, pos = c * 128 + s;
        float r1[8], r2[8]; rot8(P + (size_t)s * PLD + P0_K + h * 128 + d0, COS + pos * 64 + d0, SIN + pos * 64 + d0, 0.08838834764831845f * __expf(lg * (float)(127 - s)), r1, r2);
#pragma unroll
        for (int j = 0; j < 8; ++j) { *(LAS bf16_t*)(KT + (d0 + j) * PT + s * 2) = f2bf(r1[j]); *(LAS bf16_t*)(KT + (d0 + 64 + j) * PT + s * 2) = f2bf(r2[j]); } }
#pragma unroll
    for (int i = 0; i < 4; ++i) { const int item = F.tid + 512 * i, s = item >> 4, e0 = (item & 15) * 8;
        const u32x4 v = *(const u32x4*)(P + (size_t)s * PLD + P0_V + h * 128 + e0);
        const unsigned w[4] = {v.x, v.y, v.z, v.w};
#pragma unroll
        for (int j = 0; j < 8; ++j) *(LAS bf16_t*)(VT + (e0 + j) * PT + s * 2) = (bf16_t)((j & 1) ? (w[j >> 1] >> 16) : (w[j >> 1] & 0xffffu)); }
    __syncthreads();
    const int fr = F.lane & 15, fq = F.lane >> 4;
    f32x4 acc[8]; zero_acc(acc);
    mma16<8, 4>(acc, VT + (16 * F.wave) * PT, PT, KT, PT, fr, fq);
    float* dst = (float*)(F.ws + WS_RET_DS) + ((size_t)((b * 8 + h) * 32 + c) * 128 + 16 * F.wave + fr) * 128 + fq * 4;
#pragma unroll
    for (int nt = 0; nt < 8; ++nt) *(f32x4*)(dst + nt * 16) = acc[nt];
    __syncthreads();
}

DI void ssd_local_unit(const Frame& F_, const Args& a, int u) {
    Frame F = F_; { int tz = F_.tid; asm volatile("" : "+v"(tz)); F.tid = tz; F.lane = tz & 63; }
    const int b = u >> 7, c = (u >> 2) & 31, g = (u >> 1) & 1, hh = u & 1, hd0 = g * 8 + hh * 4;
    const bf16_t* P = (const bf16_t*)(F.ws + WS_PROJ) + (size_t)(b * SEQ + c * 128) * PLD;
    ldsp XT = F.lds, BT = F.lds + 69632; LAS float* dtv = (LAS float*)(F.lds + 104448); LAS float* acum = (LAS float*)(F.lds + 106496);
    { const int s = F.tid >> 2, r = F.tid & 3; dtv[F.tid] = softplus_(bf2f(P[(size_t)s * PLD + P0_DT + hd0 + r]) + a.in[I_SSD_DTB][hd0 + r]); }
    __syncthreads();
    if (F.wave < 4) { const int r = F.wave; const float A = -__expf(a.in[I_SSD_ALOG][hd0 + r]);
        float c0, c1; wscan_sum(dtv[(2 * F.lane) * 4 + r] * A, dtv[(2 * F.lane + 1) * 4 + r] * A, F.lane, c0, c1);
        acum[(2 * F.lane) * 4 + r] = c0; acum[(2 * F.lane + 1) * 4 + r] = c1;
        if (F.lane == 63) ((float*)(F.ws + WS_SMALL))[(b * 32 + c) * 16 + hd0 + r] = c1; }
    __syncthreads();
    const float* cw = a.in[I_SSD_CONVW]; const float* cb = a.in[I_SSD_CONVB];
#pragma unroll 2
    for (int i = 0; i < 8; ++i) { const int item = F.tid + 512 * i, s = item >> 5, ch = item & 31, r = ch >> 3, p0 = (ch & 7) * 8, xc = (hd0 + r) * 64 + p0;
        float y[8]; conv8(P + (size_t)s * PLD + P0_XBC + xc, c * 128 + s, cw + xc, 1536, cb + xc, y);
        const float sc = dtv[s * 4 + r] * __expf(acum[127 * 4 + r] - acum[s * 4 + r]);
#pragma unroll
        for (int j = 0; j < 8; ++j) *(LAS bf16_t*)(XT + (r * 64 + p0 + j) * PT + s * 2) = f2bf(silu_(y[j]) * sc); }
#pragma unroll 2
    for (int i = 0; i < 4; ++i) { const int item = F.tid + 512 * i, s = item >> 4, n0 = (item & 15) * 8, xc = 1024 + g * 128 + n0;
        float y[8]; conv8(P + (size_t)s * PLD + P0_XBC + xc, c * 128 + s, cw + xc, 1536, cb + xc, y);
#pragma unroll
        for (int j = 0; j < 8; ++j) *(LAS bf16_t*)(BT + (n0 + j) * PT + s * 2) = f2bf(silu_(y[j])); }
    __syncthreads();
    const int fr = F.lane & 15, fq = F.lane >> 4;
#pragma unroll
    for (int rt = 0; rt < 2; ++rt) {
        f32x4 acc[8]; zero_acc(acc);
        mma16<8, 4>(acc, XT + (32 * F.wave + 16 * rt) * PT, PT, BT, PT, fr, fq);
        const int rr = 32 * F.wave + 16 * rt + fr, r = rr >> 6, p = rr & 63;
        float* dst = (float*)(F.ws + WS_SSD_DS) + (((size_t)(b * 32 + c) * 16 + hd0 + r) * 64 + p) * 128 + fq * 4;
#pragma unroll
        for (int nt = 0; nt < 8; ++nt) *(f32x4*)(dst + nt * 16) = acc[nt];
    }
    __syncthreads();
}

DI void phase_even_scan(const Frame& F, const Args& a) {
    const int gt = F.bx * 512 + F.tid, NT_ = F.G * 512;
    for (int i = gt; i < 131072; i += NT_) {
        const int bh = i >> 12, v = i & 4095; const float g128 = __expf(ret_loggamma(bh & 7) * 128.f);
        const float* src = (const float*)(F.ws + WS_RET_DS) + (size_t)bh * 32 * 16384 + v * 4; bf16_t* dst = (bf16_t*)(F.ws + WS_RET_S) + (size_t)bh * 32 * 16384 + v * 4;
        f32x4 run = (f32x4){0.f, 0.f, 0.f, 0.f};
#pragma unroll 8
        for (int c = 0; c < 32; ++c) { const f32x4 x = *(const f32x4*)(src + (size_t)c * 16384);
            u32x2 w; w.x = pk2(run[0], run[1]); w.y = pk2(run[2], run[3]); *(u32x2*)(dst + (size_t)c * 16384) = w; run = run * g128 + x; }
    }
    const float* AEND = (const float*)(F.ws + WS_SMALL);
    for (int i = gt; i < 131072; i += NT_) {
        const int bhd = i >> 11, v = i & 2047, b = bhd >> 4, hd = bhd & 15;
        const float* src = (const float*)(F.ws + WS_SSD_DS) + ((size_t)(b * 32) * 16 + hd) * 8192 + v * 4; bf16_t* dst = (bf16_t*)(F.ws + WS_SSD_S) + ((size_t)(b * 32) * 16 + hd) * 8192 + v * 4;
        f32x4 run = (f32x4){0.f, 0.f, 0.f, 0.f};
#pragma unroll 8
        for (int c = 0; c < 32; ++c) { const f32x4 x = *(const f32x4*)(src + (size_t)c * 16 * 8192); const float dec = __expf(AEND[(b * 32 + c) * 16 + hd]);
            u32x2 w; w.x = pk2(run[0], run[1]); w.y = pk2(run[2], run[3]); *(u32x2*)(dst + (size_t)c * 16 * 8192) = w; run = run * dec + x; }
    }
}

DI void ret_out_unit(const Frame& F_, const Args& a, int u) {
    Frame F = F_; { int tz = F_.tid; asm volatile("" : "+v"(tz)); F.tid = tz; F.lane = tz & 63; }
    const int b = u >> 8, c = (u >> 3) & 31, h = u & 7, w = F.wave;
    const size_t row0 = (size_t)(b * SEQ + c * 128);
    const bf16_t* P = (const bf16_t*)(F.ws + WS_PROJ) + row0 * PLD;
    const float* COS = (const float*)(F.ws + WS_COS); const float* SIN = (const float*)(F.ws + WS_SIN);
    ldsp Q = F.lds, KX = F.lds + 34816, VT = F.lds + 69632, ST = F.lds + 104448;
    const float lg = ret_loggamma(h);
#pragma unroll
    for (int i = 0; i < 2; ++i) { const int item = F.tid + 512 * i, s = item >> 3, d0 = (item & 7) * 8, pos = c * 128 + s;
        float r1[8], r2[8];
        rot8(P + (size_t)s * PLD + h * 128 + d0, COS + pos * 64 + d0, SIN + pos * 64 + d0, 1.f, r1, r2);
        *(LAS u32x4*)(Q + s * PT + d0 * 2) = pack8(r1); *(LAS u32x4*)(Q + s * PT + (d0 + 64) * 2) = pack8(r2);
        rot8(P + (size_t)s * PLD + P0_K + h * 128 + d0, COS + pos * 64 + d0, SIN + pos * 64 + d0, 0.08838834764831845f, r1, r2);
        *(LAS u32x4*)(KX + s * PT + d0 * 2) = pack8(r1); *(LAS u32x4*)(KX + s * PT + (d0 + 64) * 2) = pack8(r2); }
    const bf16_t* Sg = (const bf16_t*)(F.ws + WS_RET_S) + (size_t)((b * 8 + h) * 32 + c) * 16384;
#pragma unroll
    for (int i = 0; i < 4; ++i) { const int item = F.tid + 512 * i, s = item >> 4, e0 = (item & 15) * 8;
        const u32x4 v = *(const u32x4*)(P + (size_t)s * PLD + P0_V + h * 128 + e0);
        const unsigned ww[4] = {v.x, v.y, v.z, v.w};
#pragma unroll
        for (int j = 0; j < 8; ++j) *(LAS bf16_t*)(VT + (e0 + j) * PT + s * 2) = (bf16_t)((j & 1) ? (ww[j >> 1] >> 16) : (ww[j >> 1] & 0xffffu));
        *(LAS u32x4*)(ST + s * PT + e0 * 2) = *(const u32x4*)(Sg + (size_t)s * 128 + e0); }
    __syncthreads();
    const int fr = F.lane & 15, fq = F.lane >> 4, l = 16 * w + fr;
    f32x4 as[8]; zero_acc(as);
    mma16<8, 4>(as, Q + (16 * w) * PT, PT, KX, PT, fr, fq, w + 1, 4);
    f32x4 ao[8]; zero_acc(ao);
    mma16<8, 4>(ao, Q + (16 * w) * PT, PT, ST, PT, fr, fq);
    { const float qd = __expf(lg * (float)(l + 1));
#pragma unroll
      for (int nt = 0; nt < 8; ++nt) ao[nt] = ao[nt] * qd; }
    __syncthreads();
    ldsp Pm = KX;
#pragma unroll
    for (int nt = 0; nt < 8; ++nt) if (nt <= (w | 1)) { float pv[4];
#pragma unroll
        for (int j = 0; j < 4; ++j) { const int s = nt * 16 + fq * 4 + j; pv[j] = (nt <= w && s <= l) ? as[nt][j] * __expf(lg * (float)(l - s)) : 0.f; }
        u32x2 pw; pw.x = pk2(pv[0], pv[1]); pw.y = pk2(pv[2], pv[3]); *(LAS u32x2*)(Pm + l * PT + (nt * 16 + fq * 4) * 2) = pw; }
    __syncthreads();
    mma16<8, 4>(ao, Pm + (16 * w) * PT, PT, VT, PT, fr, fq, 8, (w >> 1) + 1);
    float sm = 0.f;
#pragma unroll
    for (int nt = 0; nt < 8; ++nt) sm += ao[nt][0] + ao[nt][1] + ao[nt][2] + ao[nt][3];
    sm += __shfl_xor(sm, 16); sm += __shfl_xor(sm, 32);
    const float mean = sm * (1.f / 128.f); float vs = 0.f;
#pragma unroll
    for (int nt = 0; nt < 8; ++nt)
#pragma unroll
        for (int j = 0; j < 4; ++j) { const float d = ao[nt][j] - mean; vs += d * d; }
    vs += __shfl_xor(vs, 16); vs += __shfl_xor(vs, 32);
    const float rstd = rsqrtf(vs * (1.f / 128.f) + EPS);
    const bf16_t* grow = P + (size_t)l * PLD + P0_G + h * 128; const float* ng = a.in[I_RET_NORM] + h * 128;
    bf16_t* orow = (bf16_t*)(F.ws + WS_MIX) + (row0 + l) * 2048 + h * 128;
#pragma unroll
    for (int nt = 0; nt < 8; ++nt) { const int e = nt * 16 + fq * 4; const u32x2 gv = *(const u32x2*)(grow + e); const f32x4 nn = *(const f32x4*)(ng + e);
        const float g0 = bflo(gv.x), g1 = bfhi(gv.x), g2 = bflo(gv.y), g3 = bfhi(gv.y);
        u32x2 o; o.x = pk2((ao[nt][0] - mean) * rstd * nn[0] * silu_(g0), (ao[nt][1] - mean) * rstd * nn[1] * silu_(g1));
        o.y = pk2((ao[nt][2] - mean) * rstd * nn[2] * silu_(g2), (ao[nt][3] - mean) * rstd * nn[3] * silu_(g3));
        *(u32x2*)(orow + e) = o; }
    __syncthreads();
}

DI void ssd_out_unit(const Frame& F_, const Args& a, int u) {
    Frame F = F_; { int tz = F_.tid; asm volatile("" : "+v"(tz)); F.tid = tz; F.lane = tz & 63; }
    const int b = u >> 6, c = (u >> 1) & 31, g = u & 1, w = F.wave;
    const size_t row0 = (size_t)(b * SEQ + c * 128);
    const bf16_t* P = (const bf16_t*)(F.ws + WS_PROJ) + row0 * PLD;
    ldsp CM = F.lds, BM = F.lds + 34816, XT = F.lds + 34816, SS = F.lds + 52224, Pm = F.lds + 69632, XS = F.lds + 104448;
    LAS float* dtv = (LAS float*)(F.lds + 122880); LAS float* acum = (LAS float*)(F.lds + 126976);
    constexpr int PXS = 144;
#pragma unroll
    for (int i = 0; i < 2; ++i) { const int idx = F.tid + 512 * i, s = idx >> 3, r = idx & 7; dtv[idx] = softplus_(bf2f(P[(size_t)s * PLD + P0_DT + g * 8 + r]) + a.in[I_SSD_DTB][g * 8 + r]); }
    __syncthreads();
    { const int r = w; const float A = -__expf(a.in[I_SSD_ALOG][g * 8 + r]);
      float c0, c1; wscan_sum(dtv[(2 * F.lane) * 8 + r] * A, dtv[(2 * F.lane + 1) * 8 + r] * A, F.lane, c0, c1);
      acum[(2 * F.lane) * 8 + r] = c0; acum[(2 * F.lane + 1) * 8 + r] = c1; }
    const float* cw = a.in[I_SSD_CONVW]; const float* cb = a.in[I_SSD_CONVB];
#pragma unroll 2
    for (int i = 0; i < 4; ++i) { const int item = F.tid + 512 * i, s = item >> 4, n0 = (item & 15) * 8;
        float y[8];
        { const int xc = 1280 + g * 128 + n0; conv8(P + (size_t)s * PLD + P0_XBC + xc, c * 128 + s, cw + xc, 1536, cb + xc, y);
#pragma unroll
          for (int j = 0; j < 8; ++j) y[j] = silu_(y[j]);
          *(LAS u32x4*)(CM + s * PT + n0 * 2) = pack8(y); }
        { const int xc = 1024 + g * 128 + n0; conv8(P + (size_t)s * PLD + P0_XBC + xc, c * 128 + s, cw + xc, 1536, cb + xc, y);
#pragma unroll
          for (int j = 0; j < 8; ++j) y[j] = silu_(y[j]);
          *(LAS u32x4*)(BM + s * PT + n0 * 2) = pack8(y); } }
    __syncthreads();
    const int fr = F.lane & 15, fq = F.lane >> 4, l = 16 * w + fr;
    f32x4 cbm[8]; zero_acc(cbm);
    mma16<8, 4>(cbm, CM + (16 * w) * PT, PT, BM, PT, fr, fq, w + 1, 4);
    __syncthreads();
    float ssq = 0.f;
    const bf16_t* Sg = (const bf16_t*)(F.ws + WS_SSD_S) + ((size_t)(b * 32 + c) * 16 + g * 8) * 8192;
    bf16_t* orow = (bf16_t*)(F.ws + WS_MIX) + (row0 + l) * 2048 + 1024 + g * 512; const float* ng = a.in[I_SSD_NORM] + g * 512;
#pragma unroll 1
    for (int r = 0; r < 8; ++r) {
        const int hd = g * 8 + r;
#pragma unroll
        for (int i = 0; i < 2; ++i) { const int item = F.tid + 512 * i, s = item >> 3, p0 = (item & 7) * 8, xc = hd * 64 + p0;
            float y[8]; conv8(P + (size_t)s * PLD + P0_XBC + xc, c * 128 + s, cw + xc, 1536, cb + xc, y);
            const float dt = dtv[s * 8 + r];
#pragma unroll
            for (int j = 0; j < 8; ++j) { y[j] = silu_(y[j]); *(LAS bf16_t*)(XT + (p0 + j) * PT + s * 2) = f2bf(y[j] * dt); }
            *(LAS u32x4*)(XS + s * PXS + p0 * 2) = pack8(y);
            const int p = item >> 4, n0 = (item & 15) * 8;
            *(LAS u32x4*)(SS + p * PT + n0 * 2) = *(const u32x4*)(Sg + (size_t)r * 8192 + p * 128 + n0); }
        __syncthreads();
        f32x4 acc[4]; zero_acc(acc);
        mma16<4, 4>(acc, CM + (16 * w) * PT, PT, SS, PT, fr, fq);
        const float al = acum[l * 8 + r];
        { const float ea = __expf(al);
#pragma unroll
          for (int nt = 0; nt < 4; ++nt) acc[nt] = acc[nt] * ea; }
#pragma unroll
        for (int nt = 0; nt < 8; ++nt) if (nt <= (w | 1)) { float pv[4];
#pragma unroll
            for (int j = 0; j < 4; ++j) { const int s = nt * 16 + fq * 4 + j; pv[j] = (nt <= w && s <= l) ? cbm[nt][j] * __expf(al - acum[s * 8 + r]) : 0.f; }
            u32x2 pw; pw.x = pk2(pv[0], pv[1]); pw.y = pk2(pv[2], pv[3]); *(LAS u32x2*)(Pm + l * PT + (nt * 16 + fq * 4) * 2) = pw; }
        __syncthreads();
        mma16<4, 4>(acc, Pm + (16 * w) * PT, PT, XT, PT, fr, fq, 4, (w >> 1) + 1);
        const float dsk = a.in[I_SSD_D][hd];
#pragma unroll
        for (int nt = 0; nt < 4; ++nt) { const int p = nt * 16 + fq * 4;
            const u32x2 xv = *(const LAS u32x2*)(XS + l * PXS + p * 2); const u32x2 zv = *(const u32x2*)(P + (size_t)l * PLD + P0_Z + hd * 64 + p);
            const float y0 = (acc[nt][0] + dsk * bflo(xv.x)) * silu_(bflo(zv.x)), y1 = (acc[nt][1] + dsk * bfhi(xv.x)) * silu_(bfhi(zv.x));
            const float y2 = (acc[nt][2] + dsk * bflo(xv.y)) * silu_(bflo(zv.y)), y3 = (acc[nt][3] + dsk * bfhi(xv.y)) * silu_(bfhi(zv.y));
            ssq += y0 * y0 + y1 * y1 + y2 * y2 + y3 * y3;
            u32x2 o; o.x = pk2(y0, y1); o.y = pk2(y2, y3); *(u32x2*)(orow + r * 64 + p) = o; }
        __syncthreads();
    }
    ssq += __shfl_xor(ssq, 16); ssq += __shfl_xor(ssq, 32);
    const float rstd = rsqrtf(ssq * (1.f / 512.f) + EPS);
    asm volatile("s_waitcnt vmcnt(0)" ::: "memory");
#pragma unroll 1
    for (int r = 0; r < 8; ++r)
#pragma unroll
        for (int nt = 0; nt < 4; ++nt) { const int p = r * 64 + nt * 16 + fq * 4; const f32x4 nn = *(const f32x4*)(ng + p); const u32x2 yv = *(const u32x2*)(orow + p);
            u32x2 o; o.x = pk2(bflo(yv.x) * rstd * nn[0], bfhi(yv.x) * rstd * nn[1]); o.y = pk2(bflo(yv.y) * rstd * nn[2], bfhi(yv.y) * rstd * nn[3]);
            *(u32x2*)(orow + p) = o; }
    __syncthreads();
}

DI void phase_router(const Frame& F, const Args& a, int layer) {
    const float* H = a.out; const float* RT = (const float*)(F.ws + WS_RT) + (size_t)layer * 48 * 2048;
    unsigned* cnt = (unsigned*)(F.ws + WS_CTL) + CW_CNT + layer * 32 * 64;
    int* LIST = (int*)(F.ws + WS_LIST); int* SLOT = (int*)(F.ws + WS_SLOT); bf16_t* XN = (bf16_t*)(F.ws + WS_XN);
    LAS float* lg = (LAS float*)(F.lds + F.wave * 4096); LAS float* rs = lg + 16 * 48;
    const int fr = F.lane & 15, fq = F.lane >> 4;
    for (int q = F.wave; q * F.G + F.bx < 1024; q += 8) {
        const int row0 = (q * F.G + F.bx) * 16;
        f32x4 acc[3]; zero_acc(acc); float ss = 0.f;
        const float* ap = H + (size_t)(row0 + fr) * 2048 + 4 * fq; const float* bp = RT + (size_t)fr * 2048 + 4 * fq;
#pragma unroll 4
        for (int s = 0; s < 128; ++s) {
            const f32x4 av = *(const f32x4*)(ap + 16 * s); ss += av[0] * av[0] + av[1] * av[1] + av[2] * av[2] + av[3] * av[3];
#pragma unroll
            for (int ct = 0; ct < 3; ++ct) { const f32x4 bv = *(const f32x4*)(bp + (size_t)ct * 16 * 2048 + 16 * s);
#pragma unroll
                for (int j = 0; j < 4; ++j) acc[ct] = __builtin_amdgcn_mfma_f32_16x16x4f32(av[j], bv[j], acc[ct], 0, 0, 0); }
        }
        ss += __shfl_xor(ss, 16); ss += __shfl_xor(ss, 32);
        const float rstd = rsqrtf(ss * (1.f / D) + EPS);
        if (fq == 0) rs[fr] = rstd;
#pragma unroll
        for (int ct = 0; ct < 3; ++ct)
#pragma unroll
            for (int j = 0; j < 4; ++j) lg[(4 * fq + j) * 48 + ct * 16 + fr] = acc[ct][j];
        LDS_WAIT();
        if (F.lane < 16) {
            const int r = F.lane, tok = row0 + r; const float rr = rs[r];
            float gl[4]; float mx = -INFINITY; int gi = 0;
#pragma unroll
            for (int j = 0; j < 4; ++j) { gl[j] = lg[r * 48 + j] * rr + a.in[I_MOE_RGB][layer * 4 + j]; if (gl[j] > mx) { mx = gl[j]; gi = j; } }
            float se = 0.f;
#pragma unroll
            for (int j = 0; j < 4; ++j) se += __expf(gl[j] - mx);
            const float gw = 1.f / se;
            float v1 = -INFINITY, v2 = -INFINITY; int i1 = 0, i2 = 0;
            for (int k = 0; k < 8; ++k) { const float v = lg[r * 48 + 4 + gi * 8 + k] * rr + a.in[I_MOE_REB][layer * 32 + gi * 8 + k];
                if (v > v1) { v2 = v1; i2 = i1; v1 = v; i1 = k; } else if (v > v2) { v2 = v; i2 = k; } }
            const float e2 = __expf(v2 - v1), w1 = gw / (1.f + e2), w2 = gw * e2 / (1.f + e2);
            const int e0 = gi * 8 + i1, e1 = gi * 8 + i2;
            const int r0 = (int)__hip_atomic_fetch_add(cnt + e0 * 64, 1u, __ATOMIC_RELAXED, __HIP_MEMORY_SCOPE_AGENT);
            const int r1 = (int)__hip_atomic_fetch_add(cnt + e1 * 64, 1u, __ATOMIC_RELAXED, __HIP_MEMORY_SCOPE_AGENT);
            LIST[e0 * T + r0] = tok; LIST[e1 * T + r1] = tok;
            int* sp = SLOT + (size_t)tok * 8; sp[0] = e0; sp[1] = r0; sp[2] = __float_as_int(w1); sp[3] = e1; sp[4] = r1; sp[5] = __float_as_int(w2);
        }
        const float* gn = a.in[I_MOE_NORM] + layer * 2048;
        for (int r = 0; r < 16; ++r) { const float rr = rs[r]; const float* xr = H + (size_t)(row0 + r) * 2048; bf16_t* o = XN + (size_t)(row0 + r) * 2048;
#pragma unroll
            for (int j = 0; j < 8; ++j) { const f32x4 v = *(const f32x4*)(xr + (F.lane + 64 * j) * 4), gg = *(const f32x4*)(gn + (F.lane + 64 * j) * 4);
                u32x2 wv; wv.x = pk2(v[0] * rr * gg[0], v[1] * rr * gg[1]); wv.y = pk2(v[2] * rr * gg[2], v[3] * rr * gg[3]); *(u32x2*)(o + (F.lane + 64 * j) * 4) = wv; } }
        LDS_WAIT();
    }
}
DI int moe_tables(const Frame& F, int layer) {
    const unsigned* cnt = (const unsigned*)(F.ws + WS_CTL) + CW_CNT + layer * 32 * 64;
    LAS int* tile_e = (LAS int*)(F.lds + LDS_TAB); LAS int* tstart = tile_e + 192; LAS int* ecnt = tile_e + 224;
    if (F.tid == 0) { int acc = 0;
        for (int e = 0; e < 32; ++e) { const int n = (int)__hip_atomic_load(cnt + e * 64, __ATOMIC_RELAXED, __HIP_MEMORY_SCOPE_AGENT); const int mt = (n + 255) >> 8; tstart[e] = acc; ecnt[e] = n;
            for (int k = 0; k < mt; ++k) tile_e[acc + k] = e; acc += mt; }
        tile_e[191] = acc; }
    __syncthreads();
    return tile_e[191];
}
DI void phase_moe_gateup(const Frame& F, const Args& a, int layer) {
    const int ntiles = moe_tables(F, layer);
    LAS int* tile_e = (LAS int*)(F.lds + LDS_TAB); LAS int* tstart = tile_e + 192; LAS int* ecnt = tile_e + 224; LAS int* gtab = (LAS int*)(F.lds + LDS_TAB + 1024);
    const int* LIST = (const int*)(F.ws + WS_LIST);
    for (int i = 0; i < 4; ++i) { const int L = i * F.G + F.bx; if (L >= ntiles * 4) break;
        const int gm = L >> 2, e = tile_e[gm], rbase = (gm - tstart[e]) * 256;
        if (F.tid < 256) { const int rank = rbase + F.tid; gtab[i * 256 + F.tid] = (rank < ecnt[e]) ? LIST[e * T + rank] : 0; } }
    __syncthreads();
    pg8::MoeGU S; S.XN = (const char*)(F.ws + WS_XN); S.W = (const char*)(F.ws + WS_WGU); S.tile_e = tile_e; S.gtab = gtab; S.nunits = ntiles * 4; S.G = F.G; S.c = F.bx;
    pg8::EpiGateUp E{(bf16_t*)(F.ws + WS_HID), 512};
    pg8::gemm_phase<pg8::EpiGateUp, pg8::MoeGU, true>(F.lds, 2048, 2048, 2048, S, E);
}
DI void phase_moe_down(const Frame& F, const Args& a, int layer) {
    const int ntiles = moe_tables(F, layer);
    LAS int* tile_e = (LAS int*)(F.lds + LDS_TAB);
    pg8::MoeDown S; S.HID = (const char*)(F.ws + WS_HID); S.W = (const char*)(F.ws + WS_WD); S.tile_e = tile_e; S.nunits = ntiles * 8; S.G = F.G; S.c = F.bx;
    pg8::EpiBf16 E{(bf16_t*)(F.ws + WS_Y), 2048};
    pg8::gemm_phase<pg8::EpiBf16, pg8::MoeDown, false>(F.lds, 512, 512, 512, S, E);
}
template <bool LAST>
DI void phase_combine(const Frame& F, const Args& a, int layer) {
    (void)moe_tables(F, layer);
    LAS int* tstart = (LAS int*)(F.lds + LDS_TAB) + 192;
    const int* SLOT = (const int*)(F.ws + WS_SLOT); const bf16_t* Y = (const bf16_t*)(F.ws + WS_Y); float* H = a.out; bf16_t* XN = (bf16_t*)(F.ws + WS_XN);
    const float* gn = LAST ? a.in[I_FINAL_NORM] : a.in[I_ODD_NORM];
    const int gw = F.bx * 8 + F.wave, NGW = F.G * 8;
    for (int m = gw; m < T; m += NGW) {
        const int* sp = SLOT + (size_t)m * 8; const int e0 = sp[0], r0 = sp[1], e1 = sp[3], r1 = sp[4]; const float w0 = __int_as_float(sp[2]), w1 = __int_as_float(sp[5]);
        const bf16_t* y0 = Y + (size_t)(tstart[e0] * 256 + r0) * 2048; const bf16_t* y1 = Y + (size_t)(tstart[e1] * 256 + r1) * 2048;
        float* hr = H + (size_t)m * 2048;
        f32x4 v[8]; float ss = 0.f;
#pragma unroll
        for (int j = 0; j < 8; ++j) { const int o = (F.lane + 64 * j) * 4; const f32x4 h = *(const f32x4*)(hr + o); const u32x2 p0 = *(const u32x2*)(y0 + o), p1 = *(const u32x2*)(y1 + o);
            v[j][0] = h[0] + w0 * bflo(p0.x) + w1 * bflo(p1.x); v[j][1] = h[1] + w0 * bfhi(p0.x) + w1 * bfhi(p1.x);
            v[j][2] = h[2] + w0 * bflo(p0.y) + w1 * bflo(p1.y); v[j][3] = h[3] + w0 * bfhi(p0.y) + w1 * bfhi(p1.y);
            ss += v[j][0] * v[j][0] + v[j][1] * v[j][1] + v[j][2] * v[j][2] + v[j][3] * v[j][3]; }
        const float rstd = rsqrtf(wsum(ss) * (1.f / D) + EPS);
#pragma unroll
        for (int j = 0; j < 8; ++j) { const int o = (F.lane + 64 * j) * 4; const f32x4 gg = *(const f32x4*)(gn + o);
            if (LAST) { *(f32x4*)(hr + o) = (f32x4){v[j][0] * rstd * gg[0], v[j][1] * rstd * gg[1], v[j][2] * rstd * gg[2], v[j][3] * rstd * gg[3]}; }
            else { *(f32x4*)(hr + o) = v[j]; u32x2 wv; wv.x = pk2(v[j][0] * rstd * gg[0], v[j][1] * rstd * gg[1]); wv.y = pk2(v[j][2] * rstd * gg[2], v[j][3] * rstd * gg[3]); *(u32x2*)(XN + (size_t)m * 2048 + o) = wv; } }
    }
}

DI void mlstm_local_unit(const Frame& F_, const Args& a, int u) {
    Frame F = F_; { int tz = F_.tid; asm volatile("" : "+v"(tz)); F.tid = tz; F.lane = tz & 63; }
    const int et = u % 3, t3 = u / 3, h = t3 & 3, c = (t3 >> 2) & 31, b = t3 >> 7, bh = b * 4 + h;
    const bf16_t* P = (const bf16_t*)(F.ws + WS_PROJ) + (size_t)(b * SEQ + c * 128) * PLD;
    ldsp KT = F.lds, VT = F.lds + 104448; LAS float* wv = (LAS float*)(F.lds + 139264);
    if (F.wave == 0) {
        const int s0 = 2 * F.lane, s1 = s0 + 1; const float fb = a.in[I_ML_FB][h], ib = a.in[I_ML_IB][h];
        const float lf0 = logsigmoid_(bf2f(P[(size_t)s0 * PLD + P1_F + h]) + fb), lf1 = logsigmoid_(bf2f(P[(size_t)s1 * PLD + P1_F + h]) + fb);
        const float ig0 = bf2f(P[(size_t)s0 * PLD + P1_I + h]) + ib, ig1 = bf2f(P[(size_t)s1 * PLD + P1_I + h]) + ib;
        float bc0, bc1; wscan_sum(lf0, lf1, F.lane, bc0, bc1);
        const float blast = __shfl(bc1, 63);
        const float wl0 = blast - bc0 + ig0, wl1 = blast - bc1 + ig1; const float mloc = wmax(fmaxf(wl0, wl1));
        wv[s0] = __expf(wl0 - mloc); wv[s1] = __expf(wl1 - mloc);
        if (et == 0 && F.lane == 0) { float* MS = (float*)(F.ws + WS_SMALL + 16384); MS[(bh * 32 + c) * 2] = blast; MS[(bh * 32 + c) * 2 + 1] = mloc; }
    }
    __syncthreads();
    const float* cw = a.in[I_ML_CONVW]; const float* cb = a.in[I_ML_CONVB];
#pragma unroll 2
    for (int i = 0; i < 12; ++i) { const int item = F.tid + 512 * i, s = item / 48, d0 = (item % 48) * 8, xc = P1_K + h * 384 + d0;
        float y[8]; conv8(P + (size_t)s * PLD + xc, c * 128 + s, cw + xc, 3072, cb + xc, y);
        const float ws_ = wv[s];
#pragma unroll
        for (int j = 0; j < 8; ++j) *(LAS bf16_t*)(KT + (d0 + j) * PT + s * 2) = f2bf(silu_(y[j]) * ws_); }
#pragma unroll
    for (int i = 0; i < 4; ++i) { const int item = F.tid + 512 * i, s = item >> 4, e0 = (item & 15) * 8;
        const u32x4 v = *(const u32x4*)(P + (size_t)s * PLD + P1_V + h * 384 + et * 128 + e0);
        const unsigned ww[4] = {v.x, v.y, v.z, v.w};
#pragma unroll
        for (int j = 0; j < 8; ++j) *(LAS bf16_t*)(VT + (e0 + j) * PT + s * 2) = (bf16_t)((j & 1) ? (ww[j >> 1] >> 16) : (ww[j >> 1] & 0xffffu)); }
    __syncthreads();
    const int fr = F.lane & 15, fq = F.lane >> 4;
    f32x4 acc[24]; zero_acc(acc);
    mma16<24, 4>(acc, VT + (16 * F.wave) * PT, PT, KT, PT, fr, fq);
#if DBG == 35
    { unsigned fl = 0u;
      for (int i = F.tid; i < 128 * 128; i += 512) { const float v = bf2f(*(LAS bf16_t*)(VT + (i >> 7) * PT + (i & 127) * 2)); if (!(v - v == 0.f)) fl |= 1u; if (fabsf(v) > 1e4f) fl |= 16u; }
      for (int i = F.tid; i < 384 * 128; i += 512) { const float v = bf2f(*(LAS bf16_t*)(KT + (i >> 7) * PT + (i & 127) * 2)); if (!(v - v == 0.f)) fl |= 2u; if (fabsf(v) > 1e4f) fl |= 32u; }
#pragma unroll
      for (int nt = 0; nt < 24; ++nt) { const f32x4 q = acc[nt] - acc[nt]; if (!(q[0] == 0.f && q[1] == 0.f && q[2] == 0.f && q[3] == 0.f)) fl |= 4u; }
      if (F.tid < 128) { const float v = wv[F.tid]; if (!(v >= 0.f && v <= 1.0001f)) fl |= 8u; }
      if (fl) atomicOr((unsigned*)(F.ws + WS_SMALL + 65536 + 4), fl); }
#endif
    bf16_t* dst = (bf16_t*)(F.ws + WS_MC) + ((size_t)(bh * 32 + c) * 384 + et * 128 + 16 * F.wave + fr) * 384 + fq * 4;
#pragma unroll
    for (int nt = 0; nt < 24; ++nt) { u32x2 o; o.x = pk2(acc[nt][0], acc[nt][1]); o.y = pk2(acc[nt][2], acc[nt][3]); *(u32x2*)(dst + nt * 16) = o; }
    if (et == 0 && F.tid < 384) { float sm = 0.f;
#pragma unroll
        for (int k = 0; k < 16; ++k) { float x[8]; unpack8(*(const LAS u32x4*)(KT + F.tid * PT + k * 16), x); sm += ((x[0] + x[1]) + (x[2] + x[3])) + ((x[4] + x[5]) + (x[6] + x[7])); }
        ((float*)(F.ws + WS_MN))[(size_t)(bh * 32 + c) * 384 + F.tid] = sm; }
    __syncthreads();
}

DI void s5_local_unit(const Frame& F_, const Args& a, int u) {
    Frame F = F_; { int tz = F_.tid; asm volatile("" : "+v"(tz)); F.tid = tz; F.lane = tz & 63; }
    const int b = u >> 7, c = (u >> 2) & 31, g8 = u & 3;
    const bf16_t* P = (const bf16_t*)(F.ws + WS_PROJ) + (size_t)(b * SEQ + c * 128) * PLD + P1_U + g8 * 128;
    LAS float* U = (LAS float*)F.lds;
#pragma unroll
    for (int i = 0; i < 4; ++i) { const int item = F.tid + 512 * i, t = item >> 4, ch = (item & 15) * 8; float x[8]; unpack8(*(const u32x4*)(P + (size_t)t * PLD + ch), x);
        *(LAS f32x4*)(U + t * 128 + ch) = (f32x4){x[0], x[1], x[2], x[3]}; *(LAS f32x4*)(U + t * 128 + ch + 4) = (f32x4){x[4], x[5], x[6], x[7]}; }
    __syncthreads();
    const int g = g8 * 8 + F.wave, gn = g * 64 + F.lane;
    const float* BB = (const float*)(F.ws + WS_S5T + 32768) + (size_t)gn * 32; const f32x2 ab = ((const f32x2*)(F.ws + WS_S5T))[gn];
    float bb[32];
#pragma unroll
    for (int k = 0; k < 8; ++k) { const f32x4 v = *(const f32x4*)(BB + 4 * k); bb[4 * k] = v[0]; bb[4 * k + 1] = v[1]; bb[4 * k + 2] = v[2]; bb[4 * k + 3] = v[3]; }
    float sr = 0.f, si = 0.f;
#pragma unroll 4
    for (int t = 0; t < 128; ++t) {
        float br = 0.f, bi = 0.f;
#pragma unroll
        for (int k = 0; k < 4; ++k) { const f32x4 uv = *(const LAS f32x4*)(U + t * 128 + F.wave * 16 + 4 * k);
#pragma unroll
            for (int j = 0; j < 4; ++j) { br += bb[4 * k + j] * uv[j]; bi += bb[16 + 4 * k + j] * uv[j]; } }
        const float nr = ab.x * sr - ab.y * si + br, ni = ab.x * si + ab.y * sr + bi; sr = nr; si = ni;
    }
    ((f32x2*)(F.ws + WS_S5E))[(size_t)((b * 32 + g) * 32 + c) * 64 + F.lane] = (f32x2){sr, si};
    __syncthreads();
}

DI void phase_odd_scan(const Frame& F, const Args& a) {
    LAS float* scp = (LAS float*)F.lds; LAS float* scn = scp + 512;
    if (F.tid < 16) { const int bh = F.tid; const float* MS = (const float*)(F.ws + WS_SMALL + 16384); float* MST = (float*)(F.ws + WS_SMALL + 32768); float m = -INFINITY;
        for (int c = 0; c < 32; ++c) { const float bl = MS[(bh * 32 + c) * 2], ml = MS[(bh * 32 + c) * 2 + 1]; const float mn = fmaxf(bl + m, ml);
            scp[bh * 32 + c] = __expf(bl + m - mn); scn[bh * 32 + c] = __expf(ml - mn); if (F.bx == 0) MST[bh * 32 + c] = m; m = mn; } }
    __syncthreads();
    const int gt = F.bx * 512 + F.tid, NT_ = F.G * 512;
    for (int it = gt; it < 16 * 18432; it += NT_) { const int bh = it / 18432, v = it % 18432;
        bf16_t* p = (bf16_t*)(F.ws + WS_MC) + (size_t)bh * 32 * 147456 + (size_t)v * 8;
        float run[8];
#pragma unroll
        for (int j = 0; j < 8; ++j) run[j] = 0.f;
#pragma unroll 4
        for (int c = 0; c < 32; ++c) { float x[8]; unpack8(*(const u32x4*)(p + (size_t)c * 147456), x); *(u32x4*)(p + (size_t)c * 147456) = pack8(run);
            const float sp = scp[bh * 32 + c], sn = scn[bh * 32 + c];
#pragma unroll
            for (int j = 0; j < 8; ++j) run[j] = sp * run[j] + sn * x[j]; } }
    for (int it = gt; it < 16 * 96; it += NT_) { const int bh = it / 96, v = it % 96; float* p = (float*)(F.ws + WS_MN) + (size_t)bh * 32 * 384 + v * 4;
        f32x4 run = (f32x4){0.f, 0.f, 0.f, 0.f};
        for (int c = 0; c < 32; ++c) { const f32x4 x = *(const f32x4*)(p + c * 384); *(f32x4*)(p + c * 384) = run; run = run * scp[bh * 32 + c] + x * scn[bh * 32 + c]; } }
    for (int it = gt; it < 8192; it += NT_) { const int b = it >> 11, g = (it >> 6) & 31, n = it & 63; const f32x2 a128 = ((const f32x2*)(F.ws + WS_S5T))[2048 + g * 64 + n];
        f32x2* p = (f32x2*)(F.ws + WS_S5E) + (size_t)((b * 32 + g) * 32) * 64 + n; float sr = 0.f, si = 0.f;
        for (int c = 0; c < 32; ++c) { const f32x2 e = p[c * 64]; p[c * 64] = (f32x2){sr, si}; const float nr = a128.x * sr - a128.y * si + e.x, ni = a128.x * si + a128.y * sr + e.y; sr = nr; si = ni; } }
}

struct MlCtx { const bf16_t* P; const bf16_t* Cg; const float* cw; const float* cb; int c, h; };
template <int I> DI void ml_stage(const Frame& F, const MlCtx& m, ldsp buf) {
    int tidz = F.tid; asm volatile("" : "+v"(tidz));
    if constexpr (I < 3) {
#pragma unroll 1
        for (int i = 0; i < 4; ++i) { const int item = tidz + 512 * i, s = item >> 4, d0 = (item & 15) * 8, xc = P1_K + m.h * 384 + I * 128 + d0;
            float y[8]; conv8(m.P + (size_t)s * PLD + xc, m.c * 128 + s, m.cw + xc, 3072, m.cb + xc, y);
#pragma unroll
            for (int j = 0; j < 8; ++j) y[j] = silu_(y[j]);
            *(LAS u32x4*)(buf + s * PT + d0 * 2) = pack8(y); }
    } else if constexpr (((I - 3) & 3) < 3) {
        constexpr int et = (I - 3) >> 2, j = (I - 3) & 3;
#pragma unroll
        for (int i = 0; i < 4; ++i) { const int item = tidz + 512 * i, e = item >> 4, d0 = (item & 15) * 8;
            *(LAS u32x4*)(buf + e * PT + d0 * 2) = *(const u32x4*)(m.Cg + (size_t)(et * 128 + e) * 384 + j * 128 + d0); }
    } else {
        constexpr int et = (I - 3) >> 2;
#pragma unroll
        for (int i = 0; i < 4; ++i) { const int item = tidz + 512 * i, s = item >> 4, e0 = (item & 15) * 8;
            const u32x4 v = *(const u32x4*)(m.P + (size_t)s * PLD + P1_V + m.h * 384 + et * 128 + e0);
            const unsigned ww[4] = {v.x, v.y, v.z, v.w};
#pragma unroll
            for (int j = 0; j < 8; ++j) *(LAS bf16_t*)(buf + (e0 + j) * PT + s * 2) = (bf16_t)((j & 1) ? (ww[j >> 1] >> 16) : (ww[j >> 1] & 0xffffu)); }
    }
}
template <int I> DI void ml_compute(const Frame& F, ldsp buf, ldsp Pm, const bf16x8 (&qf)[12], f32x4 (&as)[8], f32x4 (&ao)[8], int fr, int fq) {
    const int w = F.wave;
    if constexpr (I < 3) {
#pragma unroll
        for (int ks = 0; ks < 4; ++ks)
#pragma unroll
            for (int nt = 0; nt < 8; ++nt) if (nt <= w) { const bf16x8 bv = *(const LAS bf16x8*)(buf + (nt * 16 + fr) * PT + (ks * 32 + fq * 8) * 2);
                as[nt] = __builtin_amdgcn_mfma_f32_16x16x32_bf16(bv, qf[I * 4 + ks], as[nt], 0, 0, 0); }
    } else if constexpr (((I - 3) & 3) < 3) {
        constexpr int j = (I - 3) & 3;
#pragma unroll
        for (int ks = 0; ks < 4; ++ks)
#pragma unroll
            for (int nt = 0; nt < 8; ++nt) { const bf16x8 bv = *(const LAS bf16x8*)(buf + (nt * 16 + fr) * PT + (ks * 32 + fq * 8) * 2);
                ao[nt] = __builtin_amdgcn_mfma_f32_16x16x32_bf16(bv, qf[j * 4 + ks], ao[nt], 0, 0, 0); }
    } else {
#pragma unroll
        for (int ks = 0; ks < 4; ++ks) if (ks <= (w >> 1)) { const bf16x8 av = *(const LAS bf16x8*)(Pm + (16 * w + fr) * PT + (ks * 32 + fq * 8) * 2);
#pragma unroll
            for (int nt = 0; nt < 8; ++nt) { const bf16x8 bv = *(const LAS bf16x8*)(buf + (nt * 16 + fr) * PT + (ks * 32 + fq * 8) * 2);
                ao[nt] = __builtin_amdgcn_mfma_f32_16x16x32_bf16(bv, av, ao[nt], 0, 0, 0); } }
    }
}
DI void mlstm_out_unit(const Frame& F_, const Args& a, int u) {
    Frame F = F_; { int tz = F_.tid; asm volatile("" : "+v"(tz)); F.tid = tz; F.lane = tz & 63; }
    const int h = u & 3, c = (u >> 2) & 31, b = u >> 7, bh = b * 4 + h, w = F.wave;
    const size_t row0 = (size_t)(b * SEQ + c * 128);
    MlCtx m; m.P = (const bf16_t*)(F.ws + WS_PROJ) + row0 * PLD; m.Cg = (const bf16_t*)(F.ws + WS_MC) + (size_t)(bh * 32 + c) * 147456; m.cw = a.in[I_ML_CONVW]; m.cb = a.in[I_ML_CONVB]; m.c = c; m.h = h;
    ldsp X0 = F.lds, X1 = F.lds + 34816, Pm = F.lds + 69632;
    LAS float* bcum = (LAS float*)(F.lds + 104448); LAS float* gmb = bcum + 128; LAS float* mtv = bcum + 256; LAS float* iscv = bcum + 384; LAS float* nst = bcum + 512;
    if (w == 0) {
        const int s0 = 2 * F.lane, s1 = s0 + 1; const float fb = a.in[I_ML_FB][h], ib = a.in[I_ML_IB][h];
        const float lf0 = logsigmoid_(bf2f(m.P[(size_t)s0 * PLD + P1_F + h]) + fb), lf1 = logsigmoid_(bf2f(m.P[(size_t)s1 * PLD + P1_F + h]) + fb);
        const float ig0 = bf2f(m.P[(size_t)s0 * PLD + P1_I + h]) + ib, ig1 = bf2f(m.P[(size_t)s1 * PLD + P1_I + h]) + ib;
        float bc0, bc1; wscan_sum(lf0, lf1, F.lane, bc0, bc1);
        const float g0 = ig0 - bc0, g1 = ig1 - bc1; float pm0, pm1; wscan_max(g0, g1, F.lane, pm0, pm1);
        const float mst = ((const float*)(F.ws + WS_SMALL + 32768))[bh * 32 + c];
        const float mi0 = bc0 + mst, mi1 = bc1 + mst, mt0 = fmaxf(bc0 + pm0, mi0), mt1 = fmaxf(bc1 + pm1, mi1);
        bcum[s0] = bc0; bcum[s1] = bc1; gmb[s0] = g0; gmb[s1] = g1; mtv[s0] = mt0; mtv[s1] = mt1; iscv[s0] = __expf(mi0 - mt0); iscv[s1] = __expf(mi1 - mt1);
    } else if (F.tid >= 64 && F.tid < 64 + 384) nst[F.tid - 64] = ((const float*)(F.ws + WS_MN))[(size_t)(bh * 32 + c) * 384 + F.tid - 64];
    ml_stage<0>(F, m, X0);
    __syncthreads();
    const int fr = F.lane & 15, fq = F.lane >> 4, l = 16 * w + fr;
    bf16x8 qf[12]; float qn = 0.f;
#pragma unroll
    for (int ks = 0; ks < 12; ++ks) { const int d0 = ks * 32 + fq * 8, xc = h * 384 + d0;
        float y[8]; conv8(m.P + (size_t)l * PLD + xc, c * 128 + l, m.cw + xc, 3072, m.cb + xc, y);
#pragma unroll
        for (int j = 0; j < 8; ++j) { y[j] = silu_(y[j]) * 0.05103103630798288f; qn += y[j] * nst[d0 + j]; }
        qf[ks] = __builtin_bit_cast(bf16x8, pack8(y)); asm volatile("" : "+v"(qf[ks]), "+v"(qn) :: "memory"); }
    qn += __shfl_xor(qn, 16); qn += __shfl_xor(qn, 32);
    f32x4 as[8]; zero_acc(as); f32x4 ao[8]; zero_acc(ao);
    float den = 0.f, dn = 0.f, sm = 0.f, sq = 0.f;
    const float mtl = mtv[l], iscl = iscv[l];
    bf16_t* orow = (bf16_t*)(F.ws + WS_MIX) + (row0 + l) * 2048 + h * 384;
#define ML_STEP(I) do { if constexpr ((I) + 1 < 15) ml_stage<(I) + 1>(F, m, (((I) + 1) & 1) ? X1 : X0); ml_compute<I>(F, ((I) & 1) ? X1 : X0, Pm, qf, as, ao, fr, fq); \
        if constexpr ((I) == 2) { const float bl = bcum[l]; \
            _Pragma("unroll") for (int nt = 0; nt < 8; ++nt) if (nt <= (w | 1)) { float pv[4]; \
                _Pragma("unroll") for (int j = 0; j < 4; ++j) { const int s = nt * 16 + fq * 4 + j; pv[j] = (nt <= w && s <= l) ? as[nt][j] * __expf(bl + gmb[s] - mtl) : 0.f; den += pv[j]; } \
                u32x2 pw; pw.x = pk2(pv[0], pv[1]); pw.y = pk2(pv[2], pv[3]); *(LAS u32x2*)(Pm + l * PT + (nt * 16 + fq * 4) * 2) = pw; } \
            den += __shfl_xor(den, 16); den += __shfl_xor(den, 32); den += iscl * qn; dn = __builtin_amdgcn_rcpf(fmaxf(fabsf(den), __expf(-mtl))); } \
        if constexpr ((I) >= 3 && (((I) - 3) & 3) == 2) { _Pragma("unroll") for (int nt = 0; nt < 8; ++nt) ao[nt] = ao[nt] * iscl; } \
        if constexpr ((I) >= 3 && (((I) - 3) & 3) == 3) { constexpr int et_ = ((I) - 3) >> 2; \
            _Pragma("unroll") for (int nt = 0; nt < 8; ++nt) { const f32x4 hv = ao[nt] * dn; sm += (hv[0] + hv[1]) + (hv[2] + hv[3]); sq += (hv[0] * hv[0] + hv[1] * hv[1]) + (hv[2] * hv[2] + hv[3] * hv[3]); \
                u32x2 o; o.x = pk2(hv[0], hv[1]); o.y = pk2(hv[2], hv[3]); *(u32x2*)(orow + et_ * 128 + nt * 16 + fq * 4) = o; ao[nt] = (f32x4){0.f, 0.f, 0.f, 0.f}; } } \
        __syncthreads(); } while (0)
    ML_STEP(0); ML_STEP(1); ML_STEP(2); ML_STEP(3); ML_STEP(4); ML_STEP(5); ML_STEP(6); ML_STEP(7); ML_STEP(8); ML_STEP(9); ML_STEP(10); ML_STEP(11); ML_STEP(12); ML_STEP(13); ML_STEP(14);
#undef ML_STEP
    sm += __shfl_xor(sm, 16); sm += __shfl_xor(sm, 32); sq += __shfl_xor(sq, 16); sq += __shfl_xor(sq, 32);
    const float mean = sm * (1.f / 384.f); const float var = fmaxf(sq * (1.f / 384.f) - mean * mean, 0.f);
    const float rstd = rsqrtf(var + EPS);
    const bf16_t* orow_g = m.P + (size_t)l * PLD + P1_O + h * 384; const float* ng = a.in[I_ML_NORM] + h * 384;
    asm volatile("s_waitcnt vmcnt(0)" ::: "memory");
#pragma unroll 2
    for (int nt = 0; nt < 24; ++nt) { const int e = nt * 16 + fq * 4; const u32x2 ov = *(const u32x2*)(orow_g + e); const f32x4 nn = *(const f32x4*)(ng + e); const u32x2 hv = *(const u32x2*)(orow + e);
        u32x2 o; o.x = pk2((bflo(hv.x) - mean) * rstd * nn[0] * sigmoid_(bflo(ov.x)), (bfhi(hv.x) - mean) * rstd * nn[1] * sigmoid_(bfhi(ov.x)));
        o.y = pk2((bflo(hv.y) - mean) * rstd * nn[2] * sigmoid_(bflo(ov.y)), (bfhi(hv.y) - mean) * rstd * nn[3] * sigmoid_(bfhi(ov.y)));
        *(u32x2*)(orow + e) = o; }
    __syncthreads();
}

DI void s5_out_unit(const Frame& F_, const Args& a, int u) {
    Frame F = F_; { int tz = F_.tid; asm volatile("" : "+v"(tz)); F.tid = tz; F.lane = tz & 63; }
    const int b = u >> 7, c = (u >> 2) & 31, g8 = u & 3, w = F.wave;
    const size_t row0 = (size_t)(b * SEQ + c * 128);
    const bf16_t* P = (const bf16_t*)(F.ws + WS_PROJ) + row0 * PLD + P1_U + g8 * 128;
    ldsp U = F.lds; LAS float* CT = (LAS float*)(F.lds + 32768); ldsp ST = F.lds + 98304 + w * 4160;
#pragma unroll
    for (int i = 0; i < 4; ++i) { const int item = F.tid + 512 * i, t = item >> 4, ch = (item & 15) * 8; *(LAS u32x4*)(U + t * 256 + ch * 2) = *(const u32x4*)(P + (size_t)t * PLD + ch); }
    for (int i = F.tid; i < 8192; i += 512) { const int gl = i >> 10, cc = (i >> 6) & 15, n = i & 63; const size_t src = (size_t)((g8 * 8 + gl) * 16 + cc) * 64 + n;
        CT[((gl * 64 + n) * 16 + cc) * 2] = a.in[I_S5_CRE][src]; CT[((gl * 64 + n) * 16 + cc) * 2 + 1] = a.in[I_S5_CIM][src]; }
    __syncthreads();
    const int g = g8 * 8 + w, gn = g * 64 + F.lane;
    const float* BB = (const float*)(F.ws + WS_S5T + 32768) + (size_t)gn * 32; const f32x2 ab = ((const f32x2*)(F.ws + WS_S5T))[gn];
    float bb[32];
#pragma unroll
    for (int k = 0; k < 8; ++k) { const f32x4 v = *(const f32x4*)(BB + 4 * k); bb[4 * k] = v[0]; bb[4 * k + 1] = v[1]; bb[4 * k + 2] = v[2]; bb[4 * k + 3] = v[3]; }
    const f32x2 s0 = ((const f32x2*)(F.ws + WS_S5E))[(size_t)((b * 32 + g) * 32 + c) * 64 + F.lane];
    float sr = s0.x, si = s0.y;
    const int tl = F.lane & 7, co = F.lane >> 3;
    const float dk0 = a.in[I_S5_D][g * 16 + 2 * co], dk1 = a.in[I_S5_D][g * 16 + 2 * co + 1];
    bf16_t* Y5 = (bf16_t*)(F.ws + WS_Y5);
    for (int tt = 0; tt < 16; ++tt) {
#pragma unroll
        for (int t8 = 0; t8 < 8; ++t8) { const int t = tt * 8 + t8;
            float br = 0.f, bi = 0.f;
#pragma unroll
            for (int k = 0; k < 2; ++k) { float x[8]; unpack8(*(const LAS u32x4*)(U + t * 256 + w * 32 + k * 16), x);
#pragma unroll
                for (int j = 0; j < 8; ++j) { br += bb[8 * k + j] * x[j]; bi += bb[16 + 8 * k + j] * x[j]; } }
            const float nr = ab.x * sr - ab.y * si + br, ni = ab.x * si + ab.y * sr + bi; sr = nr; si = ni;
            *(LAS f32x2*)(ST + t8 * 520 + F.lane * 8) = (f32x2){sr, si}; }
        LDS_WAIT();
        float y0 = 0.f, y1 = 0.f;
#pragma unroll 8
        for (int n = 0; n < 64; ++n) { const f32x2 sv = *(const LAS f32x2*)(ST + tl * 520 + n * 8); const f32x4 cv = *(const LAS f32x4*)(CT + ((w * 64 + n) * 16 + 2 * co) * 2);
            y0 += cv[0] * sv.x - cv[1] * sv.y; y1 += cv[2] * sv.x - cv[3] * sv.y; }
        const int t = tt * 8 + tl; const unsigned uv = *(const LAS unsigned*)(U + t * 256 + w * 32 + co * 4);
        y0 = gelu_(y0 + dk0 * bflo(uv)); y1 = gelu_(y1 + dk1 * bfhi(uv));
        *(unsigned*)(Y5 + (row0 + t) * 512 + g * 16 + 2 * co) = pk2(y0, y1);
        LDS_WAIT();
    }
    __syncthreads();
}

__global__ void __launch_bounds__(512, 2) fwd(Args a) {
    extern __shared__ __attribute__((aligned(16))) unsigned char shm[];
    Frame F; F.lds = (ldsp)shm; F.tid = threadIdx.x; F.lane = F.tid & 63; F.wave = __builtin_amdgcn_readfirstlane(F.tid >> 6); F.G = gridDim.x; F.bx = blockIdx.x; F.ws = a.ws;
    volatile LAS unsigned* LC = (volatile LAS unsigned*)(F.lds + LDS_CTL);
    if (F.tid < 128) LC[F.tid] = 0u;
    __syncthreads();
#if MK_SINGLE
    XcdBarrier bar = xcd_barrier_post((unsigned*)(F.ws + WS_CTL) + CW_BAR, LC + 8);
#define GRID_BAR() xcd_barrier(bar)
#else
#define GRID_BAR() do {} while (0)
#endif
    const int lo = a.ph_lo, hi = a.ph_hi;
#ifdef ONLY_PHASE
#define IN(k) ((k) == ONLY_PHASE && lo <= (k) && (k) < hi)
#else
#define IN(k) (lo <= (k) && (k) < hi)
#endif
#define SEAM(k) do { if (IN(k) && IN((k) + 1)) GRID_BAR(); } while (0)
    bf16_t* XN = (bf16_t*)(F.ws + WS_XN); bf16_t* MIX = (bf16_t*)(F.ws + WS_MIX); bf16_t* PROJ = (bf16_t*)(F.ws + WS_PROJ);

    if (IN(0)) { phase_prologue(F, a); } SEAM(0);
    if (IN(1)) { pg8::Tile2D S; S.init(XN, F.ws + WS_WIN0, T, PLD, 2048, 2048, F.G, F.bx); pg8::EpiBf16 E{PROJ, PLD};
        pg8::gemm_phase<pg8::EpiBf16, pg8::Tile2D, false>(F.lds, 2048, 2048, 2048, S, E); } SEAM(1);
    if (IN(2)) { for (int u = F.bx; u < 1536; u += F.G) { if (u < 512) ssd_local_unit(F, a, u); else ret_local_unit(F, a, u - 512); } } SEAM(2);
    if (IN(3)) { phase_even_scan(F, a); } SEAM(3);
    if (IN(4)) { for (int u = F.bx; u < 1280; u += F.G) { if (u < 256) ssd_out_unit(F, a, u); else ret_out_unit(F, a, u - 256); } } SEAM(4);
    if (IN(5)) { pg8::Tile2D S; S.init(MIX, F.ws + WS_WOUT0, T, 2048, 2048, 2048, F.G, F.bx); pg8::EpiResF32 E{a.in[I_X], a.out, 2048};
        pg8::gemm_phase<pg8::EpiResF32, pg8::Tile2D, false>(F.lds, 2048, 2048, 2048, S, E); } SEAM(5);
    if (IN(6)) { phase_router(F, a, 0); } SEAM(6);
    if (IN(7)) { phase_moe_gateup(F, a, 0); } SEAM(7);
    if (IN(8)) { phase_moe_down(F, a, 0); } SEAM(8);
    if (IN(9)) { phase_combine<false>(F, a, 0); __syncthreads(); moe_convert(F, a, 1); } SEAM(9);
    if (IN(10)) { pg8::Tile2D S; S.init(XN, F.ws + WS_WIN1, T, PLD, 2048, 2048, F.G, F.bx); pg8::EpiBf16 E{PROJ, PLD};
        pg8::gemm_phase<pg8::EpiBf16, pg8::Tile2D, false>(F.lds, 2048, 2048, 2048, S, E); } SEAM(10);
    if (IN(11)) { for (int u = F.bx; u < 2048; u += F.G) { if (u < 1536) mlstm_local_unit(F, a, u); else s5_local_unit(F, a, u - 1536); } } SEAM(11);
    if (IN(12)) { phase_odd_scan(F, a); } SEAM(12);
    if (IN(13)) { for (int u = F.bx; u < 1024; u += F.G) {
#ifndef NO_ML
            if (u < 512) mlstm_out_unit(F, a, u);
#endif
#ifndef NO_S5
            if (u >= 512) s5_out_unit(F, a, u - 512);
#endif
 } } SEAM(13);
    if (IN(14)) { pg8::Tile2D S; S.init(F.ws + WS_Y5, F.ws + WS_WGLU, T, 1024, 512, 512, F.G, F.bx); pg8::EpiGlu E{MIX + 1536, 2048, a.in[I_S5_BGLU]};
        pg8::GluOrder GS{S};
        pg8::gemm_phase<pg8::EpiGlu, pg8::GluOrder, false>(F.lds, 512, 512, 512, GS, E); } SEAM(14);
    if (IN(15)) { pg8::Tile2D S; S.init(MIX, F.ws + WS_WOUT1, T, 2048, 2048, 2048, F.G, F.bx); pg8::EpiResF32 E{a.out, a.out, 2048};
        pg8::gemm_phase<pg8::EpiResF32, pg8::Tile2D, false>(F.lds, 2048, 2048, 2048, S, E); } SEAM(15);
    if (IN(16)) { phase_router(F, a, 1); } SEAM(16);
    if (IN(17)) { phase_moe_gateup(F, a, 1); } SEAM(17);
    if (IN(18)) { phase_moe_down(F, a, 1); } SEAM(18);
    if (IN(19)) { phase_combine<true>(F, a, 1); }
#undef IN
#undef SEAM
}


#if DBG
constexpr size_t WS_DBG = WS_SMALL + 65536;
__device__ __forceinline__ void dbg_pub(float err, unsigned char* ws) {
    __shared__ unsigned red_;
    if (threadIdx.x == 0) red_ = 0u; __syncthreads();
    if (!(err >= 0.f)) err = __builtin_nanf("");
    atomicMax(&red_, __float_as_uint(err)); __syncthreads();
    if (threadIdx.x == 0) atomicMax((unsigned*)(ws + WS_DBG), red_);
    __syncthreads();
}
__device__ __forceinline__ float dbg_bsum(float v, float* sh) {
    __syncthreads(); sh[threadIdx.x] = v; __syncthreads();
    float t = 0.f; for (int i = 0; i < (int)blockDim.x; ++i) t += sh[i];
    __syncthreads(); return t;
}
__global__ void dbg_dump(float* out, const unsigned char* ws) {
    const size_t i = (size_t)blockIdx.x * blockDim.x + threadIdx.x; const size_t N = (size_t)T * D;
    if (i < N) { float v = 0.f; if (i == 0) { const float E = *(const float*)(ws + WS_DBG); float t = 10.f + log10f(fmaxf(E, 1e-12f)); t = fminf(fmaxf(t, 0.5f), 30.f); if (!(E == E)) t = 25.f; v = sqrtf((float)N * t); } out[i] = v; }
}
#define PRJ(row, col) bf2f(((const bf16_t*)(a.ws + WS_PROJ))[(size_t)(row) * PLD + (col)])
#define MIXV(row, col) bf2f(((const bf16_t*)(a.ws + WS_MIX))[(size_t)(row) * 2048 + (col)])
__device__ __forceinline__ float dbg_conv_(const bf16_t* prj, const float* cw, const float* cb, int C, size_t row, int pos, int col0, int ch) {
    float y = cb[ch];
    for (int tap = 0; tap < 4; ++tap) if (pos - 3 + tap >= 0) y += cw[tap * C + ch] * bf2f(prj[(size_t)(row - 3 + tap) * PLD + col0 + ch]);
    return y / (1.f + expf(-y));
}
#define dbg_conv(a, layer1, row, pos, col0, ch) dbg_conv_((const bf16_t*)((a).ws + WS_PROJ), (a).in[(layer1) ? I_ML_CONVW : I_SSD_CONVW], (a).in[(layer1) ? I_ML_CONVB : I_SSD_CONVB], (layer1) ? 3072 : 1536, row, pos, col0, ch)
__global__ void dbg_check_proj(Args a, int layer1) {
    const int tid = threadIdx.x + blockIdx.x * blockDim.x; const int NN = layer1 ? N1 : N0; const int row = (tid * 7919 + 13) % T, col = (tid * 104729 + 7) % NN;
    const float* x = (layer1 ? a.out : a.in[I_X]) + (size_t)row * D; const float* g = a.in[layer1 ? I_ODD_NORM : I_EVEN_NORM]; const float* W = a.in[layer1 ? I_ODD_WIN : I_EVEN_WIN];
    float ss = 0.f; for (int k = 0; k < D; ++k) ss += x[k] * x[k];
    const float rstd = rsqrtf(ss / D + EPS); float ref = 0.f;
    for (int k = 0; k < D; ++k) ref += x[k] * rstd * g[k] * W[(size_t)k * NN + col];
    dbg_pub(fabsf(PRJ(row, col) - ref) / (fabsf(ref) + 0.25f), a.ws);
}
__global__ void dbg_check_outproj(Args a, int layer1, const float* hprev) {
    const int tid = threadIdx.x + blockIdx.x * blockDim.x; const int row = (tid * 7919 + 13) % T, col = (tid * 104729 + 7) % D;
    const float* W = a.in[layer1 ? I_ODD_WOUT : I_EVEN_WOUT]; float ref = 0.f;
    for (int k = 0; k < 2048; ++k) ref += MIXV(row, k) * W[(size_t)k * D + col];
    const float r0 = hprev[(size_t)row * D + col];
    dbg_pub(fabsf(a.out[(size_t)row * D + col] - (r0 + ref)) / (fabsf(ref) + 0.25f), a.ws);
}
__global__ void dbg_check_ret(Args a) {
    __shared__ float qs[128], ks[128], sh[128];
    const int i = blockIdx.x, b = i & 3, h = (i >> 2) & 7, pos = (i * 977 + 131 + (i & 1) * 60) % SEQ, e = threadIdx.x; const size_t rb = (size_t)b * SEQ;
    const float lg = log1pf(-exp2f(-5.f - (float)h)); const int dd = e & 63; const float inv = 1.0f / powf(10000.f, (float)(2 * dd) / 128.f);
    { const float ang = (float)pos * inv, c = cosf(ang), sn = sinf(ang); const float t1 = PRJ(rb + pos, h * 128 + dd), t2 = PRJ(rb + pos, h * 128 + dd + 64); qs[e] = e < 64 ? t1 * c - t2 * sn : t1 * sn + t2 * c; }
    float o = 0.f;
    for (int s = 0; s <= pos; ++s) {
        __syncthreads();
        { const float ang = (float)s * inv, c = cosf(ang), sn = sinf(ang); const float t1 = PRJ(rb + s, P0_K + h * 128 + dd), t2 = PRJ(rb + s, P0_K + h * 128 + dd + 64); ks[e] = (e < 64 ? t1 * c - t2 * sn : t1 * sn + t2 * c) * 0.08838834764831845f; }
        __syncthreads();
        float sc = 0.f;
#pragma unroll 4
        for (int d = 0; d < 128; ++d) sc += qs[d] * ks[d];
        o += sc * expf(lg * (float)(pos - s)) * PRJ(rb + s, P0_V + h * 128 + e);
    }
    const float mean = dbg_bsum(o, sh) / 128.f; const float var = dbg_bsum((o - mean) * (o - mean), sh) / 128.f;
    const float gg = PRJ(rb + pos, P0_G + h * 128 + e);
    const float ref = (o - mean) * rsqrtf(var + EPS) * a.in[I_RET_NORM][h * 128 + e] * (gg / (1.f + expf(-gg)));
    dbg_pub(fabsf(MIXV(rb + pos, h * 128 + e) - ref) / (fabsf(ref) + 0.25f), a.ws);
}
__global__ void __launch_bounds__(512) dbg_check_ssd(Args a) {
    __shared__ float bms[128], cms[128], sh[512];
    const int i = blockIdx.x, b = i & 3, g = (i >> 2) & 1, pos = (i * 977 + 131 + (i & 1) * 60) % SEQ, ch = threadIdx.x, r = ch >> 6, hd = g * 8 + r; const size_t rb = (size_t)b * SEQ;
    const float A = -expf(a.in[I_SSD_ALOG][hd]), dtb = a.in[I_SSD_DTB][hd];
    float Apos = 0.f;
    for (int s = 0; s <= pos; ++s) { const float v = PRJ(rb + s, P0_DT + hd) + dtb; const float dt = v > 20.f ? v : log1pf(expf(v)); Apos += dt * A; }
    if (ch < 128) cms[ch] = dbg_conv(a, 0, rb + pos, pos, P0_XBC, 1280 + g * 128 + ch);
    float y = 0.f, As = 0.f;
    for (int s = 0; s <= pos; ++s) {
        __syncthreads();
        if (ch < 128) bms[ch] = dbg_conv(a, 0, rb + s, s, P0_XBC, 1024 + g * 128 + ch);
        __syncthreads();
        float cb = 0.f;
#pragma unroll 4
        for (int n = 0; n < 128; ++n) cb += cms[n] * bms[n];
        const float v = PRJ(rb + s, P0_DT + hd) + dtb; const float dt = v > 20.f ? v : log1pf(expf(v)); As += dt * A;
        y += cb * expf(Apos - As) * dbg_conv(a, 0, rb + s, s, P0_XBC, g * 512 + ch) * dt;
    }
    const float xs = dbg_conv(a, 0, rb + pos, pos, P0_XBC, g * 512 + ch), z = PRJ(rb + pos, P0_Z + g * 512 + ch);
    y = (y + a.in[I_SSD_D][hd] * xs) * (z / (1.f + expf(-z)));
    const float ms = dbg_bsum(y * y, sh) / 512.f;
    const float ref = y * rsqrtf(ms + EPS) * a.in[I_SSD_NORM][g * 512 + ch];
    dbg_pub(fabsf(MIXV(rb + pos, 1024 + g * 512 + ch) - ref) / (fabsf(ref) + 0.25f), a.ws);
}
__global__ void __launch_bounds__(384) dbg_check_mlstm(Args a) {
    __shared__ float qs[384], ks[384], sh[384];
    const int i = blockIdx.x, b = i & 3, h = (i >> 2) & 3, pos = (i * 977 + 131 + (i & 1) * 60) % SEQ, e = threadIdx.x; const size_t rb = (size_t)b * SEQ;
    const float fb = a.in[I_ML_FB][h], ib = a.in[I_ML_IB][h];
    float Fpos = 0.f; for (int s = 0; s <= pos; ++s) { const float f = PRJ(rb + s, P1_F + h) + fb; Fpos += -(-f > 20.f ? -f : log1pf(expf(-f))); }
    float m = -INFINITY, Fs = 0.f; for (int s = 0; s <= pos; ++s) { const float f = PRJ(rb + s, P1_F + h) + fb; Fs += -(-f > 20.f ? -f : log1pf(expf(-f))); m = fmaxf(m, Fpos - Fs + PRJ(rb + s, P1_I + h) + ib); }
    qs[e] = dbg_conv(a, 1, rb + pos, pos, 0, h * 384 + e) * 0.05103103630798288f;
    float N = 0.f, Dn = 0.f; Fs = 0.f;
    for (int s = 0; s <= pos; ++s) {
        __syncthreads();
        ks[e] = dbg_conv(a, 1, rb + s, s, 0, 1536 + h * 384 + e);
        __syncthreads();
        float qk = 0.f;
#pragma unroll 4
        for (int d = 0; d < 384; ++d) qk += qs[d] * ks[d];
        const float f = PRJ(rb + s, P1_F + h) + fb; Fs += -(-f > 20.f ? -f : log1pf(expf(-f)));
        const float w = expf(Fpos - Fs + PRJ(rb + s, P1_I + h) + ib - m);
        N += w * qk * PRJ(rb + s, P1_V + h * 384 + e); Dn += w * qk;
    }
    const float hv = N / fmaxf(fabsf(Dn), expf(-m));
    const float mean = dbg_bsum(hv, sh) / 384.f; const float var = dbg_bsum((hv - mean) * (hv - mean), sh) / 384.f;
    const float o = PRJ(rb + pos, P1_O + h * 384 + e);
    const float ref = (hv - mean) * rsqrtf(var + EPS) * a.in[I_ML_NORM][h * 384 + e] / (1.f + expf(-o));
    dbg_pub(fabsf(MIXV(rb + pos, h * 384 + e) - ref) / (fabsf(ref) + 0.25f), a.ws);
}
__global__ void dbg_check_s5(Args a) {
    __shared__ float yr[16][64];
    const int i = blockIdx.x, b = i & 3, g = (i >> 2) & 31, pos = (i * 977 + 131 + (i & 1) * 60) % SEQ, n = threadIdx.x; const size_t rb = (size_t)b * SEQ;
    const float dt = expf(a.in[I_S5_LOGDT][g]), are = a.in[I_S5_ARE][g * 64 + n], aim = a.in[I_S5_AIM][g * 64 + n];
    const float mag = expf(are * dt), abr = mag * cosf(aim * dt), abi = mag * sinf(aim * dt), den = are * are + aim * aim, nr = abr - 1.f;
    const float cr = (nr * are + abi * aim) / den, ci = (abi * are - nr * aim) / den;
    float bbr[16], bbi[16];
#pragma unroll
    for (int c = 0; c < 16; ++c) { const float br = a.in[I_S5_BRE][(size_t)(g * 64 + n) * 16 + c], bi = a.in[I_S5_BIM][(size_t)(g * 64 + n) * 16 + c]; bbr[c] = cr * br - ci * bi; bbi[c] = cr * bi + ci * br; }
    float sr = 0.f, si = 0.f;
    for (int t = 0; t <= pos; ++t) { float ur = 0.f, ui = 0.f;
#pragma unroll
        for (int c = 0; c < 16; ++c) { const float u = PRJ(rb + t, P1_U + g * 16 + c); ur += bbr[c] * u; ui += bbi[c] * u; }
        const float nr2 = abr * sr - abi * si + ur, ni2 = abr * si + abi * sr + ui; sr = nr2; si = ni2; }
    for (int c = 0; c < 16; ++c) yr[c][n] = a.in[I_S5_CRE][(size_t)(g * 16 + c) * 64 + n] * sr - a.in[I_S5_CIM][(size_t)(g * 16 + c) * 64 + n] * si;
    __syncthreads();
    float err = 0.f;
    if (n < 16) { float y = 0.f; for (int k = 0; k < 64; ++k) y += yr[n][k]; y += a.in[I_S5_D][g * 16 + n] * PRJ(rb + pos, P1_U + g * 16 + n);
        const float u = 0.7978845608f * (y + 0.044715f * y * y * y); const float ref = 0.5f * y * (1.f + tanhf(u));
        const float got = bf2f(((const bf16_t*)(a.ws + WS_Y5))[(rb + pos) * 512 + g * 16 + n]); err = fabsf(got - ref) / (fabsf(ref) + 0.25f); }
    dbg_pub(err, a.ws);
}
__global__ void dbg_check_glu(Args a) {
    const int tid = threadIdx.x + blockIdx.x * blockDim.x; const int row = (tid * 7919 + 13) % T, col = (tid * 104729 + 7) % 512;
    float v = a.in[I_S5_BGLU][col], gt = a.in[I_S5_BGLU][512 + col];
    for (int k = 0; k < 512; ++k) { const float y = bf2f(((const bf16_t*)(a.ws + WS_Y5))[(size_t)row * 512 + k]); v += y * a.in[I_S5_WGLU][(size_t)k * 1024 + col]; gt += y * a.in[I_S5_WGLU][(size_t)k * 1024 + 512 + col]; }
    const float ref = v / (1.f + expf(-gt));
    dbg_pub(fabsf(MIXV(row, 1536 + col) - ref) / (fabsf(ref) + 0.25f), a.ws);
}
__global__ void dbg_check_router(Args a, int layer) {
    const int tid = threadIdx.x + blockIdx.x * blockDim.x; const int tok = (tid * 7919 + 13) % T; const float* x = a.out + (size_t)tok * D;
    float ss = 0.f; for (int k = 0; k < D; ++k) ss += x[k] * x[k];
    const float rstd = rsqrtf(ss / D + EPS); float gmax = -INFINITY, gsec = -INFINITY; int gi = 0; float se = 0.f;
    for (int j = 0; j < 4; ++j) { float l = 0.f; for (int k = 0; k < D; ++k) l += x[k] * rstd * a.in[I_MOE_NORM][layer * D + k] * a.in[I_MOE_RG][(size_t)(layer * D + k) * 4 + j]; l += a.in[I_MOE_RGB][layer * 4 + j];
        if (l > gmax) { se = se * expf(gmax - l) + 1.f; gsec = gmax; gmax = l; gi = j; } else { se += expf(l - gmax); gsec = fmaxf(gsec, l); } }
    float v1 = -INFINITY, v2 = -INFINITY, v3 = -INFINITY; int i1 = 0, i2 = 0;
    for (int j = 0; j < 8; ++j) { float l = 0.f; for (int k = 0; k < D; ++k) l += x[k] * rstd * a.in[I_MOE_NORM][layer * D + k] * a.in[I_MOE_RE][(size_t)(layer * D + k) * 32 + gi * 8 + j]; l += a.in[I_MOE_REB][layer * 32 + gi * 8 + j];
        if (l > v1) { v3 = v2; v2 = v1; i2 = i1; v1 = l; i1 = j; } else if (l > v2) { v3 = v2; v2 = l; i2 = j; } else v3 = fmaxf(v3, l); }
    const float e2 = expf(v2 - v1), w1 = (1.f / se) / (1.f + e2), w2 = (1.f / se) * e2 / (1.f + e2);
    const int* sp = (const int*)(a.ws + WS_SLOT) + (size_t)tok * 8;
    float err = 0.f;
    if (sp[0] != gi * 8 + i1 || sp[3] != gi * 8 + i2) err += (v2 - v3 > 1e-3f && v1 - v2 > 1e-3f && gmax - gsec > 1e-3f) ? 1.f : 0.f;
    else err = fabsf(__int_as_float(sp[2]) - w1) + fabsf(__int_as_float(sp[5]) - w2);
    const unsigned* cnt = (const unsigned*)(a.ws + WS_CTL) + CW_CNT + layer * 32 * 64; unsigned tot = 0; for (int e = 0; e < 32; ++e) tot += cnt[e * 64];
    if (tot != 2u * T) err += 2.f;
    if (sp[1] < 0 || sp[1] >= (int)cnt[sp[0] * 64] || ((const int*)(a.ws + WS_LIST))[sp[0] * T + sp[1]] != tok) err += 4.f;
    dbg_pub(err, a.ws);
}
__device__ __forceinline__ bool dbg_bad(float v) { return !(v - v == 0.f); }
__global__ void dbg_scan_odd(Args a) {
    const size_t gt = (size_t)blockIdx.x * blockDim.x + threadIdx.x, NT_ = (size_t)gridDim.x * blockDim.x; unsigned fl = 0u;
    const float* MS = (const float*)(a.ws + WS_SMALL + 16384); const float* MST = (const float*)(a.ws + WS_SMALL + 32768);
    for (size_t i = gt; i < 1024; i += NT_) if (dbg_bad(MS[i])) fl |= 1u;
    for (size_t i = gt; i < 512; i += NT_) { const float v = MST[i]; if ((i & 31) == 0 ? !(v == -INFINITY) : dbg_bad(v)) fl |= 2u; }
    const bf16_t* MC = (const bf16_t*)(a.ws + WS_MC); for (size_t i = gt; i < (size_t)16 * 32 * 147456; i += NT_) if (dbg_bad(bf2f(MC[i]))) fl |= 4u;
    const float* MN = (const float*)(a.ws + WS_MN); for (size_t i = gt; i < (size_t)16 * 32 * 384; i += NT_) if (dbg_bad(MN[i])) fl |= 8u;
    const bf16_t* MX = (const bf16_t*)(a.ws + WS_MIX); for (size_t i = gt; i < (size_t)T * 1536; i += NT_) if (dbg_bad(bf2f(MX[(i / 1536) * 2048 + (i % 1536)]))) fl |= 16u;
    const bf16_t* PJ = (const bf16_t*)(a.ws + WS_PROJ); for (size_t i = gt; i < (size_t)T * N1; i += NT_) if (dbg_bad(bf2f(PJ[(i / N1) * PLD + (i % N1)]))) fl |= 32u;
    if (fl) atomicOr((unsigned*)(a.ws + WS_DBG + 4), fl);
}
__global__ void dbg_count_mc(Args a) {
    const size_t gt = (size_t)blockIdx.x * blockDim.x + threadIdx.x, NT_ = (size_t)gridDim.x * blockDim.x; unsigned n = 0;
    const bf16_t* MC = (const bf16_t*)(a.ws + WS_MC); for (size_t i = gt; i < (size_t)16 * 32 * 147456; i += NT_) if (dbg_bad(bf2f(MC[i]))) ++n;
    if (n) atomicAdd((unsigned*)(a.ws + WS_DBG + 4), n);
}
__global__ void dbg_count_fin(Args a) { const unsigned n = *(const unsigned*)(a.ws + WS_DBG + 4); *(float*)(a.ws + WS_DBG) = exp10f(log10f((float)n + 1.f) - 9.f); }
__global__ void dbg_scan_fin(Args a) { const unsigned fl = *(const unsigned*)(a.ws + WS_DBG + 4); *(float*)(a.ws + WS_DBG) = exp10f(0.1f * (float)fl - 9.f); }
__global__ void __launch_bounds__(512) dbg_check_moe(Args a, int layer) {
    __shared__ float xs[2048], hid[512]; __shared__ int ts[33];
    const int i = blockIdx.x, tok = (i * 7919 + 13) % T, slot = i & 1, f = threadIdx.x;
    const int* sp = (const int*)(a.ws + WS_SLOT) + (size_t)tok * 8; const int e = sp[slot * 3], r = sp[slot * 3 + 1];
    if (f == 0) { const unsigned* cnt = (const unsigned*)(a.ws + WS_CTL) + CW_CNT + layer * 32 * 64; int acc = 0; for (int q = 0; q < 32; ++q) { ts[q] = acc; acc += ((int)cnt[q * 64] + 255) >> 8; } }
    for (int k = f; k < 2048; k += 512) xs[k] = bf2f(((const bf16_t*)(a.ws + WS_XN))[(size_t)tok * D + k]);
    __syncthreads();
    const float* wg = a.in[I_MOE_WG] + (size_t)(layer * 32 + e) * 2048 * 512; const float* wu = a.in[I_MOE_WU] + (size_t)(layer * 32 + e) * 2048 * 512; const float* wd = a.in[I_MOE_WD] + (size_t)(layer * 32 + e) * 512 * 2048;
    float gg = 0.f, uu = 0.f; for (int k = 0; k < 2048; ++k) { gg += xs[k] * wg[(size_t)k * 512 + f]; uu += xs[k] * wu[(size_t)k * 512 + f]; }
    hid[f] = gg / (1.f + expf(-gg)) * uu;
    __syncthreads();
    const int col = (f * 37 + 5) % D; float ref = 0.f; for (int k = 0; k < 512; ++k) ref += hid[k] * wd[(size_t)k * D + col];
    const float got = bf2f(((const bf16_t*)(a.ws + WS_Y))[(size_t)(ts[e] * 256 + r) * D + col]);
    dbg_pub(fabsf(got - ref) / (fabsf(ref) + 0.25f), a.ws);
}
#endif

extern "C" void kernel_launch(void* const* d_in, const int* in_sizes, int n_in, void* d_out, int out_size, void* d_ws, size_t ws_size, hipStream_t stream) {
    static int grid = 0;
    if (grid == 0) {
        if (n_in != 38 || out_size != T * D || ws_size < WS_END) { fprintf(stderr, "kernel_launch: unexpected problem (n_in %d, out %d, ws %zu)\n", n_in, out_size, ws_size); grid = -1; return; }
        int dev = 0, cus = 0, per_cu = 0;
        if (hipGetDevice(&dev) != hipSuccess || hipDeviceGetAttribute(&cus, hipDeviceAttributeMultiprocessorCount, dev) != hipSuccess) { grid = -1; return; }
        if (hipFuncSetAttribute((const void*)fwd, hipFuncAttributeMaxDynamicSharedMemorySize, LDS_BYTES) != hipSuccess) { fprintf(stderr, "kernel_launch: hipFuncSetAttribute failed\n"); grid = -1; return; }
        if (hipOccupancyMaxActiveBlocksPerMultiprocessor(&per_cu, (const void*)fwd, 512, LDS_BYTES) != hipSuccess || per_cu < 1) fprintf(stderr, "kernel_launch: occupancy query reports %d\n", per_cu);
        (void)hipGetLastError();
        grid = cus;
    }
    if (grid < 0) return;
    (void)hipMemsetAsync((char*)d_ws + WS_CTL, 0, CTL_BYTES, stream);
    Args a{};
    for (int i = 0; i < 38; ++i) a.in[i] = (const float*)d_in[i];
    a.out = (float*)d_out; a.ws = (unsigned char*)d_ws;
#if DBG
    constexpr int dbg_last = (DBG == 1) ? 1 : (DBG == 2 || DBG == 3) ? 4 : (DBG == 4) ? 5 : (DBG == 5) ? 6 : (DBG == 6 || DBG == 20) ? 8 : (DBG == 7) ? 10 : (DBG == 31 || DBG == 33 || DBG == 34 || DBG == 35) ? 11 : (DBG == 32) ? 12 : (DBG == 8 || DBG == 9 || DBG == 30) ? 13 : (DBG == 10) ? 14 : (DBG == 11) ? 15 : (DBG == 12) ? 16 : 18;
    (void)hipMemsetAsync((char*)d_ws + WS_DBG, 0, 8, stream);
    float* hsave = (float*)((char*)d_ws + WS_END);
#define DBG_ON(k) (DBG == (k) || (DBG == 20 && (k) <= 6) || (DBG == 21 && (k) >= 7))
    for (int p = 0; p <= dbg_last; ++p) {
        if (p == 11 && DBG == 34) (void)hipMemsetAsync((char*)d_ws + WS_MC, 0, (size_t)144 * MiB, stream);
        if (p == 15 && DBG_ON(11)) (void)hipMemcpyAsync(hsave, d_out, (size_t)T * D * 4, hipMemcpyDeviceToDevice, stream);
        a.ph_lo = p; a.ph_hi = p + 1; hipLaunchKernelGGL(fwd, dim3(grid), dim3(512), LDS_BYTES, stream, a);
        a.ph_lo = 0; a.ph_hi = 0;
        if (p == 1 && DBG_ON(1)) hipLaunchKernelGGL(dbg_check_proj, dim3(4), dim3(256), 0, stream, a, 0);
        if (p == 4 && DBG_ON(2)) hipLaunchKernelGGL(dbg_check_ret, dim3(32), dim3(128), 0, stream, a);
        if (p == 4 && DBG_ON(3)) hipLaunchKernelGGL(dbg_check_ssd, dim3(16), dim3(512), 0, stream, a);
        if (p == 5 && DBG_ON(4)) hipLaunchKernelGGL(dbg_check_outproj, dim3(4), dim3(256), 0, stream, a, 0, (const float*)d_in[0]);
        if (p == 6 && DBG_ON(5)) hipLaunchKernelGGL(dbg_check_router, dim3(4), dim3(128), 0, stream, a, 0);
        if (p == 8 && DBG_ON(6)) hipLaunchKernelGGL(dbg_check_moe, dim3(32), dim3(512), 0, stream, a, 0);
        if (p == 10 && DBG_ON(7)) hipLaunchKernelGGL(dbg_check_proj, dim3(4), dim3(256), 0, stream, a, 1);
        if (p == 13 && DBG_ON(8)) hipLaunchKernelGGL(dbg_check_mlstm, dim3(16), dim3(384), 0, stream, a);
        if (p == 13 && DBG_ON(9)) hipLaunchKernelGGL(dbg_check_s5, dim3(64), dim3(64), 0, stream, a);
        if ((p == 13 && DBG == 30) || (p == 11 && DBG == 31) || (p == 12 && DBG == 32)) { hipLaunchKernelGGL(dbg_scan_odd, dim3(1024), dim3(256), 0, stream, a); hipLaunchKernelGGL(dbg_scan_fin, dim3(1), dim3(1), 0, stream, a); }
        if (p == 11 && (DBG == 33 || DBG == 34)) { hipLaunchKernelGGL(dbg_count_mc, dim3(1024), dim3(256), 0, stream, a); hipLaunchKernelGGL(dbg_count_fin, dim3(1), dim3(1), 0, stream, a); }
        if (p == 11 && DBG == 35) hipLaunchKernelGGL(dbg_scan_fin, dim3(1), dim3(1), 0, stream, a);
        if (p == 14 && DBG_ON(10)) hipLaunchKernelGGL(dbg_check_glu, dim3(4), dim3(256), 0, stream, a);
        if (p == 15 && DBG_ON(11)) hipLaunchKernelGGL(dbg_check_outproj, dim3(4), dim3(256), 0, stream, a, 1, (const float*)hsave);
        if (p == 16 && DBG_ON(12)) hipLaunchKernelGGL(dbg_check_router, dim3(4), dim3(128), 0, stream, a, 1);
        if (p == 18 && DBG_ON(13)) hipLaunchKernelGGL(dbg_check_moe, dim3(32), dim3(512), 0, stream, a, 1);
    }
    hipLaunchKernelGGL(dbg_dump, dim3((T * D + 255) / 256), dim3(256), 0, stream, (float*)d_out, (const unsigned char*)d_ws);
#elif MK_SINGLE
    a.ph_lo = 0; a.ph_hi = NPHASE;
    hipLaunchKernelGGL(fwd, dim3(grid), dim3(512), LDS_BYTES, stream, a);
#else
    for (int p = 0; p < NPHASE; ++p) { a.ph_lo = p; a.ph_hi = p + 1; hipLaunchKernelGGL(fwd, dim3(grid), dim3(512), LDS_BYTES, stream, a); }
#endif
}
```

```cpp
#include <hip/hip_runtime.h>
#include <cstdio>
#include <cstdint>

#ifndef MK_SINGLE
#define MK_SINGLE 1
#endif
#ifndef DBG
#define DBG 0
#endif

#define DI __device__ __forceinline__
#define LAS __attribute__((address_space(3)))
typedef unsigned short bf16_t;
typedef short bf16x8 __attribute__((ext_vector_type(8)));
typedef float f32x4 __attribute__((ext_vector_type(4)));
typedef float f32x2 __attribute__((ext_vector_type(2)));
typedef unsigned u32x4 __attribute__((ext_vector_type(4)));
typedef unsigned u32x2 __attribute__((ext_vector_type(2)));
typedef LAS unsigned char* ldsp;

constexpr int T = 16384, D = 2048, SEQ = 4096, NC = 32;
constexpr int PLD = 6912;
constexpr int N0 = 6672, N1 = 6664;
constexpr int P0_K = 1024, P0_V = 2048, P0_G = 3072, P0_Z = 4096, P0_XBC = 5120, P0_DT = 6656;
constexpr int P1_K = 1536, P1_V = 3072, P1_O = 4608, P1_I = 6144, P1_F = 6148, P1_U = 6152;
constexpr float EPS = 1e-6f;
constexpr int NPHASE = 20;

constexpr size_t MiB = 1u << 20;
constexpr size_t WS_CTL = 0, CTL_BYTES = 1 * MiB;
constexpr size_t WS_COS = 1 * MiB, WS_SIN = 2 * MiB;
constexpr size_t WS_RT = 3 * MiB;
constexpr size_t WS_S5T = 4 * MiB;
constexpr size_t WS_SMALL = 5 * MiB;
constexpr size_t WS_WIN0 = 8 * MiB, WS_WOUT0 = 35 * MiB, WS_WIN1 = 43 * MiB, WS_WOUT1 = 70 * MiB, WS_WGLU = 78 * MiB;
constexpr size_t WS_WGU = 80 * MiB, WS_WD = 208 * MiB;
constexpr size_t WS_XN = 272 * MiB, WS_MIX = 336 * MiB, WS_HID = 400 * MiB, WS_PROJ = 440 * MiB, WS_Y = WS_PROJ;
constexpr size_t WS_STATE = 656 * MiB;
constexpr size_t WS_RET_DS = WS_STATE, WS_RET_S = WS_STATE + 64 * MiB, WS_SSD_DS = WS_STATE + 96 * MiB, WS_SSD_S = WS_STATE + 160 * MiB;
constexpr size_t WS_MC = WS_STATE;
constexpr size_t WS_MN = WS_STATE + 144 * MiB;
constexpr size_t WS_S5E = WS_STATE + 146 * MiB;
constexpr size_t WS_Y5 = WS_STATE + 150 * MiB;
constexpr size_t WS_LIST = 856 * MiB;
constexpr size_t WS_SLOT = 858 * MiB;
constexpr size_t WS_END = 860 * MiB;
constexpr int CW_BAR = 4096;
constexpr int CW_CNT = 16384;

constexpr int LDS_TAB = 131072;
constexpr int LDS_CTL = 146944;
constexpr int LDS_BYTES = 147456;

typedef __bf16 bf16x2_t __attribute__((ext_vector_type(2)));
DI unsigned pk2(float lo, float hi) { const f32x2 v = {lo, hi}; const bf16x2_t r = __builtin_convertvector(v, bf16x2_t); return __builtin_bit_cast(unsigned, r); }
DI float bflo(unsigned w) { return __uint_as_float(w << 16); }
DI float bfhi(unsigned w) { return __uint_as_float(w & 0xffff0000u); }
DI float bf2f(bf16_t b) { return __uint_as_float(((unsigned)b) << 16); }
DI bf16_t f2bf(float f) { return (bf16_t)(pk2(f, 0.f) & 0xffffu); }
DI float sigmoid_(float x) { return __builtin_amdgcn_rcpf(1.f + __expf(-x)); }
DI float silu_(float x) { return x * sigmoid_(x); }
DI float softplus_(float x) { return x > 20.f ? x : log1pf(__expf(x)); }
DI float logsigmoid_(float x) { return -softplus_(-x); }
DI float gelu_(float x) { const float u = 0.7978845608f * (x + 0.044715f * x * x * x); const float t = 1.f - 2.f * __builtin_amdgcn_rcpf(1.f + __expf(2.f * u)); return 0.5f * x * (1.f + t); }
DI float wsum(float v) {
#pragma unroll
    for (int o = 1; o < 64; o <<= 1) v += __shfl_xor(v, o);
    return v; }
DI float wmax(float v) {
#pragma unroll
    for (int o = 1; o < 64; o <<= 1) v = fmaxf(v, __shfl_xor(v, o));
    return v; }
DI void unpack8(const u32x4 v, float (&f)[8]) { f[0] = bflo(v.x); f[1] = bfhi(v.x); f[2] = bflo(v.y); f[3] = bfhi(v.y); f[4] = bflo(v.z); f[5] = bfhi(v.z); f[6] = bflo(v.w); f[7] = bfhi(v.w); }
DI u32x4 pack8(const float (&f)[8]) { u32x4 o; o.x = pk2(f[0], f[1]); o.y = pk2(f[2], f[3]); o.z = pk2(f[4], f[5]); o.w = pk2(f[6], f[7]); return o; }
#define LDS_WAIT() asm volatile("s_waitcnt lgkmcnt(0)" ::: "memory")
DI void wscan_sum(float a0, float a1, int lane, float& c0, float& c1) {
    const float s = a0 + a1; float x = s;
#pragma unroll
    for (int o = 1; o < 64; o <<= 1) { const float y = __shfl_up(x, o); if (lane >= o) x += y; }
    const float ex = x - s; c0 = ex + a0; c1 = c0 + a1; }
DI void wscan_max(float a0, float a1, int lane, float& c0, float& c1) {
    const float s = fmaxf(a0, a1); float x = s;
#pragma unroll
    for (int o = 1; o < 64; o <<= 1) { const float y = __shfl_up(x, o); if (lane >= o) x = fmaxf(x, y); }
    float ex = __shfl_up(x, 1); if (lane == 0) ex = -INFINITY;
    c0 = fmaxf(ex, a0); c1 = fmaxf(c0, a1); }

namespace pg8 {
constexpr int BM = 256, BK = 64, HALF = 128, HTB = HALF * BK * 2, STAGE_BYTES = 8 * HTB;
DI int lds_byte(int r, int c) { const int st = (r >> 4) * 2 + (c >> 5), rr = r & 15, cc = c & 31, ob = rr * 64 + cc * 2; return st * 1024 + (ob ^ (((ob >> 9) & 1) << 5)); }
DI void stage_rc(int b, int& R, int& C) { const int st = b / 1024, sb = b % 1024, swz = sb ^ (((sb >> 9) & 1) << 5); R = (st >> 1) * 16 + swz / 64; C = (st & 1) * 32 + (swz % 64) / 2; }
DI int perm32(int rho) { const int n = rho >> 4, i = rho & 15; return 8 * (i >> 2) + 4 * n + (i & 3); }
struct Unit { const char* A; const char* B; int row0, col0, aux; };
typedef f32x4 Acc[2][2][4][2];

template <class Epi, class Sched, bool GATHER>
DI void gemm_phase(ldsp lds, const int K, const int lda, const int ldb, const Sched& S, const Epi& E) {
    const int tid = threadIdx.x, wid = __builtin_amdgcn_readfirstlane(tid >> 6), lane = tid & 63, wr = wid >> 2, wc = wid & 3, fr = lane & 15, fq = lane >> 4;
    const int nt = K / BK;
    unsigned voffA[2], voffB[2]; int RA[2], CA[2];
#pragma unroll
    for (int i = 0; i < 2; ++i) { int R, C; stage_rc(tid * 16 + i * 8192, R, C); const int Rb = Epi::PERM ? ((R & ~31) + perm32(R & 31)) : R;
        RA[i] = R; CA[i] = C; voffA[i] = (unsigned)(R * lda + C) * 2u; voffB[i] = (unsigned)(Rb * ldb + C) * 2u; }
    const unsigned hstepA = (unsigned)HALF * (unsigned)lda * 2u, hstepB = (unsigned)HALF * (unsigned)ldb * 2u;
    const size_t kstep = (size_t)(BK * 2);
    const unsigned ldsw = (unsigned)wid * 1024u;
    const int aoff = lds_byte(wr * 64 + fr, fq * 8), boff = lds_byte(wc * 32 + fr, fq * 8);
    unsigned vc[2][2], vn[2][2];
#define PG8_SA(b, h) (((b) * 2 + (h)) * HTB)
#define PG8_SB(b, h) ((4 + (b) * 2 + (h)) * HTB)
#define PG8_AOFF(h, i, NX) (GATHER ? ((NX) ? vn[h][i] : vc[h][i]) : (voffA[i] + (unsigned)(h) * hstepA))
#define PG8_STAGE_A(bufoff, gbase, h, NX) do { _Pragma("unroll") for (int _i = 0; _i < 2; ++_i) \
        __builtin_amdgcn_global_load_lds((const unsigned*)((const char*)(gbase) + PG8_AOFF(h, _i, NX)), (LAS unsigned*)(lds + (bufoff) + ldsw + _i * 8192), 16, 0, 0); } while (0)
#define PG8_STAGE_B(bufoff, gbase) do { _Pragma("unroll") for (int _i = 0; _i < 2; ++_i) \
        __builtin_amdgcn_global_load_lds((const unsigned*)((const char*)(gbase) + voffB[_i]), (LAS unsigned*)(lds + (bufoff) + ldsw + _i * 8192), 16, 0, 0); } while (0)
#define PG8_LDA(dst, b, h) do { _Pragma("unroll") for (int m = 0; m < 4; ++m) _Pragma("unroll") for (int k = 0; k < 2; ++k) dst[m][k] = *(const LAS bf16x8*)(lds + PG8_SA(b, h) + aoff + m * 2048 + k * 1024); } while (0)
#define PG8_LDB(dst, b, h) do { _Pragma("unroll") for (int n = 0; n < 2; ++n) _Pragma("unroll") for (int k = 0; k < 2; ++k) dst[n][k] = *(const LAS bf16x8*)(lds + PG8_SB(b, h) + boff + n * 2048 + k * 1024); } while (0)
#define PG8_MMA(ai, bj, At, Bt) do { __builtin_amdgcn_s_setprio(1); _Pragma("unroll") for (int m = 0; m < 4; ++m) _Pragma("unroll") for (int n = 0; n < 2; ++n) _Pragma("unroll") for (int k = 0; k < 2; ++k) \
        acc[ai][bj][m][n] = __builtin_amdgcn_mfma_f32_16x16x32_bf16(Bt[n][k], At[m][k], acc[ai][bj][m][n], 0, 0, 0); __builtin_amdgcn_s_setprio(0); } while (0)
#define PG8_WAIT_V(n) asm volatile("s_waitcnt vmcnt(" #n ")" ::: "memory")
#define PG8_WAIT_L(n) asm volatile("s_waitcnt lgkmcnt(" #n ")" ::: "memory")
#define PG8_BAR __builtin_amdgcn_s_barrier()
#define PG8_SCHED __builtin_amdgcn_sched_barrier(0)
    Unit cur, nxt; int ui = 0;
    if (!S.next(0, cur)) return;
    Acc acc;
#pragma unroll
    for (int a = 0; a < 2; ++a)
#pragma unroll
        for (int b = 0; b < 2; ++b)
#pragma unroll
            for (int m = 0; m < 4; ++m)
#pragma unroll
                for (int n = 0; n < 2; ++n) acc[a][b][m][n] = (f32x4){0.f, 0.f, 0.f, 0.f};
    bf16x8 At[4][2], B0[2][2], B1[2][2];
    const char* cA = cur.A; const char* cB = cur.B;
    if constexpr (GATHER) {
#pragma unroll
        for (int h = 0; h < 2; ++h)
#pragma unroll
            for (int i = 0; i < 2; ++i) { vc[h][i] = ((unsigned)S.grow(cur, RA[i] + 128 * h) * (unsigned)lda + (unsigned)CA[i]) * 2u; vn[h][i] = vc[h][i]; }
    }
    PG8_STAGE_B(PG8_SB(0, 0), cB); PG8_STAGE_B(PG8_SB(0, 1), cB + hstepB); PG8_STAGE_A(PG8_SA(0, 0), cA, 0, false); PG8_STAGE_A(PG8_SA(0, 1), cA, 1, false);
    if (wr == 1) PG8_BAR;
    PG8_WAIT_V(2); PG8_BAR;
    PG8_STAGE_B(PG8_SB(1, 0), cB + kstep); PG8_STAGE_A(PG8_SA(1, 0), cA + kstep, 0, false); PG8_STAGE_B(PG8_SB(1, 1), cB + hstepB + kstep);
    PG8_WAIT_V(6); PG8_BAR;
    for (;;) {
        const bool has_next = S.next(ui + 1, nxt);
        const char* nA = has_next ? nxt.A : cA; const char* nB = has_next ? nxt.B : cB;
        if constexpr (GATHER) {
            if (has_next) {
#pragma unroll
                for (int h = 0; h < 2; ++h)
#pragma unroll
                    for (int i = 0; i < 2; ++i) vn[h][i] = ((unsigned)S.grow(nxt, RA[i] + 128 * h) * (unsigned)lda + (unsigned)CA[i]) * 2u;
            }
        }
        for (int t = 0; t < nt; t += 2) {
            const bool last = (t == nt - 2);
            const char* a1 = cA + (size_t)(t + 1) * kstep;
            const char* a2 = last ? nA : cA + (size_t)(t + 2) * kstep; const char* b2 = last ? nB : cB + (size_t)(t + 2) * kstep;
            const char* a3 = a2 + kstep; const char* b3 = b2 + kstep;
            PG8_LDB(B0, 0, 0); PG8_LDB(B1, 0, 1); PG8_SCHED; PG8_LDA(At, 0, 0); PG8_STAGE_A(PG8_SA(1, 1), a1, 1, false);
            PG8_WAIT_V(8); PG8_WAIT_L(0); PG8_BAR; PG8_MMA(0, 0, At, B0); PG8_MMA(0, 1, At, B1); PG8_BAR; PG8_SCHED;
            PG8_LDA(At, 0, 1); PG8_STAGE_B(PG8_SB(0, 0), b2); PG8_STAGE_B(PG8_SB(0, 1), b2 + hstepB); PG8_STAGE_A(PG8_SA(0, 0), a2, 0, last);
            PG8_WAIT_V(8); PG8_WAIT_L(0); PG8_BAR; PG8_MMA(1, 0, At, B0); PG8_MMA(1, 1, At, B1); PG8_BAR; PG8_SCHED;
            PG8_LDB(B0, 1, 0); PG8_LDB(B1, 1, 1); PG8_SCHED; PG8_LDA(At, 1, 0); PG8_STAGE_A(PG8_SA(0, 1), a2, 1, last);
            PG8_WAIT_V(8); PG8_WAIT_L(0); PG8_BAR; PG8_MMA(0, 0, At, B0); PG8_MMA(0, 1, At, B1); PG8_BAR; PG8_SCHED;
            PG8_LDA(At, 1, 1); PG8_STAGE_B(PG8_SB(1, 0), b3); PG8_STAGE_B(PG8_SB(1, 1), b3 + hstepB); PG8_STAGE_A(PG8_SA(1, 0), a3, 0, last);
            PG8_WAIT_V(8); PG8_WAIT_L(0); PG8_BAR; PG8_MMA(1, 0, At, B0); PG8_MMA(1, 1, At, B1); PG8_BAR; PG8_SCHED;
        }
        if (wr == 0) PG8_BAR;
        E(acc, cur, wr, wc, fr, fq);
        if (!has_next) break;
#pragma unroll
        for (int a = 0; a < 2; ++a)
#pragma unroll
            for (int b = 0; b < 2; ++b)
#pragma unroll
                for (int m = 0; m < 4; ++m)
#pragma unroll
                    for (int n = 0; n < 2; ++n) acc[a][b][m][n] = (f32x4){0.f, 0.f, 0.f, 0.f};
        cur = nxt; cA = nA; cB = nB; ++ui;
        if constexpr (GATHER) {
#pragma unroll
            for (int h = 0; h < 2; ++h)
#pragma unroll
                for (int i = 0; i < 2; ++i) vc[h][i] = vn[h][i];
        }
        if (wr == 1) PG8_BAR;
    }
    PG8_WAIT_V(0);
    PG8_BAR;
#undef PG8_SA
#undef PG8_SB
#undef PG8_AOFF
#undef PG8_STAGE_A
#undef PG8_STAGE_B
#undef PG8_LDA
#undef PG8_LDB
#undef PG8_MMA
#undef PG8_WAIT_V
#undef PG8_WAIT_L
#undef PG8_BAR
#undef PG8_SCHED
}

struct Tile2D {
    const char* A; const char* B; int nM, nN, nwg, G, c; size_t tA, tB;
    DI void init(const void* A_, const void* B_, int M, int N, int lda, int ldb, int G_, int c_) { A = (const char*)A_; B = (const char*)B_; nM = M / 256; nN = N / 256; nwg = nM * nN; G = G_; c = c_; tA = (size_t)256 * lda * 2; tB = (size_t)256 * ldb * 2; }
    DI bool next(int i, Unit& u) const {
        const long L = (long)i * G + c; if (L >= nwg) return false;
        int wgid = (int)L; { const int q = nwg / 8, r = nwg % 8, xcd = wgid % 8, off = wgid / 8; wgid = (xcd < r ? xcd * (q + 1) : r * (q + 1) + (xcd - r) * q) + off; }
        const int nig = 8 * nN, gid = wgid / nig, fm = gid * 8, gsz = (nM - fm) < 8 ? (nM - fm) : 8;
        const int pm = fm + ((wgid % nig) % gsz), pn = (wgid % nig) / gsz;
        u.A = A + (size_t)pm * tA; u.B = B + (size_t)pn * tB; u.row0 = pm * 256; u.col0 = pn * 256; u.aux = 0; return true;
    }
    DI int grow(const Unit&, int) const { return 0; }
};
struct GluOrder { Tile2D t; DI bool next(int i, Unit& u) const { if (!t.next(i, u)) return false; u.col0 >>= 1; return true; } DI int grow(const Unit&, int) const { return 0; } };
struct MoeGU {
    const char* XN; const char* W; const LAS int* tile_e; const LAS int* gtab; int nunits, G, c;
    DI bool next(int i, Unit& u) const {
        const int L = i * G + c; if (L >= nunits || i >= 4) return false;
        const int gm = L >> 2, j = L & 3, e = tile_e[gm];
        u.A = XN; u.B = W + ((size_t)e * 1024 + (size_t)j * 256) * 2048 * 2; u.row0 = gm * 256; u.col0 = j * 128; u.aux = i; return true;
    }
    DI int grow(const Unit& u, int r) const { return gtab[u.aux * 256 + r]; }
};
struct MoeDown {
    const char* HID; const char* W; const LAS int* tile_e; int nunits, G, c;
    DI bool next(int i, Unit& u) const {
        const int L = i * G + c; if (L >= nunits) return false;
        const int gm = L >> 3, pn = L & 7, e = tile_e[gm];
        u.A = HID + (size_t)gm * 256 * 512 * 2; u.B = W + ((size_t)e * 2048 + (size_t)pn * 256) * 512 * 2; u.row0 = gm * 256; u.col0 = pn * 256; u.aux = e; return true;
    }
    DI int grow(const Unit&, int) const { return 0; }
};

struct EpiBf16 {
    static constexpr bool PERM = true;
    bf16_t* O; int ldc;
    DI void operator()(const Acc& acc, const Unit& u, int wr, int wc, int fr, int fq) const {
#pragma unroll
        for (int ai = 0; ai < 2; ++ai)
#pragma unroll
            for (int m = 0; m < 4; ++m) { bf16_t* rowp = O + (size_t)(u.row0 + ai * HALF + wr * 64 + m * 16 + fr) * ldc + u.col0 + wc * 32 + 8 * fq;
#pragma unroll
                for (int bj = 0; bj < 2; ++bj) { const f32x4 v0 = acc[ai][bj][m][0], v1 = acc[ai][bj][m][1];
                    u32x4 w; w.x = pk2(v0[0], v0[1]); w.y = pk2(v0[2], v0[3]); w.z = pk2(v1[0], v1[1]); w.w = pk2(v1[2], v1[3]);
                    *(u32x4*)(rowp + bj * HALF) = w; } }
    }
};
struct EpiResF32 {
    static constexpr bool PERM = false;
    const float* res; float* out; int ldc;
    DI void operator()(const Acc& acc, const Unit& u, int wr, int wc, int fr, int fq) const {
#pragma unroll
        for (int ai = 0; ai < 2; ++ai)
#pragma unroll
            for (int m = 0; m < 4; ++m) { const size_t off = (size_t)(u.row0 + ai * HALF + wr * 64 + m * 16 + fr) * ldc + u.col0 + wc * 32 + 4 * fq;
#pragma unroll
                for (int bj = 0; bj < 2; ++bj)
#pragma unroll
                    for (int n = 0; n < 2; ++n) { const f32x4 r = *(const f32x4*)(res + off + bj * HALF + n * 16); *(f32x4*)(out + off + bj * HALF + n * 16) = r + acc[ai][bj][m][n]; } }
    }
};
struct EpiGateUp {
    static constexpr bool PERM = true;
    bf16_t* O; int ldc;
    DI void operator()(const Acc& acc, const Unit& u, int wr, int wc, int fr, int fq) const {
#pragma unroll
        for (int ai = 0; ai < 2; ++ai)
#pragma unroll
            for (int m = 0; m < 4; ++m) { bf16_t* rowp = O + (size_t)(u.row0 + ai * HALF + wr * 64 + m * 16 + fr) * ldc + u.col0 + wc * 32 + 8 * fq;
                float o[8];
#pragma unroll
                for (int n = 0; n < 2; ++n)
#pragma unroll
                    for (int j = 0; j < 4; ++j) o[n * 4 + j] = silu_(acc[ai][0][m][n][j]) * acc[ai][1][m][n][j];
                *(u32x4*)rowp = pack8(o); }
    }
};
struct EpiGlu {
    static constexpr bool PERM = true;
    bf16_t* O; int ldc; const float* bias;
    DI void operator()(const Acc& acc, const Unit& u, int wr, int wc, int fr, int fq) const {
        const int cb = u.col0 + wc * 32 + 8 * fq;
        float bv[8], bg[8];
#pragma unroll
        for (int j = 0; j < 8; ++j) { bv[j] = bias[cb + j]; bg[j] = bias[512 + cb + j]; }
#pragma unroll
        for (int ai = 0; ai < 2; ++ai)
#pragma unroll
            for (int m = 0; m < 4; ++m) { bf16_t* rowp = O + (size_t)(u.row0 + ai * HALF + wr * 64 + m * 16 + fr) * ldc + cb;
                float o[8];
#pragma unroll
                for (int n = 0; n < 2; ++n)
#pragma unroll
                    for (int j = 0; j < 4; ++j) o[n * 4 + j] = (acc[ai][0][m][n][j] + bv[n * 4 + j]) * sigmoid_(acc[ai][1][m][n][j] + bg[n * 4 + j]);
                *(u32x4*)rowp = pack8(o); }
    }
};
}

#define XB_TMO      128
#define XB_XCNT(j)  (256  + 64 * (j))
#define XB_XSUB(j)  (1280 + 64 * (j))
#define XB_XGEN(j)  (2304 + 64 * (j))
#define XB_TOP      3328
#define XB_TOPGEN   3392
#define XCD_BAR_WORDS 3456
#define XB_SPIN_CAP (1u << 18)
__device__ __forceinline__ unsigned xb_ld(unsigned* p)              { return __hip_atomic_load(p, __ATOMIC_RELAXED, __HIP_MEMORY_SCOPE_AGENT); }
__device__ __forceinline__ unsigned xb_add(unsigned* p, unsigned v) { return __hip_atomic_fetch_add(p, v, __ATOMIC_RELAXED, __HIP_MEMORY_SCOPE_AGENT); }
__device__ __forceinline__ unsigned xb_xcc_id() { return (unsigned)__builtin_amdgcn_s_getreg((3 << 11) | 20) & 0xFu; }
#define XB_SPIN(cond, bar) do { unsigned _sp = 0; while (cond) { __builtin_amdgcn_s_sleep(1); \
    if ((++_sp & 255u) == 0u) { if (xb_ld(&(bar)[XB_TMO])) break; if (_sp > XB_SPIN_CAP) { atomicAdd(&(bar)[XB_TMO], 1u); break; } } } } while (0)
struct XcdBarrier { unsigned* bar; unsigned x; volatile LAS unsigned* st; };
__device__ __forceinline__ XcdBarrier xcd_barrier_post(unsigned* bar, volatile LAS unsigned* st) {
    XcdBarrier b; b.bar = bar; b.x = xb_xcc_id(); b.st = st;
    if (threadIdx.x == 0) (void)xb_add(&bar[XB_XCNT(b.x)], 1u);
    return b;
}
__device__ __forceinline__ void xcd_barrier_complete(unsigned* bar, unsigned x, unsigned& nloc, unsigned& nx) {
    const unsigned G = gridDim.x * gridDim.y * gridDim.z;
    unsigned sum, cnt, mine, sp = 0u;
    for (;;) {
        sum = 0u; cnt = 0u; mine = 0u;
#pragma unroll
        for (unsigned j = 0; j < 16; ++j) { const unsigned c = xb_ld(&bar[XB_XCNT(j)]); sum += c; cnt += (c > 0u) ? 1u : 0u; mine = (j == x) ? c : mine; }
        if (sum == G) break;
        __builtin_amdgcn_s_sleep(1);
        if ((++sp & 255u) == 0u) { if (xb_ld(&bar[XB_TMO])) break; if (sp > XB_SPIN_CAP) { atomicAdd(&bar[XB_TMO], 1u); break; } }
    }
    nloc = mine > 0u ? mine : 1u; nx = cnt > 0u ? cnt : 1u;
}
__device__ __forceinline__ void xcd_barrier(const XcdBarrier& b) {
    asm volatile("s_waitcnt vmcnt(0)" ::: "memory");
    __syncthreads();
    if (threadIdx.x == 0) {
        unsigned* bar = b.bar;
        __builtin_amdgcn_s_waitcnt(0);
        unsigned nloc = b.st[0], nx = b.st[1];
        if (nloc == 0u) { xcd_barrier_complete(bar, b.x, nloc, nx); b.st[0] = nloc; b.st[1] = nx; }
        const unsigned old = xb_add(&bar[XB_XSUB(b.x)], 1u);
        const unsigned gen = old / nloc;
        if (old + 1u == (gen + 1u) * nloc) {
            __builtin_amdgcn_fence(__ATOMIC_RELEASE, "agent");
            asm volatile("s_waitcnt vmcnt(0)" ::: "memory");
            const unsigned og = xb_add(&bar[XB_TOP], 1u);
            const unsigned tg = og / nx;
            if (og + 1u == (tg + 1u) * nx) xb_add(&bar[XB_TOPGEN], 1u);
            else XB_SPIN(xb_ld(&bar[XB_TOPGEN]) == tg, bar);
            __builtin_amdgcn_fence(__ATOMIC_ACQUIRE, "agent");
            xb_add(&bar[XB_XGEN(b.x)], 1u);
            asm volatile("s_waitcnt vmcnt(0)" ::: "memory");
        } else {
            XB_SPIN(xb_ld(&bar[XB_XGEN(b.x)]) == gen, bar);
            __builtin_amdgcn_fence(__ATOMIC_ACQUIRE, "agent");
            asm volatile("s_waitcnt vmcnt(0)" ::: "memory");
        }
    }
    __syncthreads();
}

struct Args { const float* in[38]; float* out; unsigned char* ws; int ph_lo, ph_hi; };
enum { I_X = 0, I_EVEN_NORM, I_EVEN_WIN, I_RET_NORM, I_SSD_CONVW, I_SSD_CONVB, I_SSD_DTB, I_SSD_ALOG, I_SSD_D, I_SSD_NORM, I_EVEN_WOUT, I_ODD_NORM, I_ODD_WIN, I_ML_CONVW, I_ML_CONVB,
       I_ML_IB, I_ML_FB, I_ML_NORM, I_S5_ARE, I_S5_AIM, I_S5_LOGDT, I_S5_BRE, I_S5_BIM, I_S5_CRE, I_S5_CIM, I_S5_D, I_S5_WGLU, I_S5_BGLU, I_ODD_WOUT, I_MOE_NORM, I_MOE_RG, I_MOE_RGB,
       I_MOE_RE, I_MOE_REB, I_MOE_WG, I_MOE_WU, I_MOE_WD, I_FINAL_NORM };

struct Frame { ldsp lds; int tid, lane, wave, G, bx; unsigned char* ws; };

template <int NT, int KS>
DI void mma16(f32x4 (&acc)[NT], ldsp Arows, int pitchA, ldsp Bt, int pitchB, int fr, int fq, int nt_lim = NT, int ks_lim = KS) {
#pragma unroll
    for (int ks = 0; ks < KS; ++ks) {
        if (ks < ks_lim) {
            const bf16x8 a = *(const LAS bf16x8*)(Arows + fr * pitchA + (ks * 32 + fq * 8) * 2);
#pragma unroll
            for (int nt = 0; nt < NT; ++nt)
                if (nt < nt_lim) { const bf16x8 b = *(const LAS bf16x8*)(Bt + (nt * 16 + fr) * pitchB + (ks * 32 + fq * 8) * 2);
                    acc[nt] = __builtin_amdgcn_mfma_f32_16x16x32_bf16(b, a, acc[nt], 0, 0, 0); }
        }
    }
}
template <int NT> DI void zero_acc(f32x4 (&acc)[NT]) {
#pragma unroll
    for (int i = 0; i < NT; ++i) acc[i] = (f32x4){0.f, 0.f, 0.f, 0.f}; }

DI void conv8(const bf16_t* P, int pos, const float* cw, int C, const float* cb, float (&y)[8]) {
    const f32x4 b0 = *(const f32x4*)cb, b1 = *(const f32x4*)(cb + 4);
    y[0] = b0[0]; y[1] = b0[1]; y[2] = b0[2]; y[3] = b0[3]; y[4] = b1[0]; y[5] = b1[1]; y[6] = b1[2]; y[7] = b1[3];
#pragma unroll
    for (int tap = 0; tap < 4; ++tap) {
        if (pos - 3 + tap >= 0) {
            const u32x4 xv = *(const u32x4*)(P + (ptrdiff_t)(tap - 3) * PLD); float x[8]; unpack8(xv, x);
            const f32x4 w0 = *(const f32x4*)(cw + tap * C), w1 = *(const f32x4*)(cw + tap * C + 4);
            y[0] += w0[0] * x[0]; y[1] += w0[1] * x[1]; y[2] += w0[2] * x[2]; y[3] += w0[3] * x[3];
            y[4] += w1[0] * x[4]; y[5] += w1[1] * x[5]; y[6] += w1[2] * x[6]; y[7] += w1[3] * x[7];
        }
    }
}

DI void tr_item(const float* W, int N, bf16_t* WT, int ldt, int k0, int n0, int drow0, LAS float* scr, int lane) {
    const int n = n0 + (lane & 31);
#pragma unroll 8
    for (int i = 0; i < 32; ++i) { const int kk = 2 * i + (lane >> 5); scr[kk * 33 + (lane & 31)] = (n < N) ? W[(size_t)(k0 + kk) * N + n] : 0.f; }
    LDS_WAIT();
    const int c = lane & 7;
#pragma unroll
    for (int j = 0; j < 4; ++j) { const int nn = (lane >> 3) + 8 * j; const LAS float* s = scr + (8 * c) * 33 + nn;
        u32x4 o; o.x = pk2(s[0 * 33], s[1 * 33]); o.y = pk2(s[2 * 33], s[3 * 33]); o.z = pk2(s[4 * 33], s[5 * 33]); o.w = pk2(s[6 * 33], s[7 * 33]);
        *(u32x4*)(WT + (size_t)(drow0 + nn) * ldt + k0 + 8 * c) = o; }
    LDS_WAIT();
}
DI void moe_convert(const Frame& F, const Args& a, int layer) {
    LAS float* scr = (LAS float*)(F.lds + F.wave * 16384);
    const int gw = F.bx * 8 + F.wave, NGW = F.G * 8;
    bf16_t* Wgu = (bf16_t*)(F.ws + WS_WGU); bf16_t* Wd = (bf16_t*)(F.ws + WS_WD);
    for (int it = gw; it < 3 * 16384; it += NGW) {
        const int mat = it >> 14, r = it & 16383, e = r >> 9, q = r & 511;
        if (mat < 2) { const int kb = q >> 4, nb = q & 15, n0 = nb * 32;
            const float* src = a.in[mat == 0 ? I_MOE_WG : I_MOE_WU] + (size_t)(layer * 32 + e) * 2048 * 512;
            tr_item(src, 512, Wgu + (size_t)e * 1024 * 2048, 2048, kb * 64, n0, (n0 >> 7) * 256 + (mat ? 128 : 0) + (n0 & 127), scr, F.lane);
        } else { const int kb = q >> 6, nb = q & 63, n0 = nb * 32;
            const float* src = a.in[I_MOE_WD] + (size_t)(layer * 32 + e) * 512 * 2048;
            tr_item(src, 2048, Wd + (size_t)e * 2048 * 512, 512, kb * 64, n0, n0, scr, F.lane); }
    }
}
DI void norm_row_bf16(const float* xr, const float* g, bf16_t* o, int lane) {
    f32x4 v[8]; float ss = 0.f;
#pragma unroll
    for (int j = 0; j < 8; ++j) { v[j] = *(const f32x4*)(xr + (lane + 64 * j) * 4); ss += v[j][0] * v[j][0] + v[j][1] * v[j][1] + v[j][2] * v[j][2] + v[j][3] * v[j][3]; }
    const float rstd = rsqrtf(wsum(ss) * (1.f / D) + EPS);
#pragma unroll
    for (int j = 0; j < 8; ++j) { const f32x4 gg = *(const f32x4*)(g + (lane + 64 * j) * 4);
        u32x2 w; w.x = pk2(v[j][0] * rstd * gg[0], v[j][1] * rstd * gg[1]); w.y = pk2(v[j][2] * rstd * gg[2], v[j][3] * rstd * gg[3]);
        *(u32x2*)(o + (lane + 64 * j) * 4) = w; }
}
DI void phase_prologue(const Frame& F, const Args& a) {
    LAS float* scr = (LAS float*)(F.lds + F.wave * 16384);
    const int gw = F.bx * 8 + F.wave, NGW = F.G * 8;
    bf16_t* Win0 = (bf16_t*)(F.ws + WS_WIN0); bf16_t* Wout0 = (bf16_t*)(F.ws + WS_WOUT0); bf16_t* Win1 = (bf16_t*)(F.ws + WS_WIN1); bf16_t* Wout1 = (bf16_t*)(F.ws + WS_WOUT1); bf16_t* Wglu = (bf16_t*)(F.ws + WS_WGLU);
    constexpr int I_IN = 32 * 209, I_OUT = 32 * 64, I_GLU = 8 * 32;
    for (int it = gw; it < 2 * I_IN + 2 * I_OUT + I_GLU; it += NGW) {
        int r = it;
        if (r < I_IN) { tr_item(a.in[I_EVEN_WIN], N0, Win0, 2048, (r / 209) * 64, (r % 209) * 32, (r % 209) * 32, scr, F.lane); continue; } r -= I_IN;
        if (r < I_IN) { tr_item(a.in[I_ODD_WIN], N1, Win1, 2048, (r / 209) * 64, (r % 209) * 32, (r % 209) * 32, scr, F.lane); continue; } r -= I_IN;
        if (r < I_OUT) { tr_item(a.in[I_EVEN_WOUT], 2048, Wout0, 2048, (r >> 6) * 64, (r & 63) * 32, (r & 63) * 32, scr, F.lane); continue; } r -= I_OUT;
        if (r < I_OUT) { tr_item(a.in[I_ODD_WOUT], 2048, Wout1, 2048, (r >> 6) * 64, (r & 63) * 32, (r & 63) * 32, scr, F.lane); continue; } r -= I_OUT;
        { const int kb = r >> 5, nb = r & 31, n0 = nb * 32, nn = n0 & 511;
          tr_item(a.in[I_S5_WGLU], 1024, Wglu, 512, kb * 64, n0, (nn >> 7) * 256 + (n0 >= 512 ? 128 : 0) + (nn & 127), scr, F.lane); }
    }
    moe_convert(F, a, 0);
    const int gt = F.bx * 512 + F.tid, NT_ = F.G * 512;
    for (int i = gt; i < 2 * 224 * 256; i += NT_) { const int l = i / (224 * 256), r = i % (224 * 256); *(u32x4*)((l ? Win1 : Win0) + (size_t)6688 * 2048 + (size_t)r * 8) = (u32x4){0u, 0u, 0u, 0u}; }
    float* COS = (float*)(F.ws + WS_COS); float* SIN = (float*)(F.ws + WS_SIN);
    for (int i = gt; i < 4096 * 64; i += NT_) { const int pos = i >> 6, k = i & 63; const float inv = 1.0f / powf(10000.f, (float)(2 * k) / 128.f); const float ang = (float)pos * inv; COS[i] = cosf(ang); SIN[i] = sinf(ang); }
    float* RT = (float*)(F.ws + WS_RT);
    for (int i = gt; i < 2 * 48 * 2048; i += NT_) { const int l = i / (48 * 2048), r = i % (48 * 2048), j = r >> 11, k = r & 2047; const float g = a.in[I_MOE_NORM][l * 2048 + k];
        float w = 0.f; if (j < 4) w = a.in[I_MOE_RG][(size_t)(l * 2048 + k) * 4 + j]; else if (j < 36) w = a.in[I_MOE_RE][(size_t)(l * 2048 + k) * 32 + (j - 4)];
        RT[i] = g * w; }
    { f32x2* ABAR = (f32x2*)(F.ws + WS_S5T); f32x2* A128 = ABAR + 2048; float* BBAR = (float*)(F.ws + WS_S5T + 32768);
      for (int i = gt; i < 2048; i += NT_) { const int g = i >> 6;
          const double dt = exp((double)a.in[I_S5_LOGDT][g]), are = a.in[I_S5_ARE][i], aim = a.in[I_S5_AIM][i];
          const double mag = exp(are * dt), br = mag * cos(aim * dt), bi = mag * sin(aim * dt);
          const double m128 = exp(128.0 * are * dt);
          ABAR[i] = (f32x2){(float)br, (float)bi}; A128[i] = (f32x2){(float)(m128 * cos(128.0 * aim * dt)), (float)(m128 * sin(128.0 * aim * dt))};
          const double den = are * are + aim * aim, nr = br - 1.0, cr = (nr * are + bi * aim) / den, ci = (bi * are - nr * aim) / den;
          for (int c = 0; c < 16; ++c) { const double bre = a.in[I_S5_BRE][(size_t)i * 16 + c], bim = a.in[I_S5_BIM][(size_t)i * 16 + c];
              BBAR[(size_t)i * 32 + c] = (float)(cr * bre - ci * bim); BBAR[(size_t)i * 32 + 16 + c] = (float)(cr * bim + ci * bre); } } }
    bf16_t* XN = (bf16_t*)(F.ws + WS_XN);
    for (int m = gw; m < T; m += NGW) norm_row_bf16(a.in[I_X] + (size_t)m * D, a.in[I_EVEN_NORM], XN + (size_t)m * D, F.lane);
}

DI float ret_loggamma(int h) { return log1pf(-exp2f(-5.f - (float)h)); }
DI void rot8(const bf16_t* p, const float* cs, const float* sn, float scale, float (&r1)[8], float (&r2)[8]) {
    float a[8], b[8]; unpack8(*(const u32x4*)p, a); unpack8(*(const u32x4*)(p + 64), b);
    const f32x4 c0 = *(const f32x4*)cs, c1 = *(const f32x4*)(cs + 4), s0 = *(const f32x4*)sn, s1 = *(const f32x4*)(sn + 4);
    const float c[8] = {c0[0], c0[1], c0[2], c0[3], c1[0], c1[1], c1[2], c1[3]}, s[8] = {s0[0], s0[1], s0[2], s0[3], s1[0], s1[1], s1[2], s1[3]};
#pragma unroll
    for (int j = 0; j < 8; ++j) { r1[j] = (a[j] * c[j] - b[j] * s[j]) * scale; r2[j] = (a[j] * s[j] + b[j] * c[j]) * scale; }
}
constexpr int PT = 272;

DI void ret_local_unit(const Frame& F_, const Args& a, int u) {
    Frame F = F_; { int tz = F_.tid; asm volatile("" : "+v"(tz)); F.tid = tz; F.lane = tz & 63; }
    const int b = u >> 8, c = (u >> 3) & 31, h = u & 7;
    const bf16_t* P = (const bf16_t*)(F.ws + WS_PROJ) + (size_t)(b * SEQ + c * 128) * PLD;
    const float* COS = (const float*)(F.ws + WS_COS); const float* SIN = (const float*)(F.ws + WS_SIN);
    ldsp KT = F.lds, VT = F.lds + 34816;
    const float lg = ret_loggamma(h);
#pragma unroll
    for (int i = 0; i < 2; ++i) { const int item = F.tid + 512 * i, s = item >> 3, d0 = (item & 7) * 8, pos = c * 128 + s;
        float r1[8], r2[8]; rot8(P + (size_t)s * PLD + P0_K + h * 128 + d0, COS + pos * 64 + d0, SIN + pos * 64 + d0, 0.08838834764831845f * __expf(lg * (float)(127 - s)), r1, r2);
#pragma unroll
        for (int j = 0; j < 8; ++j) { *(LAS bf16_t*)(KT + (d0 + j) * PT + s * 2) = f2bf(r1[j]); *(LAS bf16_t*)(KT + (d0 + 64 + j) * PT + s * 2) = f2bf(r2[j]); } }
#pragma unroll
    for (int i = 0; i < 4; ++i) { const int item = F.tid + 512 * i, s = item >> 4, e0 = (item & 15) * 8;
        const u32x4 v = *(const u32x4*)(P + (size_t)s * PLD + P0_V + h * 128 + e0);
        const unsigned w[4] = {v.x, v.y, v.z, v.w};
#pragma unroll
        for (int j = 0; j < 8; ++j) *(LAS bf16_t*)(VT + (e0 + j) * PT + s * 2) = (bf16_t)((j & 1) ? (w[j >> 1] >> 16) : (w[j >> 1] & 0xffffu)); }
    __syncthreads();
    const int fr = F.lane & 15, fq = F.lane >> 4;
    f32x4 acc[8]; zero_acc(acc);
    mma16<8, 4>(acc, VT + (16 * F.wave) * PT, PT, KT, PT, fr, fq);
    float* dst = (float*)(F.ws + WS_RET_DS) + ((size_t)((b * 8 + h) * 32 + c) * 128 + 16 * F.wave + fr) * 128 + fq * 4;
#pragma unroll
    for (int nt = 0; nt < 8; ++nt) *(f32x4*)(dst + nt * 16) = acc[nt];
    __syncthreads();
}

DI void ssd_local_unit(const Frame& F_, const Args& a, int u) {
    Frame F = F_; { int tz = F_.tid; asm volatile("" : "+v"(tz)); F.tid = tz; F.lane = tz & 63; }
    const int b = u >> 7, c = (u >> 2) & 31, g = (u >> 1) & 1, hh = u & 1, hd0 = g * 8 + hh * 4;
    const bf16_t* P = (const bf16_t*)(F.ws + WS_PROJ) + (size_t)(b * SEQ + c * 128) * PLD;
    ldsp XT = F.lds, BT = F.lds + 69632; LAS float* dtv = (LAS float*)(F.lds + 104448); LAS float* acum = (LAS float*)(F.lds + 106496);
    { const int s = F.tid >> 2, r = F.tid & 3; dtv[F.tid] = softplus_(bf2f(P[(size_t)s * PLD + P0_DT + hd0 + r]) + a.in[I_SSD_DTB][hd0 + r]); }
    __syncthreads();
    if (F.wave < 4) { const int r = F.wave; const float A = -__expf(a.in[I_SSD_ALOG][hd0 + r]);
        float c0, c1; wscan_sum(dtv[(2 * F.lane) * 4 + r] * A, dtv[(2 * F.lane + 1) * 4 + r] * A, F.lane, c0, c1);
        acum[(2 * F.lane) * 4 + r] = c0; acum[(2 * F.lane + 1) * 4 + r] = c1;
        if (F.lane == 63) ((float*)(F.ws + WS_SMALL))[(b * 32 + c) * 16 + hd0 + r] = c1; }
    __syncthreads();
    const float* cw = a.in[I_SSD_CONVW]; const float* cb = a.in[I_SSD_CONVB];
#pragma unroll 2
    for (int i = 0; i < 8; ++i) { const int item = F.tid + 512 * i, s = item >> 5, ch = item & 31, r = ch >> 3, p0 = (ch & 7) * 8, xc = (hd0 + r) * 64 + p0;
        float y[8]; conv8(P + (size_t)s * PLD + P0_XBC + xc, c * 128 + s, cw + xc, 1536, cb + xc, y);
        const float sc = dtv[s * 4 + r] * __expf(acum[127 * 4 + r] - acum[s * 4 + r]);
#pragma unroll
        for (int j = 0; j < 8; ++j) *(LAS bf16_t*)(XT + (r * 64 + p0 + j) * PT + s * 2) = f2bf(silu_(y[j]) * sc); }
#pragma unroll 2
    for (int i = 0; i < 4; ++i) { const int item = F.tid + 512 * i, s = item >> 4, n0 = (item & 15) * 8, xc = 1024 + g * 128 + n0;
        float y[8]; conv8(P + (size_t)s * PLD + P0_XBC + xc, c * 128 + s, cw + xc, 1536, cb + xc, y);
#pragma unroll
        for (int j = 0; j < 8; ++j) *(LAS bf16_t*)(BT + (n0 + j) * PT + s * 2) = f2bf(silu_(y[j])); }
    __syncthreads();
    const int fr = F.lane & 15, fq = F.lane >> 4;
#pragma unroll
    for (int rt = 0; rt < 2; ++rt) {
        f32x4 acc[8]; zero_acc(acc);
        mma16<8, 4>(acc, XT + (32 * F.wave + 16 * rt) * PT, PT, BT, PT, fr, fq);
        const int rr = 32 * F.wave + 16 * rt + fr, r = rr >> 6, p = rr & 63;
        float* dst = (float*)(F.ws + WS_SSD_DS) + (((size_t)(b * 32 + c) * 16 + hd0 + r) * 64 + p) * 128 + fq * 4;
#pragma unroll
        for (int nt = 0; nt < 8; ++nt) *(f32x4*)(dst + nt * 16) = acc[nt];
    }
    __syncthreads();
}

DI void phase_even_scan(const Frame& F, const Args& a) {
    const int gt = F.bx * 512 + F.tid, NT_ = F.G * 512;
    for (int i = gt; i < 131072; i += NT_) {
        const int bh = i >> 12, v = i & 4095; const float g128 = __expf(ret_loggamma(bh & 7) * 128.f);
        const float* src = (const float*)(F.ws + WS_RET_DS) + (size_t)bh * 32 * 16384 + v * 4; bf16_t* dst = (bf16_t*)(F.ws + WS_RET_S) + (size_t)bh * 32 * 16384 + v * 4;
        f32x4 run = (f32x4){0.f, 0.f, 0.f, 0.f};
#pragma unroll 8
        for (int c = 0; c < 32; ++c) { const f32x4 x = *(const f32x4*)(src + (size_t)c * 16384);
            u32x2 w; w.x = pk2(run[0], run[1]); w.y = pk2(run[2], run[3]); *(u32x2*)(dst + (size_t)c * 16384) = w; run = run * g128 + x; }
    }
    const float* AEND = (const float*)(F.ws + WS_SMALL);
    for (int i = gt; i < 131072; i += NT_) {
        const int bhd = i >> 11, v = i & 2047, b = bhd >> 4, hd = bhd & 15;
        const float* src = (const float*)(F.ws + WS_SSD_DS) + ((size_t)(b * 32) * 16 + hd) * 8192 + v * 4; bf16_t* dst = (bf16_t*)(F.ws + WS_SSD_S) + ((size_t)(b * 32) * 16 + hd) * 8192 + v * 4;
        f32x4 run = (f32x4){0.f, 0.f, 0.f, 0.f};
#pragma unroll 8
        for (int c = 0; c < 32; ++c) { const f32x4 x = *(const f32x4*)(src + (size_t)c * 16 * 8192); const float dec = __expf(AEND[(b * 32 + c) * 16 + hd]);
            u32x2 w; w.x = pk2(run[0], run[1]); w.y = pk2(run[2], run[3]); *(u32x2*)(dst + (size_t)c * 16 * 8192) = w; run = run * dec + x; }
    }
}

DI void ret_out_unit(const Frame& F_, const Args& a, int u) {
    Frame F = F_; { int tz = F_.tid; asm volatile("" : "+v"(tz)); F.tid = tz; F.lane = tz & 63; }
    const int b = u >> 8, c = (u >> 3) & 31, h = u & 7, w = F.wave;
    const size_t row0 = (size_t)(b * SEQ + c * 128);
    const bf16_t* P = (const bf16_t*)(F.ws + WS_PROJ) + row0 * PLD;
    const float* COS = (const float*)(F.ws + WS_COS); const float* SIN = (const float*)(F.ws + WS_SIN);
    ldsp Q = F.lds, KX = F.lds + 34816, VT = F.lds + 69632, ST = F.lds + 104448;
    const float lg = ret_loggamma(h);
#pragma unroll
    for (int i = 0; i < 2; ++i) { const int item = F.tid + 512 * i, s = item >> 3, d0 = (item & 7) * 8, pos = c * 128 + s;
        float r1[8], r2[8];
        rot8(P + (size_t)s * PLD + h * 128 + d0, COS + pos * 64 + d0, SIN + pos * 64 + d0, 1.f, r1, r2);
        *(LAS u32x4*)(Q + s * PT + d0 * 2) = pack8(r1); *(LAS u32x4*)(Q + s * PT + (d0 + 64) * 2) = pack8(r2);
        rot8(P + (size_t)s * PLD + P0_K + h * 128 + d0, COS + pos * 64 + d0, SIN + pos * 64 + d0, 0.08838834764831845f, r1, r2);
        *(LAS u32x4*)(KX + s * PT + d0 * 2) = pack8(r1); *(LAS u32x4*)(KX + s * PT + (d0 + 64) * 2) = pack8(r2); }
    const bf16_t* Sg = (const bf16_t*)(F.ws + WS_RET_S) + (size_t)((b * 8 + h) * 32 + c) * 16384;
#pragma unroll
    for (int i = 0; i < 4; ++i) { const int item = F.tid + 512 * i, s = item >> 4, e0 = (item & 15) * 8;
        const u32x4 v = *(const u32x4*)(P + (size_t)s * PLD + P0_V + h * 128 + e0);
        const unsigned ww[4] = {v.x, v.y, v.z, v.w};
#pragma unroll
        for (int j = 0; j < 8; ++j) *(LAS bf16_t*)(VT + (e0 + j) * PT + s * 2) = (bf16_t)((j & 1) ? (ww[j >> 1] >> 16) : (ww[j >> 1] & 0xffffu));
        *(LAS u32x4*)(ST + s * PT + e0 * 2) = *(const u32x4*)(Sg + (size_t)s * 128 + e0); }
    __syncthreads();
    const int fr = F.lane & 15, fq = F.lane >> 4, l = 16 * w + fr;
    f32x4 as[8]; zero_acc(as);
    mma16<8, 4>(as, Q + (16 * w) * PT, PT, KX, PT, fr, fq, w + 1, 4);
    f32x4 ao[8]; zero_acc(ao);
    mma16<8, 4>(ao, Q + (16 * w) * PT, PT, ST, PT, fr, fq);
    { const float qd = __expf(lg * (float)(l + 1));
#pragma unroll
      for (int nt = 0; nt < 8; ++nt) ao[nt] = ao[nt] * qd; }
    __syncthreads();
    ldsp Pm = KX;
#pragma unroll
    for (int nt = 0; nt < 8; ++nt) if (nt <= (w | 1)) { float pv[4];
#pragma unroll
        for (int j = 0; j < 4; ++j) { const int s = nt * 16 + fq * 4 + j; pv[j] = (nt <= w && s <= l) ? as[nt][j] * __expf(lg * (float)(l - s)) : 0.f; }
        u32x2 pw; pw.x = pk2(pv[0], pv[1]); pw.y = pk2(pv[2], pv[3]); *(LAS u32x2*)(Pm + l * PT + (nt * 16 + fq * 4) * 2) = pw; }
    __syncthreads();
    mma16<8, 4>(ao, Pm + (16 * w) * PT, PT, VT, PT, fr, fq, 8, (w >> 1) + 1);
    float sm = 0.f;
#pragma unroll
    for (int nt = 0; nt < 8; ++nt) sm += ao[nt][0] + ao[nt][1] + ao[nt][2] + ao[nt][3];
    sm += __shfl_xor(sm, 16); sm += __shfl_xor(sm, 32);
    const float mean = sm * (1.f / 128.f); float vs = 0.f;
#pragma unroll
    for (int nt = 0; nt < 8; ++nt)
#pragma unroll
        for (int j = 0; j < 4; ++j) { const float d = ao[nt][j] - mean; vs += d * d; }
    vs += __shfl_xor(vs, 16); vs += __shfl_xor(vs, 32);
    const float rstd = rsqrtf(vs * (1.f / 128.f) + EPS);
    const bf16_t* grow = P + (size_t)l * PLD + P0_G + h * 128; const float* ng = a.in[I_RET_NORM] + h * 128;
    bf16_t* orow = (bf16_t*)(F.ws + WS_MIX) + (row0 + l) * 2048 + h * 128;
#pragma unroll
    for (int nt = 0; nt < 8; ++nt) { const int e = nt * 16 + fq * 4; const u32x2 gv = *(const u32x2*)(grow + e); const f32x4 nn = *(const f32x4*)(ng + e);
        const float g0 = bflo(gv.x), g1 = bfhi(gv.x), g2 = bflo(gv.y), g3 = bfhi(gv.y);
        u32x2 o; o.x = pk2((ao[nt][0] - mean) * rstd * nn[0] * silu_(g0), (ao[nt][1] - mean) * rstd * nn[1] * silu_(g1));
        o.y = pk2((ao[nt][2] - mean) * rstd * nn[2] * silu_(g2), (ao[nt][3] - mean) * rstd * nn[3] * silu_(g3));
        *(u32x2*)(orow + e) = o; }
    __syncthreads();
}

DI void ssd_out_unit(const Frame& F_, const Args& a, int u) {
    Frame F = F_; { int tz = F_.tid; asm volatile("" : "+v"(tz)); F.tid = tz; F.lane = tz & 63; }
    const int b = u >> 6, c = (u >> 1) & 31, g = u & 1, w = F.wave;
    const size_t row0 = (size_t)(b * SEQ + c * 128);
    const bf16_t* P = (const bf16_t*)(F.ws + WS_PROJ) + row0 * PLD;
    ldsp CM = F.lds, BM = F.lds + 34816, XT = F.lds + 34816, SS = F.lds + 52224, Pm = F.lds + 69632, XS = F.lds + 104448;
    LAS float* dtv = (LAS float*)(F.lds + 122880); LAS float* acum = (LAS float*)(F.lds + 126976);
    constexpr int PXS = 144;
#pragma unroll
    for (int i = 0; i < 2; ++i) { const int idx = F.tid + 512 * i, s = idx >> 3, r = idx & 7; dtv[idx] = softplus_(bf2f(P[(size_t)s * PLD + P0_DT + g * 8 + r]) + a.in[I_SSD_DTB][g * 8 + r]); }
    __syncthreads();
    { const int r = w; const float A = -__expf(a.in[I_SSD_ALOG][g * 8 + r]);
      float c0, c1; wscan_sum(dtv[(2 * F.lane) * 8 + r] * A, dtv[(2 * F.lane + 1) * 8 + r] * A, F.lane, c0, c1);
      acum[(2 * F.lane) * 8 + r] = c0; acum[(2 * F.lane + 1) * 8 + r] = c1; }
    const float* cw = a.in[I_SSD_CONVW]; const float* cb = a.in[I_SSD_CONVB];
#pragma unroll 2
    for (int i = 0; i < 4; ++i) { const int item = F.tid + 512 * i, s = item >> 4, n0 = (item & 15) * 8;
        float y[8];
        { const int xc = 1280 + g * 128 + n0; conv8(P + (size_t)s * PLD + P0_XBC + xc, c * 128 + s, cw + xc, 1536, cb + xc, y);
#pragma unroll
          for (int j = 0; j < 8; ++j) y[j] = silu_(y[j]);
          *(LAS u32x4*)(CM + s * PT + n0 * 2) = pack8(y); }
        { const int xc = 1024 + g * 128 + n0; conv8(P + (size_t)s * PLD + P0_XBC + xc, c * 128 + s, cw + xc, 1536, cb + xc, y);
#pragma unroll
          for (int j = 0; j < 8; ++j) y[j] = silu_(y[j]);
          *(LAS u32x4*)(BM + s * PT + n0 * 2) = pack8(y); } }
    __syncthreads();
    const int fr = F.lane & 15, fq = F.lane >> 4, l = 16 * w + fr;
    f32x4 cbm[8]; zero_acc(cbm);
    mma16<8, 4>(cbm, CM + (16 * w) * PT, PT, BM, PT, fr, fq, w + 1, 4);
    __syncthreads();
    float ssq = 0.f;
    const bf16_t* Sg = (const bf16_t*)(F.ws + WS_SSD_S) + ((size_t)(b * 32 + c) * 16 + g * 8) * 8192;
    bf16_t* orow = (bf16_t*)(F.ws + WS_MIX) + (row0 + l) * 2048 + 1024 + g * 512; const float* ng = a.in[I_SSD_NORM] + g * 512;
#pragma unroll 1
    for (int r = 0; r < 8; ++r) {
        const int hd = g * 8 + r;
#pragma unroll
        for (int i = 0; i < 2; ++i) { const int item = F.tid + 512 * i, s = item >> 3, p0 = (item & 7) * 8, xc = hd * 64 + p0;
            float y[8]; conv8(P + (size_t)s * PLD + P0_XBC + xc, c * 128 + s, cw + xc, 1536, cb + xc, y);
            const float dt = dtv[s * 8 + r];
#pragma unroll
            for (int j = 0; j < 8; ++j) { y[j] = silu_(y[j]); *(LAS bf16_t*)(XT + (p0 + j) * PT + s * 2) = f2bf(y[j] * dt); }
            *(LAS u32x4*)(XS + s * PXS + p0 * 2) = pack8(y);
            const int p = item >> 4, n0 = (item & 15) * 8;
            *(LAS u32x4*)(SS + p * PT + n0 * 2) = *(const u32x4*)(Sg + (size_t)r * 8192 + p * 128 + n0); }
        __syncthreads();
        f32x4 acc[4]; zero_acc(acc);
        mma16<4, 4>(acc, CM + (16 * w) * PT, PT, SS, PT, fr, fq);
        const float al = acum[l * 8 + r];
        { const float ea = __expf(al);
#pragma unroll
          for (int nt = 0; nt < 4; ++nt) acc[nt] = acc[nt] * ea; }
#pragma unroll
        for (int nt = 0; nt < 8; ++nt) if (nt <= (w | 1)) { float pv[4];
#pragma unroll
            for (int j = 0; j < 4; ++j) { const int s = nt * 16 + fq * 4 + j; pv[j] = (nt <= w && s <= l) ? cbm[nt][j] * __expf(al - acum[s * 8 + r]) : 0.f; }
            u32x2 pw; pw.x = pk2(pv[0], pv[1]); pw.y = pk2(pv[2], pv[3]); *(LAS u32x2*)(Pm + l * PT + (nt * 16 + fq * 4) * 2) = pw; }
        __syncthreads();
        mma16<4, 4>(acc, Pm + (16 * w) * PT, PT, XT, PT, fr, fq, 4, (w >> 1) + 1);
        const float dsk = a.in[I_SSD_D][hd];
#pragma unroll
        for (int nt = 0; nt < 4; ++nt) { const int p = nt * 16 + fq * 4;
            const u32x2 xv = *(const LAS u32x2*)(XS + l * PXS + p * 2); const u32x2 zv = *(const u32x2*)(P + (size_t)l * PLD + P0_Z + hd * 64 + p);
            const float y0 = (acc[nt][0] + dsk * bflo(xv.x)) * silu_(bflo(zv.x)), y1 = (acc[nt][1] + dsk * bfhi(xv.x)) * silu_(bfhi(zv.x));
            const float y2 = (acc[nt][2] + dsk * bflo(xv.y)) * silu_(bflo(zv.y)), y3 = (acc[nt][3] + dsk * bfhi(xv.y)) * silu_(bfhi(zv.y));
            ssq += y0 * y0 + y1 * y1 + y2 * y2 + y3 * y3;
            u32x2 o; o.x = pk2(y0, y1); o.y = pk2(y2, y3); *(u32x2*)(orow + r * 64 + p) = o; }
        __syncthreads();
    }
    ssq += __shfl_xor(ssq, 16); ssq += __shfl_xor(ssq, 32);
    const float rstd = rsqrtf(ssq * (1.f / 512.f) + EPS);
    asm volatile("s_waitcnt vmcnt(0)" ::: "memory");
#pragma unroll 1
    for (int r = 0; r < 8; ++r)
#pragma unroll
        for (int nt = 0; nt < 4; ++nt) { const int p = r * 64 + nt * 16 + fq * 4; const f32x4 nn = *(const f32x4*)(ng + p); const u32x2 yv = *(const u32x2*)(orow + p);
            u32x2 o; o.x = pk2(bflo(yv.x) * rstd * nn[0], bfhi(yv.x) * rstd * nn[1]); o.y = pk2(bflo(yv.y) * rstd * nn[2], bfhi(yv.y) * rstd * nn[3]);
            *(u32x2*)(orow + p) = o; }
    __syncthreads();
}

DI void phase_router(const Frame& F, const Args& a, int layer) {
    const float* H = a.out; const float* RT = (const float*)(F.ws + WS_RT) + (size_t)layer * 48 * 2048;
    unsigned* cnt = (unsigned*)(F.ws + WS_CTL) + CW_CNT + layer * 32 * 64;
    int* LIST = (int*)(F.ws + WS_LIST); int* SLOT = (int*)(F.ws + WS_SLOT); bf16_t* XN = (bf16_t*)(F.ws + WS_XN);
    LAS float* lg = (LAS float*)(F.lds + F.wave * 4096); LAS float* rs = lg + 16 * 48;
    const int fr = F.lane & 15, fq = F.lane >> 4;
    for (int q = F.wave; q * F.G + F.bx < 1024; q += 8) {
        const int row0 = (q * F.G + F.bx) * 16;
        f32x4 acc[3]; zero_acc(acc); float ss = 0.f;
        const float* ap = H + (size_t)(row0 + fr) * 2048 + 4 * fq; const float* bp = RT + (size_t)fr * 2048 + 4 * fq;
#pragma unroll 4
        for (int s = 0; s < 128; ++s) {
            const f32x4 av = *(const f32x4*)(ap + 16 * s); ss += av[0] * av[0] + av[1] * av[1] + av[2] * av[2] + av[3] * av[3];
#pragma unroll
            for (int ct = 0; ct < 3; ++ct) { const f32x4 bv = *(const f32x4*)(bp + (size_t)ct * 16 * 2048 + 16 * s);
#pragma unroll
                for (int j = 0; j < 4; ++j) acc[ct] = __builtin_amdgcn_mfma_f32_16x16x4f32(av[j], bv[j], acc[ct], 0, 0, 0); }
        }
        ss += __shfl_xor(ss, 16); ss += __shfl_xor(ss, 32);
        const float rstd = rsqrtf(ss * (1.f / D) + EPS);
        if (fq == 0) rs[fr] = rstd;
#pragma unroll
        for (int ct = 0; ct < 3; ++ct)
#pragma unroll
            for (int j = 0; j < 4; ++j) lg[(4 * fq + j) * 48 + ct * 16 + fr] = acc[ct][j];
        LDS_WAIT();
        if (F.lane < 16) {
            const int r = F.lane, tok = row0 + r; const float rr = rs[r];
            float gl[4]; float mx = -INFINITY; int gi = 0;
#pragma unroll
            for (int j = 0; j < 4; ++j) { gl[j] = lg[r * 48 + j] * rr + a.in[I_MOE_RGB][layer * 4 + j]; if (gl[j] > mx) { mx = gl[j]; gi = j; } }
            float se = 0.f;
#pragma unroll
            for (int j = 0; j < 4; ++j) se += __expf(gl[j] - mx);
            const float gw = 1.f / se;
            float v1 = -INFINITY, v2 = -INFINITY; int i1 = 0, i2 = 0;
            for (int k = 0; k < 8; ++k) { const float v = lg[r * 48 + 4 + gi * 8 + k] * rr + a.in[I_MOE_REB][layer * 32 + gi * 8 + k];
                if (v > v1) { v2 = v1; i2 = i1; v1 = v; i1 = k; } else if (v > v2) { v2 = v; i2 = k; } }
            const float e2 = __expf(v2 - v1), w1 = gw / (1.f + e2), w2 = gw * e2 / (1.f + e2);
            const int e0 = gi * 8 + i1, e1 = gi * 8 + i2;
            const int r0 = (int)__hip_atomic_fetch_add(cnt + e0 * 64, 1u, __ATOMIC_RELAXED, __HIP_MEMORY_SCOPE_AGENT);
            const int r1 = (int)__hip_atomic_fetch_add(cnt + e1 * 64, 1u, __ATOMIC_RELAXED, __HIP_MEMORY_SCOPE_AGENT);
            LIST[e0 * T + r0] = tok; LIST[e1 * T + r1] = tok;
            int* sp = SLOT + (size_t)tok * 8; sp[0] = e0; sp[1] = r0; sp[2] = __float_as_int(w1); sp[3] = e1; sp[4] = r1; sp[5] = __float_as_int(w2);
        }
        const float* gn = a.in[I_MOE_NORM] + layer * 2048;
        for (int r = 0; r < 16; ++r) { const float rr = rs[r]; const float* xr = H + (size_t)(row0 + r) * 2048; bf16_t* o = XN + (size_t)(row0 + r) * 2048;
#pragma unroll
            for (int j = 0; j < 8; ++j) { const f32x4 v = *(const f32x4*)(xr + (F.lane + 64 * j) * 4), gg = *(const f32x4*)(gn + (F.lane + 64 * j) * 4);
                u32x2 wv; wv.x = pk2(v[0] * rr * gg[0], v[1] * rr * gg[1]); wv.y = pk2(v[2] * rr * gg[2], v[3] * rr * gg[3]); *(u32x2*)(o + (F.lane + 64 * j) * 4) = wv; } }
        LDS_WAIT();
    }
}
DI int moe_tables(const Frame& F, int layer) {
    const unsigned* cnt = (const unsigned*)(F.ws + WS_CTL) + CW_CNT + layer * 32 * 64;
    LAS int* tile_e = (LAS int*)(F.lds + LDS_TAB); LAS int* tstart = tile_e + 192; LAS int* ecnt = tile_e + 224;
    if (F.tid == 0) { int acc = 0;
        for (int e = 0; e < 32; ++e) { const int n = (int)__hip_atomic_load(cnt + e * 64, __ATOMIC_RELAXED, __HIP_MEMORY_SCOPE_AGENT); const int mt = (n + 255) >> 8; tstart[e] = acc; ecnt[e] = n;
            for (int k = 0; k < mt; ++k) tile_e[acc + k] = e; acc += mt; }
        tile_e[191] = acc; }
    __syncthreads();
    return tile_e[191];
}
DI void phase_moe_gateup(const Frame& F, const Args& a, int layer) {
    const int ntiles = moe_tables(F, layer);
    LAS int* tile_e = (LAS int*)(F.lds + LDS_TAB); LAS int* tstart = tile_e + 192; LAS int* ecnt = tile_e + 224; LAS int* gtab = (LAS int*)(F.lds + LDS_TAB + 1024);
    const int* LIST = (const int*)(F.ws + WS_LIST);
    for (int i = 0; i < 4; ++i) { const int L = i * F.G + F.bx; if (L >= ntiles * 4) break;
        const int gm = L >> 2, e = tile_e[gm], rbase = (gm - tstart[e]) * 256;
        if (F.tid < 256) { const int rank = rbase + F.tid; gtab[i * 256 + F.tid] = (rank < ecnt[e]) ? LIST[e * T + rank] : 0; } }
    __syncthreads();
    pg8::MoeGU S; S.XN = (const char*)(F.ws + WS_XN); S.W = (const char*)(F.ws + WS_WGU); S.tile_e = tile_e; S.gtab = gtab; S.nunits = ntiles * 4; S.G = F.G; S.c = F.bx;
    pg8::EpiGateUp E{(bf16_t*)(F.ws + WS_HID), 512};
    pg8::gemm_phase<pg8::EpiGateUp, pg8::MoeGU, true>(F.lds, 2048, 2048, 2048, S, E);
}
DI void phase_moe_down(const Frame& F, const Args& a, int layer) {
    const int ntiles = moe_tables(F, layer);
    LAS int* tile_e = (LAS int*)(F.lds + LDS_TAB);
    pg8::MoeDown S; S.HID = (const char*)(F.ws + WS_HID); S.W = (const char*)(F.ws + WS_WD); S.tile_e = tile_e; S.nunits = ntiles * 8; S.G = F.G; S.c = F.bx;
    pg8::EpiBf16 E{(bf16_t*)(F.ws + WS_Y), 2048};
    pg8::gemm_phase<pg8::EpiBf16, pg8::MoeDown, false>(F.lds, 512, 512, 512, S, E);
}
template <bool LAST>
DI void phase_combine(const Frame& F, const Args& a, int layer) {
    (void)moe_tables(F, layer);
    LAS int* tstart = (LAS int*)(F.lds + LDS_TAB) + 192;
    const int* SLOT = (const int*)(F.ws + WS_SLOT); const bf16_t* Y = (const bf16_t*)(F.ws + WS_Y); float* H = a.out; bf16_t* XN = (bf16_t*)(F.ws + WS_XN);
    const float* gn = LAST ? a.in[I_FINAL_NORM] : a.in[I_ODD_NORM];
    const int gw = F.bx * 8 + F.wave, NGW = F.G * 8;
    for (int m = gw; m < T; m += NGW) {
        const int* sp = SLOT + (size_t)m * 8; const int e0 = sp[0], r0 = sp[1], e1 = sp[3], r1 = sp[4]; const float w0 = __int_as_float(sp[2]), w1 = __int_as_float(sp[5]);
        const bf16_t* y0 = Y + (size_t)(tstart[e0] * 256 + r0) * 2048; const bf16_t* y1 = Y + (size_t)(tstart[e1] * 256 + r1) * 2048;
        float* hr = H + (size_t)m * 2048;
        f32x4 v[8]; float ss = 0.f;
#pragma unroll
        for (int j = 0; j < 8; ++j) { const int o = (F.lane + 64 * j) * 4; const f32x4 h = *(const f32x4*)(hr + o); const u32x2 p0 = *(const u32x2*)(y0 + o), p1 = *(const u32x2*)(y1 + o);
            v[j][0] = h[0] + w0 * bflo(p0.x) + w1 * bflo(p1.x); v[j][1] = h[1] + w0 * bfhi(p0.x) + w1 * bfhi(p1.x);
            v[j][2] = h[2] + w0 * bflo(p0.y) + w1 * bflo(p1.y); v[j][3] = h[3] + w0 * bfhi(p0.y) + w1 * bfhi(p1.y);
            ss += v[j][0] * v[j][0] + v[j][1] * v[j][1] + v[j][2] * v[j][2] + v[j][3] * v[j][3]; }
        const float rstd = rsqrtf(wsum(ss) * (1.f / D) + EPS);
#pragma unroll
        for (int j = 0; j < 8; ++j) { const int o = (F.lane + 64 * j) * 4; const f32x4 gg = *(const f32x4*)(gn + o);
            if (LAST) { *(f32x4*)(hr + o) = (f32x4){v[j][0] * rstd * gg[0], v[j][1] * rstd * gg[1], v[j][2] * rstd * gg[2], v[j][3] * rstd * gg[3]}; }
            else { *(f32x4*)(hr + o) = v[j]; u32x2 wv; wv.x = pk2(v[j][0] * rstd * gg[0], v[j][1] * rstd * gg[1]); wv.y = pk2(v[j][2] * rstd * gg[2], v[j][3] * rstd * gg[3]); *(u32x2*)(XN + (size_t)m * 2048 + o) = wv; } }
    }
}

DI void mlstm_local_unit(const Frame& F_, const Args& a, int u) {
    Frame F = F_; { int tz = F_.tid; asm volatile("" : "+v"(tz)); F.tid = tz; F.lane = tz & 63; }
    const int et = u % 3, t3 = u / 3, h = t3 & 3, c = (t3 >> 2) & 31, b = t3 >> 7, bh = b * 4 + h;
    const bf16_t* P = (const bf16_t*)(F.ws + WS_PROJ) + (size_t)(b * SEQ + c * 128) * PLD;
    ldsp KT = F.lds, VT = F.lds + 104448; LAS float* wv = (LAS float*)(F.lds + 139264);
    if (F.wave == 0) {
        const int s0 = 2 * F.lane, s1 = s0 + 1; const float fb = a.in[I_ML_FB][h], ib = a.in[I_ML_IB][h];
        const float lf0 = logsigmoid_(bf2f(P[(size_t)s0 * PLD + P1_F + h]) + fb), lf1 = logsigmoid_(bf2f(P[(size_t)s1 * PLD + P1_F + h]) + fb);
        const float ig0 = bf2f(P[(size_t)s0 * PLD + P1_I + h]) + ib, ig1 = bf2f(P[(size_t)s1 * PLD + P1_I + h]) + ib;
        float bc0, bc1; wscan_sum(lf0, lf1, F.lane, bc0, bc1);
        const float blast = __shfl(bc1, 63);
        const float wl0 = blast - bc0 + ig0, wl1 = blast - bc1 + ig1; const float mloc = wmax(fmaxf(wl0, wl1));
        wv[s0] = __expf(wl0 - mloc); wv[s1] = __expf(wl1 - mloc);
        if (et == 0 && F.lane == 0) { float* MS = (float*)(F.ws + WS_SMALL + 16384); MS[(bh * 32 + c) * 2] = blast; MS[(bh * 32 + c) * 2 + 1] = mloc; }
    }
    __syncthreads();
    const float* cw = a.in[I_ML_CONVW]; const float* cb = a.in[I_ML_CONVB];
#pragma unroll 2
    for (int i = 0; i < 12; ++i) { const int item = F.tid + 512 * i, s = item / 48, d0 = (item % 48) * 8, xc = P1_K + h * 384 + d0;
        float y[8]; conv8(P + (size_t)s * PLD + xc, c * 128 + s, cw + xc, 3072, cb + xc, y);
        const float ws_ = wv[s];
#pragma unroll
        for (int j = 0; j < 8; ++j) *(LAS bf16_t*)(KT + (d0 + j) * PT + s * 2) = f2bf(silu_(y[j]) * ws_); }
#pragma unroll
    for (int i = 0; i < 4; ++i) { const int item = F.tid + 512 * i, s = item >> 4, e0 = (item & 15) * 8;
        const u32x4 v = *(const u32x4*)(P + (size_t)s * PLD + P1_V + h * 384 + et * 128 + e0);
        const unsigned ww[4] = {v.x, v.y, v.z, v.w};
#pragma unroll
        for (int j = 0; j < 8; ++j) *(LAS bf16_t*)(VT + (e0 + j) * PT + s * 2) = (bf16_t)((j & 1) ? (ww[j >> 1] >> 16) : (ww[j >> 1] & 0xffffu)); }
    __syncthreads();
    const int fr = F.lane & 15, fq = F.lane >> 4;
    f32x4 acc[24]; zero_acc(acc);
    mma16<24, 4>(acc, VT + (16 * F.wave) * PT, PT, KT, PT, fr, fq);
#if DBG == 35
    { unsigned fl = 0u;
      for (int i = F.tid; i < 128 * 128; i += 512) { const float v = bf2f(*(LAS bf16_t*)(VT + (i >> 7) * PT + (i & 127) * 2)); if (!(v - v == 0.f)) fl |= 1u; if (fabsf(v) > 1e4f) fl |= 16u; }
      for (int i = F.tid; i < 384 * 128; i += 512) { const float v = bf2f(*(LAS bf16_t*)(KT + (i >> 7) * PT + (i & 127) * 2)); if (!(v - v == 0.f)) fl |= 2u; if (fabsf(v) > 1e4f) fl |= 32u; }
#pragma unroll
      for (int nt = 0; nt < 24; ++nt) { const f32x4 q = acc[nt] - acc[nt]; if (!(q[0] == 0.f && q[1] == 0.f && q[2] == 0.f && q[3] == 0.f)) fl |= 4u; }
      if (F.tid < 128) { const float v = wv[F.tid]; if (!(v >= 0.f && v <= 1.0001f)) fl |= 8u; }
      if (fl) atomicOr((unsigned*)(F.ws + WS_SMALL + 65536 + 4), fl); }
#endif
    bf16_t* dst = (bf16_t*)(F.ws + WS_MC) + ((size_t)(bh * 32 + c) * 384 + et * 128 + 16 * F.wave + fr) * 384 + fq * 4;
#pragma unroll
    for (int nt = 0; nt < 24; ++nt) { u32x2 o; o.x = pk2(acc[nt][0], acc[nt][1]); o.y = pk2(acc[nt][2], acc[nt][3]); *(u32x2*)(dst + nt * 16) = o; }
    if (et == 0 && F.tid < 384) { float sm = 0.f;
#pragma unroll
        for (int k = 0; k < 16; ++k) { float x[8]; unpack8(*(const LAS u32x4*)(KT + F.tid * PT + k * 16), x); sm += ((x[0] + x[1]) + (x[2] + x[3])) + ((x[4] + x[5]) + (x[6] + x[7])); }
        ((float*)(F.ws + WS_MN))[(size_t)(bh * 32 + c) * 384 + F.tid] = sm; }
    __syncthreads();
}

DI void s5_local_unit(const Frame& F_, const Args& a, int u) {
    Frame F = F_; { int tz = F_.tid; asm volatile("" : "+v"(tz)); F.tid = tz; F.lane = tz & 63; }
    const int b = u >> 7, c = (u >> 2) & 31, g8 = u & 3;
    const bf16_t* P = (const bf16_t*)(F.ws + WS_PROJ) + (size_t)(b * SEQ + c * 128) * PLD + P1_U + g8 * 128;
    LAS float* U = (LAS float*)F.lds;
#pragma unroll
    for (int i = 0; i < 4; ++i) { const int item = F.tid + 512 * i, t = item >> 4, ch = (item & 15) * 8; float x[8]; unpack8(*(const u32x4*)(P + (size_t)t * PLD + ch), x);
        *(LAS f32x4*)(U + t * 128 + ch) = (f32x4){x[0], x[1], x[2], x[3]}; *(LAS f32x4*)(U + t * 128 + ch + 4) = (f32x4){x[4], x[5], x[6], x[7]}; }
    __syncthreads();
    const int g = g8 * 8 + F.wave, gn = g * 64 + F.lane;
    const float* BB = (const float*)(F.ws + WS_S5T + 32768) + (size_t)gn * 32; const f32x2 ab = ((const f32x2*)(F.ws + WS_S5T))[gn];
    float bb[32];
#pragma unroll
    for (int k = 0; k < 8; ++k) { const f32x4 v = *(const f32x4*)(BB + 4 * k); bb[4 * k] = v[0]; bb[4 * k + 1] = v[1]; bb[4 * k + 2] = v[2]; bb[4 * k + 3] = v[3]; }
    float sr = 0.f, si = 0.f;
#pragma unroll 4
    for (int t = 0; t < 128; ++t) {
        float br = 0.f, bi = 0.f;
#pragma unroll
        for (int k = 0; k < 4; ++k) { const f32x4 uv = *(const LAS f32x4*)(U + t * 128 + F.wave * 16 + 4 * k);
#pragma unroll
            for (int j = 0; j < 4; ++j) { br += bb[4 * k + j] * uv[j]; bi += bb[16 + 4 * k + j] * uv[j]; } }
        const float nr = ab.x * sr - ab.y * si + br, ni = ab.x * si + ab.y * sr + bi; sr = nr; si = ni;
    }
    ((f32x2*)(F.ws + WS_S5E))[(size_t)((b * 32 + g) * 32 + c) * 64 + F.lane] = (f32x2){sr, si};
    __syncthreads();
}

DI void phase_odd_scan(const Frame& F, const Args& a) {
    LAS float* scp = (LAS float*)F.lds; LAS float* scn = scp + 512;
    if (F.tid < 16) { const int bh = F.tid; const float* MS = (const float*)(F.ws + WS_SMALL + 16384); float* MST = (float*)(F.ws + WS_SMALL + 32768); float m = -INFINITY;
        for (int c = 0; c < 32; ++c) { const float bl = MS[(bh * 32 + c) * 2], ml = MS[(bh * 32 + c) * 2 + 1]; const float mn = fmaxf(bl + m, ml);
            scp[bh * 32 + c] = __expf(bl + m - mn); scn[bh * 32 + c] = __expf(ml - mn); if (F.bx == 0) MST[bh * 32 + c] = m; m = mn; } }
    __syncthreads();
    const int gt = F.bx * 512 + F.tid, NT_ = F.G * 512;
    for (int it = gt; it < 16 * 18432; it += NT_) { const int bh = it / 18432, v = it % 18432;
        bf16_t* p = (bf16_t*)(F.ws + WS_MC) + (size_t)bh * 32 * 147456 + (size_t)v * 8;
        float run[8];
#pragma unroll
        for (int j = 0; j < 8; ++j) run[j] = 0.f;
#pragma unroll 4
        for (int c = 0; c < 32; ++c) { float x[8]; unpack8(*(const u32x4*)(p + (size_t)c * 147456), x); *(u32x4*)(p + (size_t)c * 147456) = pack8(run);
            const float sp = scp[bh * 32 + c], sn = scn[bh * 32 + c];
#pragma unroll
            for (int j = 0; j < 8; ++j) run[j] = sp * run[j] + sn * x[j]; } }
    for (int it = gt; it < 16 * 96; it += NT_) { const int bh = it / 96, v = it % 96; float* p = (float*)(F.ws + WS_MN) + (size_t)bh * 32 * 384 + v * 4;
        f32x4 run = (f32x4){0.f, 0.f, 0.f, 0.f};
        for (int c = 0; c < 32; ++c) { const f32x4 x = *(const f32x4*)(p + c * 384); *(f32x4*)(p + c * 384) = run; run = run * scp[bh * 32 + c] + x * scn[bh * 32 + c]; } }
    for (int it = gt; it < 8192; it += NT_) { const int b = it >> 11, g = (it >> 6) & 31, n = it & 63; const f32x2 a128 = ((const f32x2*)(F.ws + WS_S5T))[2048 + g * 64 + n];
        f32x2* p = (f32x2*)(F.ws + WS_S5E) + (size_t)((b * 32 + g) * 32) * 64 + n; float sr = 0.f, si = 0.f;
        for (int c = 0; c < 32; ++c) { const f32x2 e = p[c * 64]; p[c * 64] = (f32x2){sr, si}; const float nr = a128.x * sr - a128.y * si + e.x, ni = a128.x * si + a128.y * sr + e.y; sr = nr; si = ni; } }
}

struct MlCtx { const bf16_t* P; const bf16_t* Cg; const float* cw; const float* cb; int c, h; };
template <int I> DI void ml_stage(const Frame& F, const MlCtx& m, ldsp buf) {
    int tidz = F.tid; asm volatile("" : "+v"(tidz));
    if constexpr (I < 3) {
#pragma unroll 1
        for (int i = 0; i < 4; ++i) { const int item = tidz + 512 * i, s = item >> 4, d0 = (item & 15) * 8, xc = P1_K + m.h * 384 + I * 128 + d0;
            float y[8]; conv8(m.P + (size_t)s * PLD + xc, m.c * 128 + s, m.cw + xc, 3072, m.cb + xc, y);
#pragma unroll
            for (int j = 0; j < 8; ++j) y[j] = silu_(y[j]);
            *(LAS u32x4*)(buf + s * PT + d0 * 2) = pack8(y); }
    } else if constexpr (((I - 3) & 3) < 3) {
        constexpr int et = (I - 3) >> 2, j = (I - 3) & 3;
#pragma unroll
        for (int i = 0; i < 4; ++i) { const int item = tidz + 512 * i, e = item >> 4, d0 = (item & 15) * 8;
            *(LAS u32x4*)(buf + e * PT + d0 * 2) = *(const u32x4*)(m.Cg + (size_t)(et * 128 + e) * 384 + j * 128 + d0); }
    } else {
        constexpr int et = (I - 3) >> 2;
#pragma unroll
        for (int i = 0; i < 4; ++i) { const int item = tidz + 512 * i, s = item >> 4, e0 = (item & 15) * 8;
            const u32x4 v = *(const u32x4*)(m.P + (size_t)s * PLD + P1_V + m.h * 384 + et * 128 + e0);
            const unsigned ww[4] = {v.x, v.y, v.z, v.w};
#pragma unroll
            for (int j = 0; j < 8; ++j) *(LAS bf16_t*)(buf + (e0 + j) * PT + s * 2) = (bf16_t)((j & 1) ? (ww[j >> 1] >> 16) : (ww[j >> 1] & 0xffffu)); }
    }
}
template <int I> DI void ml_compute(const Frame& F, ldsp buf, ldsp Pm, const bf16x8 (&qf)[12], f32x4 (&as)[8], f32x4 (&ao)[8], int fr, int fq) {
    const int w = F.wave;
    if constexpr (I < 3) {
#pragma unroll
        for (int ks = 0; ks < 4; ++ks)
#pragma unroll
            for (int nt = 0; nt < 8; ++nt) if (nt <= w) { const bf16x8 bv = *(const LAS bf16x8*)(buf + (nt * 16 + fr) * PT + (ks * 32 + fq * 8) * 2);
                as[nt] = __builtin_amdgcn_mfma_f32_16x16x32_bf16(bv, qf[I * 4 + ks], as[nt], 0, 0, 0); }
    } else if constexpr (((I - 3) & 3) < 3) {
        constexpr int j = (I - 3) & 3;
#pragma unroll
        for (int ks = 0; ks < 4; ++ks)
#pragma unroll
            for (int nt = 0; nt < 8; ++nt) { const bf16x8 bv = *(const LAS bf16x8*)(buf + (nt * 16 + fr) * PT + (ks * 32 + fq * 8) * 2);
                ao[nt] = __builtin_amdgcn_mfma_f32_16x16x32_bf16(bv, qf[j * 4 + ks], ao[nt], 0, 0, 0); }
    } else {
#pragma unroll
        for (int ks = 0; ks < 4; ++ks) if (ks <= (w >> 1)) { const bf16x8 av = *(const LAS bf16x8*)(Pm + (16 * w + fr) * PT + (ks * 32 + fq * 8) * 2);
#pragma unroll
            for (int nt = 0; nt < 8; ++nt) { const bf16x8 bv = *(const LAS bf16x8*)(buf + (nt * 16 + fr) * PT + (ks * 32 + fq * 8) * 2);
                ao[nt] = __builtin_amdgcn_mfma_f32_16x16x32_bf16(bv, av, ao[nt], 0, 0, 0); } }
    }
}
DI void mlstm_out_unit(const Frame& F_, const Args& a, int u) {
    Frame F = F_; { int tz = F_.tid; asm volatile("" : "+v"(tz)); F.tid = tz; F.lane = tz & 63; }
    const int h = u & 3, c = (u >> 2) & 31, b = u >> 7, bh = b * 4 + h, w = F.wave;
    const size_t row0 = (size_t)(b * SEQ + c * 128);
    MlCtx m; m.P = (const bf16_t*)(F.ws + WS_PROJ) + row0 * PLD; m.Cg = (const bf16_t*)(F.ws + WS_MC) + (size_t)(bh * 32 + c) * 147456; m.cw = a.in[I_ML_CONVW]; m.cb = a.in[I_ML_CONVB]; m.c = c; m.h = h;
    ldsp X0 = F.lds, X1 = F.lds + 34816, Pm = F.lds + 69632;
    LAS float* bcum = (LAS float*)(F.lds + 104448); LAS float* gmb = bcum + 128; LAS float* mtv = bcum + 256; LAS float* iscv = bcum + 384; LAS float* nst = bcum + 512;
    if (w == 0) {
        const int s0 = 2 * F.lane, s1 = s0 + 1; const float fb = a.in[I_ML_FB][h], ib = a.in[I_ML_IB][h];
        const float lf0 = logsigmoid_(bf2f(m.P[(size_t)s0 * PLD + P1_F + h]) + fb), lf1 = logsigmoid_(bf2f(m.P[(size_t)s1 * PLD + P1_F + h]) + fb);
        const float ig0 = bf2f(m.P[(size_t)s0 * PLD + P1_I + h]) + ib, ig1 = bf2f(m.P[(size_t)s1 * PLD + P1_I + h]) + ib;
        float bc0, bc1; wscan_sum(lf0, lf1, F.lane, bc0, bc1);
        const float g0 = ig0 - bc0, g1 = ig1 - bc1; float pm0, pm1; wscan_max(g0, g1, F.lane, pm0, pm1);
        const float mst = ((const float*)(F.ws + WS_SMALL + 32768))[bh * 32 + c];
        const float mi0 = bc0 + mst, mi1 = bc1 + mst, mt0 = fmaxf(bc0 + pm0, mi0), mt1 = fmaxf(bc1 + pm1, mi1);
        bcum[s0] = bc0; bcum[s1] = bc1; gmb[s0] = g0; gmb[s1] = g1; mtv[s0] = mt0; mtv[s1] = mt1; iscv[s0] = __expf(mi0 - mt0); iscv[s1] = __expf(mi1 - mt1);
    } else if (F.tid >= 64 && F.tid < 64 + 384) nst[F.tid - 64] = ((const float*)(F.ws + WS_MN))[(size_t)(bh * 32 + c) * 384 + F.tid - 64];
    ml_stage<0>(F, m, X0);
    __syncthreads();
    const int fr = F.lane & 15, fq = F.lane >> 4, l = 16 * w + fr;
    bf16x8 qf[12]; float qn = 0.f;
#pragma unroll
    for (int ks = 0; ks < 12; ++ks) { const int d0 = ks * 32 + fq * 8, xc = h * 384 + d0;
        float y[8]; conv8(m.P + (size_t)l * PLD + xc, c * 128 + l, m.cw + xc, 3072, m.cb + xc, y);
#pragma unroll
        for (int j = 0; j < 8; ++j) { y[j] = silu_(y[j]) * 0.05103103630798288f; qn += y[j] * nst[d0 + j]; }
        qf[ks] = __builtin_bit_cast(bf16x8, pack8(y)); asm volatile("" : "+v"(qf[ks]), "+v"(qn) :: "memory"); }
    qn += __shfl_xor(qn, 16); qn += __shfl_xor(qn, 32);
    f32x4 as[8]; zero_acc(as); f32x4 ao[8]; zero_acc(ao);
    float den = 0.f, dn = 0.f, sm = 0.f, sq = 0.f;
    const float mtl = mtv[l], iscl = iscv[l];
    bf16_t* orow = (bf16_t*)(F.ws + WS_MIX) + (row0 + l) * 2048 + h * 384;
#define ML_STEP(I) do { if constexpr ((I) + 1 < 15) ml_stage<(I) + 1>(F, m, (((I) + 1) & 1) ? X1 : X0); ml_compute<I>(F, ((I) & 1) ? X1 : X0, Pm, qf, as, ao, fr, fq); \
        if constexpr ((I) == 2) { const float bl = bcum[l]; \
            _Pragma("unroll") for (int nt = 0; nt < 8; ++nt) if (nt <= (w | 1)) { float pv[4]; \
                _Pragma("unroll") for (int j = 0; j < 4; ++j) { const int s = nt * 16 + fq * 4 + j; pv[j] = (nt <= w && s <= l) ? as[nt][j] * __expf(bl + gmb[s] - mtl) : 0.f; den += pv[j]; } \
                u32x2 pw; pw.x = pk2(pv[0], pv[1]); pw.y = pk2(pv[2], pv[3]); *(LAS u32x2*)(Pm + l * PT + (nt * 16 + fq * 4) * 2) = pw; } \
            den += __shfl_xor(den, 16); den += __shfl_xor(den, 32); den += iscl * qn; dn = __builtin_amdgcn_rcpf(fmaxf(fabsf(den), __expf(-mtl))); } \
        if constexpr ((I) >= 3 && (((I) - 3) & 3) == 2) { _Pragma("unroll") for (int nt = 0; nt < 8; ++nt) ao[nt] = ao[nt] * iscl; } \
        if constexpr ((I) >= 3 && (((I) - 3) & 3) == 3) { constexpr int et_ = ((I) - 3) >> 2; \
            _Pragma("unroll") for (int nt = 0; nt < 8; ++nt) { const f32x4 hv = ao[nt] * dn; sm += (hv[0] + hv[1]) + (hv[2] + hv[3]); sq += (hv[0] * hv[0] + hv[1] * hv[1]) + (hv[2] * hv[2] + hv[3] * hv[3]); \
                u32x2 o; o.x = pk2(hv[0], hv[1]); o.y = pk2(hv[2], hv[3]); *(u32x2*)(orow + et_ * 128 + nt * 16 + fq * 4) = o; ao[nt] = (f32x4){0.f, 0.f, 0.f, 0.f}; } } \
        __syncthreads(); } while (0)
    ML_STEP(0); ML_STEP(1); ML_STEP(2); ML_STEP(3); ML_STEP(4); ML_STEP(5); ML_STEP(6); ML_STEP(7); ML_STEP(8); ML_STEP(9); ML_STEP(10); ML_STEP(11); ML_STEP(12); ML_STEP(13); ML_STEP(14);
#undef ML_STEP
    sm += __shfl_xor(sm, 16); sm += __shfl_xor(sm, 32); sq += __shfl_xor(sq, 16); sq += __shfl_xor(sq, 32);
    const float mean = sm * (1.f / 384.f); const float var = fmaxf(sq * (1.f / 384.f) - mean * mean, 0.f);
    const float rstd = rsqrtf(var + EPS);
    const bf16_t* orow_g = m.P + (size_t)l * PLD + P1_O + h * 384; const float* ng = a.in[I_ML_NORM] + h * 384;
    asm volatile("s_waitcnt vmcnt(0)" ::: "memory");
#pragma unroll 2
    for (int nt = 0; nt < 24; ++nt) { const int e = nt * 16 + fq * 4; const u32x2 ov = *(const u32x2*)(orow_g + e); const f32x4 nn = *(const f32x4*)(ng + e); const u32x2 hv = *(const u32x2*)(orow + e);
        u32x2 o; o.x = pk2((bflo(hv.x) - mean) * rstd * nn[0] * sigmoid_(bflo(ov.x)), (bfhi(hv.x) - mean) * rstd * nn[1] * sigmoid_(bfhi(ov.x)));
        o.y = pk2((bflo(hv.y) - mean) * rstd * nn[2] * sigmoid_(bflo(ov.y)), (bfhi(hv.y) - mean) * rstd * nn[3] * sigmoid_(bfhi(ov.y)));
        *(u32x2*)(orow + e) = o; }
    __syncthreads();
}

DI void s5_out_unit(const Frame& F_, const Args& a, int u) {
    Frame F = F_; { int tz = F_.tid; asm volatile("" : "+v"(tz)); F.tid = tz; F.lane = tz & 63; }
    const int b = u >> 7, c = (u >> 2) & 31, g8 = u & 3, w = F.wave;
    const size_t row0 = (size_t)(b * SEQ + c * 128);
    const bf16_t* P = (const bf16_t*)(F.ws + WS_PROJ) + row0 * PLD + P1_U + g8 * 128;
    ldsp U = F.lds; LAS float* CT = (LAS float*)(F.lds + 32768); ldsp ST = F.lds + 98304 + w * 4160;
#pragma unroll
    for (int i = 0; i < 4; ++i) { const int item = F.tid + 512 * i, t = item >> 4, ch = (item & 15) * 8; *(LAS u32x4*)(U + t * 256 + ch * 2) = *(const u32x4*)(P + (size_t)t * PLD + ch); }
    for (int i = F.tid; i < 8192; i += 512) { const int gl = i >> 10, cc = (i >> 6) & 15, n = i & 63; const size_t src = (size_t)((g8 * 8 + gl) * 16 + cc) * 64 + n;
        CT[((gl * 64 + n) * 16 + cc) * 2] = a.in[I_S5_CRE][src]; CT[((gl * 64 + n) * 16 + cc) * 2 + 1] = a.in[I_S5_CIM][src]; }
    __syncthreads();
    const int g = g8 * 8 + w, gn = g * 64 + F.lane;
    const float* BB = (const float*)(F.ws + WS_S5T + 32768) + (size_t)gn * 32; const f32x2 ab = ((const f32x2*)(F.ws + WS_S5T))[gn];
    float bb[32];
#pragma unroll
    for (int k = 0; k < 8; ++k) { const f32x4 v = *(const f32x4*)(BB + 4 * k); bb[4 * k] = v[0]; bb[4 * k + 1] = v[1]; bb[4 * k + 2] = v[2]; bb[4 * k + 3] = v[3]; }
    const f32x2 s0 = ((const f32x2*)(F.ws + WS_S5E))[(size_t)((b * 32 + g) * 32 + c) * 64 + F.lane];
    float sr = s0.x, si = s0.y;
    const int tl = F.lane & 7, co = F.lane >> 3;
    const float dk0 = a.in[I_S5_D][g * 16 + 2 * co], dk1 = a.in[I_S5_D][g * 16 + 2 * co + 1];
    bf16_t* Y5 = (bf16_t*)(F.ws + WS_Y5);
    for (int tt = 0; tt < 16; ++tt) {
#pragma unroll
        for (int t8 = 0; t8 < 8; ++t8) { const int t = tt * 8 + t8;
            float br = 0.f, bi = 0.f;
#pragma unroll
            for (int k = 0; k < 2; ++k) { float x[8]; unpack8(*(const LAS u32x4*)(U + t * 256 + w * 32 + k * 16), x);
#pragma unroll
                for (int j = 0; j < 8; ++j) { br += bb[8 * k + j] * x[j]; bi += bb[16 + 8 * k + j] * x[j]; } }
            const float nr = ab.x * sr - ab.y * si + br, ni = ab.x * si + ab.y * sr + bi; sr = nr; si = ni;
            *(LAS f32x2*)(ST + t8 * 520 + F.lane * 8) = (f32x2){sr, si}; }
        LDS_WAIT();
        float y0 = 0.f, y1 = 0.f;
#pragma unroll 8
        for (int n = 0; n < 64; ++n) { const f32x2 sv = *(const LAS f32x2*)(ST + tl * 520 + n * 8); const f32x4 cv = *(const LAS f32x4*)(CT + ((w * 64 + n) * 16 + 2 * co) * 2);
            y0 += cv[0] * sv.x - cv[1] * sv.y; y1 += cv[2] * sv.x - cv[3] * sv.y; }
        const int t = tt * 8 + tl; const unsigned uv = *(const LAS unsigned*)(U + t * 256 + w * 32 + co * 4);
        y0 = gelu_(y0 + dk0 * bflo(uv)); y1 = gelu_(y1 + dk1 * bfhi(uv));
        *(unsigned*)(Y5 + (row0 + t) * 512 + g * 16 + 2 * co) = pk2(y0, y1);
        LDS_WAIT();
    }
    __syncthreads();
}

__global__ void __launch_bounds__(512, 2) fwd(Args a) {
    extern __shared__ __attribute__((aligned(16))) unsigned char shm[];
    Frame F; F.lds = (ldsp)shm; F.tid = threadIdx.x; F.lane = F.tid & 63; F.wave = __builtin_amdgcn_readfirstlane(F.tid >> 6); F.G = gridDim.x; F.bx = blockIdx.x; F.ws = a.ws;
    volatile LAS unsigned* LC = (volatile LAS unsigned*)(F.lds + LDS_CTL);
    if (F.tid < 128) LC[F.tid] = 0u;
    __syncthreads();
#if MK_SINGLE
    XcdBarrier bar = xcd_barrier_post((unsigned*)(F.ws + WS_CTL) + CW_BAR, LC + 8);
#define GRID_BAR() xcd_barrier(bar)
#else
#define GRID_BAR() do {} while (0)
#endif
    const int lo = a.ph_lo, hi = a.ph_hi;
#ifdef ONLY_PHASE
#define IN(k) ((k) == ONLY_PHASE && lo <= (k) && (k) < hi)
#else
#define IN(k) (lo <= (k) && (k) < hi)
#endif
#define SEAM(k) do { if (IN(k) && IN((k) + 1)) GRID_BAR(); } while (0)
    bf16_t* XN = (bf16_t*)(F.ws + WS_XN); bf16_t* MIX = (bf16_t*)(F.ws + WS_MIX); bf16_t* PROJ = (bf16_t*)(F.ws + WS_PROJ);

    if (IN(0)) { phase_prologue(F, a); } SEAM(0);
    if (IN(1)) { pg8::Tile2D S; S.init(XN, F.ws + WS_WIN0, T, PLD, 2048, 2048, F.G, F.bx); pg8::EpiBf16 E{PROJ, PLD};
        pg8::gemm_phase<pg8::EpiBf16, pg8::Tile2D, false>(F.lds, 2048, 2048, 2048, S, E); } SEAM(1);
    if (IN(2)) { for (int u = F.bx; u < 1536; u += F.G) { if (u < 512) ssd_local_unit(F, a, u); else ret_local_unit(F, a, u - 512); } } SEAM(2);
    if (IN(3)) { phase_even_scan(F, a); } SEAM(3);
    if (IN(4)) { for (int u = F.bx; u < 1280; u += F.G) { if (u < 256) ssd_out_unit(F, a, u); else ret_out_unit(F, a, u - 256); } } SEAM(4);
    if (IN(5)) { pg8::Tile2D S; S.init(MIX, F.ws + WS_WOUT0, T, 2048, 2048, 2048, F.G, F.bx); pg8::EpiResF32 E{a.in[I_X], a.out, 2048};
        pg8::gemm_phase<pg8::EpiResF32, pg8::Tile2D, false>(F.lds, 2048, 2048, 2048, S, E); } SEAM(5);
    if (IN(6)) { phase_router(F, a, 0); } SEAM(6);
    if (IN(7)) { phase_moe_gateup(F, a, 0); } SEAM(7);
    if (IN(8)) { phase_moe_down(F, a, 0); } SEAM(8);
    if (IN(9)) { phase_combine<false>(F, a, 0); __syncthreads(); moe_convert(F, a, 1); } SEAM(9);
    if (IN(10)) { pg8::Tile2D S; S.init(XN, F.ws + WS_WIN1, T, PLD, 2048, 2048, F.G, F.bx); pg8::EpiBf16 E{PROJ, PLD};
        pg8::gemm_phase<pg8::EpiBf16, pg8::Tile2D, false>(F.lds, 2048, 2048, 2048, S, E); } SEAM(10);
    if (IN(11)) { for (int u = F.bx; u < 2048; u += F.G) { if (u < 1536) mlstm_local_unit(F, a, u); else s5_local_unit(F, a, u - 1536); } } SEAM(11);
    if (IN(12)) { phase_odd_scan(F, a); } SEAM(12);
    if (IN(13)) { for (int u = F.bx; u < 1024; u += F.G) {
#ifndef NO_ML
            if (u < 512) mlstm_out_unit(F, a, u);
#endif
#ifndef NO_S5
            if (u >= 512) s5_out_unit(F, a, u - 512);
#endif
 } } SEAM(13);
    if (IN(14)) { pg8::Tile2D S; S.init(F.ws + WS_Y5, F.ws + WS_WGLU, T, 1024, 512, 512, F.G, F.bx); pg8::EpiGlu E{MIX + 1536, 2048, a.in[I_S5_BGLU]};
        pg8::GluOrder GS{S};
        pg8::gemm_phase<pg8::EpiGlu, pg8::GluOrder, false>(F.lds, 512, 512, 512, GS, E); } SEAM(14);
    if (IN(15)) { pg8::Tile2D S; S.init(MIX, F.ws + WS_WOUT1, T, 2048, 2048, 2048, F.G, F.bx); pg8::EpiResF32 E{a.out, a.out, 2048};
        pg8::gemm_phase<pg8::EpiResF32, pg8::Tile2D, false>(F.lds, 2048, 2048, 2048, S, E); } SEAM(15);
    if (IN(16)) { phase_router(F, a, 1); } SEAM(16);
    if (IN(17)) { phase_moe_gateup(F, a, 1); } SEAM(17);
    if (IN(18)) { phase_moe_down(F, a, 1); } SEAM(18);
    if (IN(19)) { phase_combine<true>(F, a, 1); }
#undef IN
#undef SEAM
}


#if DBG
constexpr size_t WS_DBG = WS_SMALL + 65536;
__device__ __forceinline__ void dbg_pub(float err, unsigned char* ws) {
    __shared__ unsigned red_;
    if (threadIdx.x == 0) red_ = 0u; __syncthreads();
    if (!(err >= 0.f)) err = __builtin_nanf("");
    atomicMax(&red_, __float_as_uint(err)); __syncthreads();
    if (threadIdx.x == 0) atomicMax((unsigned*)(ws + WS_DBG), red_);
    __syncthreads();
}
__device__ __forceinline__ float dbg_bsum(float v, float* sh) {
    __syncthreads(); sh[threadIdx.x] = v; __syncthreads();
    float t = 0.f; for (int i = 0; i < (int)blockDim.x; ++i) t += sh[i];
    __syncthreads(); return t;
}
__global__ void dbg_dump(float* out, const unsigned char* ws) {
    const size_t i = (size_t)blockIdx.x * blockDim.x + threadIdx.x; const size_t N = (size_t)T * D;
    if (i < N) { float v = 0.f; if (i == 0) { const float E = *(const float*)(ws + WS_DBG); float t = 10.f + log10f(fmaxf(E, 1e-12f)); t = fminf(fmaxf(t, 0.5f), 30.f); if (!(E == E)) t = 25.f; v = sqrtf((float)N * t); } out[i] = v; }
}
#define PRJ(row, col) bf2f(((const bf16_t*)(a.ws + WS_PROJ))[(size_t)(row) * PLD + (col)])
#define MIXV(row, col) bf2f(((const bf16_t*)(a.ws + WS_MIX))[(size_t)(row) * 2048 + (col)])
__device__ __forceinline__ float dbg_conv_(const bf16_t* prj, const float* cw, const float* cb, int C, size_t row, int pos, int col0, int ch) {
    float y = cb[ch];
    for (int tap = 0; tap < 4; ++tap) if (pos - 3 + tap >= 0) y += cw[tap * C + ch] * bf2f(prj[(size_t)(row - 3 + tap) * PLD + col0 + ch]);
    return y / (1.f + expf(-y));
}
#define dbg_conv(a, layer1, row, pos, col0, ch) dbg_conv_((const bf16_t*)((a).ws + WS_PROJ), (a).in[(layer1) ? I_ML_CONVW : I_SSD_CONVW], (a).in[(layer1) ? I_ML_CONVB : I_SSD_CONVB], (layer1) ? 3072 : 1536, row, pos, col0, ch)
__global__ void dbg_check_proj(Args a, int layer1) {
    const int tid = threadIdx.x + blockIdx.x * blockDim.x; const int NN = layer1 ? N1 : N0; const int row = (tid * 7919 + 13) % T, col = (tid * 104729 + 7) % NN;
    const float* x = (layer1 ? a.out : a.in[I_X]) + (size_t)row * D; const float* g = a.in[layer1 ? I_ODD_NORM : I_EVEN_NORM]; const float* W = a.in[layer1 ? I_ODD_WIN : I_EVEN_WIN];
    float ss = 0.f; for (int k = 0; k < D; ++k) ss += x[k] * x[k];
    const float rstd = rsqrtf(ss / D + EPS); float ref = 0.f;
    for (int k = 0; k < D; ++k) ref += x[k] * rstd * g[k] * W[(size_t)k * NN + col];
    dbg_pub(fabsf(PRJ(row, col) - ref) / (fabsf(ref) + 0.25f), a.ws);
}
__global__ void dbg_check_outproj(Args a, int layer1, const float* hprev) {
    const int tid = threadIdx.x + blockIdx.x * blockDim.x; const int row = (tid * 7919 + 13) % T, col = (tid * 104729 + 7) % D;
    const float* W = a.in[layer1 ? I_ODD_WOUT : I_EVEN_WOUT]; float ref = 0.f;
    for (int k = 0; k < 2048; ++k) ref += MIXV(row, k) * W[(size_t)k * D + col];
    const float r0 = hprev[(size_t)row * D + col];
    dbg_pub(fabsf(a.out[(size_t)row * D + col] - (r0 + ref)) / (fabsf(ref) + 0.25f), a.ws);
}
__global__ void dbg_check_ret(Args a) {
    __shared__ float qs[128], ks[128], sh[128];
    const int i = blockIdx.x, b = i & 3, h = (i >> 2) & 7, pos = (i * 977 + 131 + (i & 1) * 60) % SEQ, e = threadIdx.x; const size_t rb = (size_t)b * SEQ;
    const float lg = log1pf(-exp2f(-5.f - (float)h)); const int dd = e & 63; const float inv = 1.0f / powf(10000.f, (float)(2 * dd) / 128.f);
    { const float ang = (float)pos * inv, c = cosf(ang), sn = sinf(ang); const float t1 = PRJ(rb + pos, h * 128 + dd), t2 = PRJ(rb + pos, h * 128 + dd + 64); qs[e] = e < 64 ? t1 * c - t2 * sn : t1 * sn + t2 * c; }
    float o = 0.f;
    for (int s = 0; s <= pos; ++s) {
        __syncthreads();
        { const float ang = (float)s * inv, c = cosf(ang), sn = sinf(ang); const float t1 = PRJ(rb + s, P0_K + h * 128 + dd), t2 = PRJ(rb + s, P0_K + h * 128 + dd + 64); ks[e] = (e < 64 ? t1 * c - t2 * sn : t1 * sn + t2 * c) * 0.08838834764831845f; }
        __syncthreads();
        float sc = 0.f;
#pragma unroll 4
        for (int d = 0; d < 128; ++d) sc += qs[d] * ks[d];
        o += sc * expf(lg * (float)(pos - s)) * PRJ(rb + s, P0_V + h * 128 + e);
    }
    const float mean = dbg_bsum(o, sh) / 128.f; const float var = dbg_bsum((o - mean) * (o - mean), sh) / 128.f;
    const float gg = PRJ(rb + pos, P0_G + h * 128 + e);
    const float ref = (o - mean) * rsqrtf(var + EPS) * a.in[I_RET_NORM][h * 128 + e] * (gg / (1.f + expf(-gg)));
    dbg_pub(fabsf(MIXV(rb + pos, h * 128 + e) - ref) / (fabsf(ref) + 0.25f), a.ws);
}
__global__ void __launch_bounds__(512) dbg_check_ssd(Args a) {
    __shared__ float bms[128], cms[128], sh[512];
    const int i = blockIdx.x, b = i & 3, g = (i >> 2) & 1, pos = (i * 977 + 131 + (i & 1) * 60) % SEQ, ch = threadIdx.x, r = ch >> 6, hd = g * 8 + r; const size_t rb = (size_t)b * SEQ;
    const float A = -expf(a.in[I_SSD_ALOG][hd]), dtb = a.in[I_SSD_DTB][hd];
    float Apos = 0.f;
    for (int s = 0; s <= pos; ++s) { const float v = PRJ(rb + s, P0_DT + hd) + dtb; const float dt = v > 20.f ? v : log1pf(expf(v)); Apos += dt * A; }
    if (ch < 128) cms[ch] = dbg_conv(a, 0, rb + pos, pos, P0_XBC, 1280 + g * 128 + ch);
    float y = 0.f, As = 0.f;
    for (int s = 0; s <= pos; ++s) {
        __syncthreads();
        if (ch < 128) bms[ch] = dbg_conv(a, 0, rb + s, s, P0_XBC, 1024 + g * 128 + ch);
        __syncthreads();
        float cb = 0.f;
#pragma unroll 4
        for (int n = 0; n < 128; ++n) cb += cms[n] * bms[n];
        const float v = PRJ(rb + s, P0_DT + hd) + dtb; const float dt = v > 20.f ? v : log1pf(expf(v)); As += dt * A;
        y += cb * expf(Apos - As) * dbg_conv(a, 0, rb + s, s, P0_XBC, g * 512 + ch) * dt;
    }
    const float xs = dbg_conv(a, 0, rb + pos, pos, P0_XBC, g * 512 + ch), z = PRJ(rb + pos, P0_Z + g * 512 + ch);
    y = (y + a.in[I_SSD_D][hd] * xs) * (z / (1.f + expf(-z)));
    const float ms = dbg_bsum(y * y, sh) / 512.f;
    const float ref = y * rsqrtf(ms + EPS) * a.in[I_SSD_NORM][g * 512 + ch];
    dbg_pub(fabsf(MIXV(rb + pos, 1024 + g * 512 + ch) - ref) / (fabsf(ref) + 0.25f), a.ws);
}
__global__ void __launch_bounds__(384) dbg_check_mlstm(Args a) {
    __shared__ float qs[384], ks[384], sh[384];
    const int i = blockIdx.x, b = i & 3, h = (i >> 2) & 3, pos = (i * 977 + 131 + (i & 1) * 60) % SEQ, e = threadIdx.x; const size_t rb = (size_t)b * SEQ;
    const float fb = a.in[I_ML_FB][h], ib = a.in[I_ML_IB][h];
    float Fpos = 0.f; for (int s = 0; s <= pos; ++s) { const float f = PRJ(rb + s, P1_F + h) + fb; Fpos += -(-f > 20.f ? -f : log1pf(expf(-f))); }
    float m = -INFINITY, Fs = 0.f; for (int s = 0; s <= pos; ++s) { const float f = PRJ(rb + s, P1_F + h) + fb; Fs += -(-f > 20.f ? -f : log1pf(expf(-f))); m = fmaxf(m, Fpos - Fs + PRJ(rb + s, P1_I + h) + ib); }
    qs[e] = dbg_conv(a, 1, rb + pos, pos, 0, h * 384 + e) * 0.05103103630798288f;
    float N = 0.f, Dn = 0.f; Fs = 0.f;
    for (int s = 0; s <= pos; ++s) {
        __syncthreads();
        ks[e] = dbg_conv(a, 1, rb + s, s, 0, 1536 + h * 384 + e);
        __syncthreads();
        float qk = 0.f;
#pragma unroll 4
        for (int d = 0; d < 384; ++d) qk += qs[d] * ks[d];
        const float f = PRJ(rb + s, P1_F + h) + fb; Fs += -(-f > 20.f ? -f : log1pf(expf(-f)));
        const float w = expf(Fpos - Fs + PRJ(rb + s, P1_I + h) + ib - m);
        N += w * qk * PRJ(rb + s, P1_V + h * 384 + e); Dn += w * qk;
    }
    const float hv = N / fmaxf(fabsf(Dn), expf(-m));
    const float mean = dbg_bsum(hv, sh) / 384.f; const float var = dbg_bsum((hv - mean) * (hv - mean), sh) / 384.f;
    const float o = PRJ(rb + pos, P1_O + h * 384 + e);
    const float ref = (hv - mean) * rsqrtf(var + EPS) * a.in[I_ML_NORM][h * 384 + e] / (1.f + expf(-o));
    dbg_pub(fabsf(MIXV(rb + pos, h * 384 + e) - ref) / (fabsf(ref) + 0.25f), a.ws);
}
__global__ void dbg_check_s5(Args a) {
    __shared__ float yr[16][64];
    const int i = blockIdx.x, b = i & 3, g = (i >> 2) & 31, pos = (i * 977 + 131 + (i & 1) * 60) % SEQ, n = threadIdx.x; const size_t rb = (size_t)b * SEQ;
    const float dt = expf(a.in[I_S5_LOGDT][g]), are = a.in[I_S5_ARE][g * 64 + n], aim = a.in[I_S5_AIM][g * 64 + n];
    const float mag = expf(are * dt), abr = mag * cosf(aim * dt), abi = mag * sinf(aim * dt), den = are * are + aim * aim, nr = abr - 1.f;
    const float cr = (nr * are + abi * aim) / den, ci = (abi * are - nr * aim) / den;
    float bbr[16], bbi[16];
#pragma unroll
    for (int c = 0; c < 16; ++c) { const float br = a.in[I_S5_BRE][(size_t)(g * 64 + n) * 16 + c], bi = a.in[I_S5_BIM][(size_t)(g * 64 + n) * 16 + c]; bbr[c] = cr * br - ci * bi; bbi[c] = cr * bi + ci * br; }
    float sr = 0.f, si = 0.f;
    for (int t = 0; t <= pos; ++t) { float ur = 0.f, ui = 0.f;
#pragma unroll
        for (int c = 0; c < 16; ++c) { const float u = PRJ(rb + t, P1_U + g * 16 + c); ur += bbr[c] * u; ui += bbi[c] * u; }
        const float nr2 = abr * sr - abi * si + ur, ni2 = abr * si + abi * sr + ui; sr = nr2; si = ni2; }
    for (int c = 0; c < 16; ++c) yr[c][n] = a.in[I_S5_CRE][(size_t)(g * 16 + c) * 64 + n] * sr - a.in[I_S5_CIM][(size_t)(g * 16 + c) * 64 + n] * si;
    __syncthreads();
    float err = 0.f;
    if (n < 16) { float y = 0.f; for (int k = 0; k < 64; ++k) y += yr[n][k]; y += a.in[I_S5_D][g * 16 + n] * PRJ(rb + pos, P1_U + g * 16 + n);
        const float u = 0.7978845608f * (y + 0.044715f * y * y * y); const float ref = 0.5f * y * (1.f + tanhf(u));
        const float got = bf2f(((const bf16_t*)(a.ws + WS_Y5))[(rb + pos) * 512 + g * 16 + n]); err = fabsf(got - ref) / (fabsf(ref) + 0.25f); }
    dbg_pub(err, a.ws);
}
__global__ void dbg_check_glu(Args a) {
    const int tid = threadIdx.x + blockIdx.x * blockDim.x; const int row = (tid * 7919 + 13) % T, col = (tid * 104729 + 7) % 512;
    float v = a.in[I_S5_BGLU][col], gt = a.in[I_S5_BGLU][512 + col];
    for (int k = 0; k < 512; ++k) { const float y = bf2f(((const bf16_t*)(a.ws + WS_Y5))[(size_t)row * 512 + k]); v += y * a.in[I_S5_WGLU][(size_t)k * 1024 + col]; gt += y * a.in[I_S5_WGLU][(size_t)k * 1024 + 512 + col]; }
    const float ref = v / (1.f + expf(-gt));
    dbg_pub(fabsf(MIXV(row, 1536 + col) - ref) / (fabsf(ref) + 0.25f), a.ws);
}
__global__ void dbg_check_router(Args a, int layer) {
    const int tid = threadIdx.x + blockIdx.x * blockDim.x; const int tok = (tid * 7919 + 13) % T; const float* x = a.out + (size_t)tok * D;
    float ss = 0.f; for (int k = 0; k < D; ++k) ss += x[k] * x[k];
    const float rstd = rsqrtf(ss / D + EPS); float gmax = -INFINITY, gsec = -INFINITY; int gi = 0; float se = 0.f;
    for (int j = 0; j < 4; ++j) { float l = 0.f; for (int k = 0; k < D; ++k) l += x[k] * rstd * a.in[I_MOE_NORM][layer * D + k] * a.in[I_MOE_RG][(size_t)(layer * D + k) * 4 + j]; l += a.in[I_MOE_RGB][layer * 4 + j];
        if (l > gmax) { se = se * expf(gmax - l) + 1.f; gsec = gmax; gmax = l; gi = j; } else { se += expf(l - gmax); gsec = fmaxf(gsec, l); } }
    float v1 = -INFINITY, v2 = -INFINITY, v3 = -INFINITY; int i1 = 0, i2 = 0;
    for (int j = 0; j < 8; ++j) { float l = 0.f; for (int k = 0; k < D; ++k) l += x[k] * rstd * a.in[I_MOE_NORM][layer * D + k] * a.in[I_MOE_RE][(size_t)(layer * D + k) * 32 + gi * 8 + j]; l += a.in[I_MOE_REB][layer * 32 + gi * 8 + j];
        if (l > v1) { v3 = v2; v2 = v1; i2 = i1; v1 = l; i1 = j; } else if (l > v2) { v3 = v2; v2 = l; i2 = j; } else v3 = fmaxf(v3, l); }
    const float e2 = expf(v2 - v1), w1 = (1.f / se) / (1.f + e2), w2 = (1.f / se) * e2 / (1.f + e2);
    const int* sp = (const int*)(a.ws + WS_SLOT) + (size_t)tok * 8;
    float err = 0.f;
    if (sp[0] != gi * 8 + i1 || sp[3] != gi * 8 + i2) err += (v2 - v3 > 1e-3f && v1 - v2 > 1e-3f && gmax - gsec > 1e-3f) ? 1.f : 0.f;
    else err = fabsf(__int_as_float(sp[2]) - w1) + fabsf(__int_as_float(sp[5]) - w2);
    const unsigned* cnt = (const unsigned*)(a.ws + WS_CTL) + CW_CNT + layer * 32 * 64; unsigned tot = 0; for (int e = 0; e < 32; ++e) tot += cnt[e * 64];
    if (tot != 2u * T) err += 2.f;
    if (sp[1] < 0 || sp[1] >= (int)cnt[sp[0] * 64] || ((const int*)(a.ws + WS_LIST))[sp[0] * T + sp[1]] != tok) err += 4.f;
    dbg_pub(err, a.ws);
}
__device__ __forceinline__ bool dbg_bad(float v) { return !(v - v == 0.f); }
__global__ void dbg_scan_odd(Args a) {
    const size_t gt = (size_t)blockIdx.x * blockDim.x + threadIdx.x, NT_ = (size_t)gridDim.x * blockDim.x; unsigned fl = 0u;
    const float* MS = (const float*)(a.ws + WS_SMALL + 16384); const float* MST = (const float*)(a.ws + WS_SMALL + 32768);
    for (size_t i = gt; i < 1024; i += NT_) if (dbg_bad(MS[i])) fl |= 1u;
    for (size_t i = gt; i < 512; i += NT_) { const float v = MST[i]; if ((i & 31) == 0 ? !(v == -INFINITY) : dbg_bad(v)) fl |= 2u; }
    const bf16_t* MC = (const bf16_t*)(a.ws + WS_MC); for (size_t i = gt; i < (size_t)16 * 32 * 147456; i += NT_) if (dbg_bad(bf2f(MC[i]))) fl |= 4u;
    const float* MN = (const float*)(a.ws + WS_MN); for (size_t i = gt; i < (size_t)16 * 32 * 384; i += NT_) if (dbg_bad(MN[i])) fl |= 8u;
    const bf16_t* MX = (const bf16_t*)(a.ws + WS_MIX); for (size_t i = gt; i < (size_t)T * 1536; i += NT_) if (dbg_bad(bf2f(MX[(i / 1536) * 2048 + (i % 1536)]))) fl |= 16u;
    const bf16_t* PJ = (const bf16_t*)(a.ws + WS_PROJ); for (size_t i = gt; i < (size_t)T * N1; i += NT_) if (dbg_bad(bf2f(PJ[(i / N1) * PLD + (i % N1)]))) fl |= 32u;
    if (fl) atomicOr((unsigned*)(a.ws + WS_DBG + 4), fl);
}
__global__ void dbg_count_mc(Args a) {
    const size_t gt = (size_t)blockIdx.x * blockDim.x + threadIdx.x, NT_ = (size_t)gridDim.x * blockDim.x; unsigned n = 0;
    const bf16_t* MC = (const bf16_t*)(a.ws + WS_MC); for (size_t i = gt; i < (size_t)16 * 32 * 147456; i += NT_) if (dbg_bad(bf2f(MC[i]))) ++n;
    if (n) atomicAdd((unsigned*)(a.ws + WS_DBG + 4), n);
}
__global__ void dbg_count_fin(Args a) { const unsigned n = *(const unsigned*)(a.ws + WS_DBG + 4); *(float*)(a.ws + WS_DBG) = exp10f(log10f((float)n + 1.f) - 9.f); }
__global__ void dbg_scan_fin(Args a) { const unsigned fl = *(const unsigned*)(a.ws + WS_DBG + 4); *(float*)(a.ws + WS_DBG) = exp10f(0.1f * (float)fl - 9.f); }
__global__ void __launch_bounds__(512) dbg_check_moe(Args a, int layer) {
    __shared__ float xs[2048], hid[512]; __shared__ int ts[33];
    const int i = blockIdx.x, tok = (i * 7919 + 13) % T, slot = i & 1, f = threadIdx.x;
    const int* sp = (const int*)(a.ws + WS_SLOT) + (size_t)tok * 8; const int e = sp[slot * 3], r = sp[slot * 3 + 1];
    if (f == 0) { const unsigned* cnt = (const unsigned*)(a.ws + WS_CTL) + CW_CNT + layer * 32 * 64; int acc = 0; for (int q = 0; q < 32; ++q) { ts[q] = acc; acc += ((int)cnt[q * 64] + 255) >> 8; } }
    for (int k = f; k < 2048; k += 512) xs[k] = bf2f(((const bf16_t*)(a.ws + WS_XN))[(size_t)tok * D + k]);
    __syncthreads();
    const float* wg = a.in[I_MOE_WG] + (size_t)(layer * 32 + e) * 2048 * 512; const float* wu = a.in[I_MOE_WU] + (size_t)(layer * 32 + e) * 2048 * 512; const float* wd = a.in[I_MOE_WD] + (size_t)(layer * 32 + e) * 512 * 2048;
    float gg = 0.f, uu = 0.f; for (int k = 0; k < 2048; ++k) { gg += xs[k] * wg[(size_t)k * 512 + f]; uu += xs[k] * wu[(size_t)k * 512 + f]; }
    hid[f] = gg / (1.f + expf(-gg)) * uu;
    __syncthreads();
    const int col = (f * 37 + 5) % D; float ref = 0.f; for (int k = 0; k < 512; ++k) ref += hid[k] * wd[(size_t)k * D + col];
    const float got = bf2f(((const bf16_t*)(a.ws + WS_Y))[(size_t)(ts[e] * 256 + r) * D + col]);
    dbg_pub(fabsf(got - ref) / (fabsf(ref) + 0.25f), a.ws);
}
#endif

extern "C" void kernel_launch(void* const* d_in, const int* in_sizes, int n_in, void* d_out, int out_size, void* d_ws, size_t ws_size, hipStream_t stream) {
    static int grid = 0;
    if (grid == 0) {
        if (n_in != 38 || out_size != T * D || ws_size < WS_END) { fprintf(stderr, "kernel_launch: unexpected problem (n_in %d, out %d, ws %zu)\n", n_in, out_size, ws_size); grid = -1; return; }
        int dev = 0, cus = 0, per_cu = 0;
        if (hipGetDevice(&dev) != hipSuccess || hipDeviceGetAttribute(&cus, hipDeviceAttributeMultiprocessorCount, dev) != hipSuccess) { grid = -1; return; }
        if (hipFuncSetAttribute((const void*)fwd, hipFuncAttributeMaxDynamicSharedMemorySize, LDS_BYTES) != hipSuccess) { fprintf(stderr, "kernel_launch: hipFuncSetAttribute failed\n"); grid = -1; return; }
        if (hipOccupancyMaxActiveBlocksPerMultiprocessor(&per_cu, (const void*)fwd, 512, LDS_BYTES) != hipSuccess || per_cu < 1) fprintf(stderr, "kernel_launch: occupancy query reports %d\n", per_cu);
        (void)hipGetLastError();
        grid = cus;
    }
    if (grid < 0) return;
    (void)hipMemsetAsync((char*)d_ws + WS_CTL, 0, CTL_BYTES, stream);
    Args a{};
    for (int i = 0; i < 38; ++i) a.in[i] = (const float*)d_in[i];
    a.out = (float*)d_out; a.ws = (unsigned char*)d_ws;
#if DBG
    constexpr int dbg_last = (DBG == 1) ? 1 : (DBG == 2 || DBG == 3) ? 4 : (DBG == 4) ? 5 : (DBG == 5) ? 6 : (DBG == 6 || DBG == 20) ? 8 : (DBG == 7) ? 10 : (DBG == 31 || DBG == 33 || DBG == 34 || DBG == 35) ? 11 : (DBG == 32) ? 12 : (DBG == 8 || DBG == 9 || DBG == 30) ? 13 : (DBG == 10) ? 14 : (DBG == 11) ? 15 : (DBG == 12) ? 16 : 18;
    (void)hipMemsetAsync((char*)d_ws + WS_DBG, 0, 8, stream);
    float* hsave = (float*)((char*)d_ws + WS_END);
#define DBG_ON(k) (DBG == (k) || (DBG == 20 && (k) <= 6) || (DBG == 21 && (k) >= 7))
    for (int p = 0; p <= dbg_last; ++p) {
        if (p == 11 && DBG == 34) (void)hipMemsetAsync((char*)d_ws + WS_MC, 0, (size_t)144 * MiB, stream);
        if (p == 15 && DBG_ON(11)) (void)hipMemcpyAsync(hsave, d_out, (size_t)T * D * 4, hipMemcpyDeviceToDevice, stream);
        a.ph_lo = p; a.ph_hi = p + 1; hipLaunchKernelGGL(fwd, dim3(grid), dim3(512), LDS_BYTES, stream, a);
        a.ph_lo = 0; a.ph_hi = 0;
        if (p == 1 && DBG_ON(1)) hipLaunchKernelGGL(dbg_check_proj, dim3(4), dim3(256), 0, stream, a, 0);
        if (p == 4 && DBG_ON(2)) hipLaunchKernelGGL(dbg_check_ret, dim3(32), dim3(128), 0, stream, a);
        if (p == 4 && DBG_ON(3)) hipLaunchKernelGGL(dbg_check_ssd, dim3(16), dim3(512), 0, stream, a);
        if (p == 5 && DBG_ON(4)) hipLaunchKernelGGL(dbg_check_outproj, dim3(4), dim3(256), 0, stream, a, 0, (const float*)d_in[0]);
        if (p == 6 && DBG_ON(5)) hipLaunchKernelGGL(dbg_check_router, dim3(4), dim3(128), 0, stream, a, 0);
        if (p == 8 && DBG_ON(6)) hipLaunchKernelGGL(dbg_check_moe, dim3(32), dim3(512), 0, stream, a, 0);
        if (p == 10 && DBG_ON(7)) hipLaunchKernelGGL(dbg_check_proj, dim3(4), dim3(256), 0, stream, a, 1);
        if (p == 13 && DBG_ON(8)) hipLaunchKernelGGL(dbg_check_mlstm, dim3(16), dim3(384), 0, stream, a);
        if (p == 13 && DBG_ON(9)) hipLaunchKernelGGL(dbg_check_s5, dim3(64), dim3(64), 0, stream, a);
        if ((p == 13 && DBG == 30) || (p == 11 && DBG == 31) || (p == 12 && DBG == 32)) { hipLaunchKernelGGL(dbg_scan_odd, dim3(1024), dim3(256), 0, stream, a); hipLaunchKernelGGL(dbg_scan_fin, dim3(1), dim3(1), 0, stream, a); }
        if (p == 11 && (DBG == 33 || DBG == 34)) { hipLaunchKernelGGL(dbg_count_mc, dim3(1024), dim3(256), 0, stream, a); hipLaunchKernelGGL(dbg_count_fin, dim3(1), dim3(1), 0, stream, a); }
        if (p == 11 && DBG == 35) hipLaunchKernelGGL(dbg_scan_fin, dim3(1), dim3(1), 0, stream, a);
        if (p == 14 && DBG_ON(10)) hipLaunchKernelGGL(dbg_check_glu, dim3(4), dim3(256), 0, stream, a);
        if (p == 15 && DBG_ON(11)) hipLaunchKernelGGL(dbg_check_outproj, dim3(4), dim3(256), 0, stream, a, 1, (const float*)hsave);
        if (p == 16 && DBG_ON(12)) hipLaunchKernelGGL(dbg_check_router, dim3(4), dim3(128), 0, stream, a, 1);
        if (p == 18 && DBG_ON(13)) hipLaunchKernelGGL(dbg_check_moe, dim3(32), dim3(512), 0, stream, a, 1);
    }
    hipLaunchKernelGGL(dbg_dump, dim3((T * D + 255) / 256), dim3(256), 0, stream, (float*)d_out, (const unsigned char*)d_ws);
#elif MK_SINGLE
    a.ph_lo = 0; a.ph_hi = NPHASE;
    hipLaunchKernelGGL(fwd, dim3(grid), dim3(512), LDS_BYTES, stream, a);
#else
    for (int p = 0; p < NPHASE; ++p) { a.ph_lo = p; a.ph_hi = p + 1; hipLaunchKernelGGL(fwd, dim3(grid), dim3(512), LDS_BYTES, stream, a); }
#endif
}
```

```cpp
#include <hip/hip_runtime.h>
#include <cstdio>
#include <cstdint>

#ifndef MK_SINGLE
#define MK_SINGLE 1
#endif
#ifndef DBG
#define DBG 0
#endif
#ifndef ML_REP
#define ML_REP 1
#endif
#ifndef S5_REP
#define S5_REP 1
#endif
#ifndef CONV_REP
#define CONV_REP 1
#endif
#ifndef KNOB_A
#define KNOB_A 1
#endif
#ifndef KNOB_B
#define KNOB_B 1
#endif
#ifndef KNOB_C
#define KNOB_C 1
#endif
#ifndef REP_MASK
#define REP_MASK 0
#endif
#ifndef REP_N
#define REP_N 2
#endif

#define DI __device__ __forceinline__
#define LAS __attribute__((address_space(3)))
typedef unsigned short bf16_t;
typedef short bf16x8 __attribute__((ext_vector_type(8)));
typedef float f32x4 __attribute__((ext_vector_type(4)));
typedef float f32x2 __attribute__((ext_vector_type(2)));
typedef unsigned u32x4 __attribute__((ext_vector_type(4)));
typedef unsigned u32x2 __attribute__((ext_vector_type(2)));
typedef LAS unsigned char* ldsp;

constexpr int T = 16384, D = 2048, SEQ = 4096, NC = 32;
constexpr int PLD = 6912;
constexpr int N0 = 6672, N1 = 6664;
constexpr int P0_K = 1024, P0_V = 2048, P0_G = 3072, P0_Z = 4096, P0_XBC = 5120, P0_DT = 6656;
constexpr int P1_K = 1536, P1_V = 3072, P1_O = 4608, P1_I = 6144, P1_F = 6148, P1_U = 6152;
constexpr float EPS = 1e-6f;
constexpr int NPHASE = 22;
enum { PH_PRO = 0, PH_INPROJ0, PH_PRE0, PH_LOCAL0, PH_SCAN0, PH_OUT0, PH_OUTPROJ0, PH_ROUTER0, PH_GATEUP0, PH_DOWN0, PH_COMBINE0, PH_INPROJ1, PH_PRE1, PH_LOCAL1, PH_SCAN1, PH_OUT1, PH_GLU, PH_OUTPROJ1, PH_ROUTER1, PH_GATEUP1, PH_DOWN1, PH_COMBINE1 };

constexpr size_t MiB = 1u << 20;
constexpr size_t WS_CTL = 0, CTL_BYTES = 1 * MiB;
constexpr size_t WS_COS = 1 * MiB, WS_SIN = 2 * MiB;
constexpr size_t WS_RT = 3 * MiB;
constexpr size_t WS_S5T = 4 * MiB;
constexpr size_t WS_SMALL = 5 * MiB;
constexpr size_t WS_WIN0 = 8 * MiB, WS_WOUT0 = 35 * MiB, WS_WIN1 = 43 * MiB, WS_WOUT1 = 70 * MiB, WS_WGLU = 78 * MiB;
constexpr size_t WS_WGU = 80 * MiB, WS_WD = 208 * MiB;
constexpr size_t WS_XN = 272 * MiB, WS_MIX = 336 * MiB, WS_HID = 400 * MiB, WS_PROJ = 440 * MiB, WS_Y = WS_PROJ;
constexpr size_t WS_STATE = 656 * MiB;
constexpr size_t WS_RET_DS = WS_STATE, WS_RET_S = WS_STATE + 64 * MiB, WS_SSD_DS = WS_STATE + 96 * MiB, WS_SSD_S = WS_STATE + 160 * MiB;
constexpr size_t WS_MC = WS_STATE;
constexpr size_t WS_MN = WS_STATE + 144 * MiB;
constexpr size_t WS_S5E = WS_STATE + 146 * MiB;
constexpr size_t WS_Y5 = WS_STATE + 150 * MiB;
constexpr size_t WS_LIST = 856 * MiB;
constexpr size_t WS_SLOT = 858 * MiB;
constexpr size_t WS_QC = WS_XN;
constexpr size_t WS_XC = WS_XN;
constexpr size_t WS_ROWS = WS_XN + 48 * MiB;
constexpr size_t WS_KC = 860 * MiB;
constexpr size_t WS_S5K = 908 * MiB;
constexpr size_t WS_S5W = 910 * MiB;
constexpr size_t WS_S5C = 912 * MiB;
constexpr size_t WS_S5G = 913 * MiB;
constexpr size_t WS_H = 929 * MiB;
constexpr size_t WS_RSTD0 = WS_SMALL + (1u << 20) + 65536;
constexpr size_t WS_RSTD1 = WS_SMALL + (1u << 20);
constexpr size_t WS_END = 993 * MiB;
constexpr int CW_BAR = 4096;
constexpr int CW_CNT = 16384;

constexpr int LDS_TAB = 131072;
constexpr int LDS_CTL = 146944;
constexpr int LDS_BYTES = 147456;

typedef __bf16 bf16x2_t __attribute__((ext_vector_type(2)));
DI unsigned pk2(float lo, float hi) { const f32x2 v = {lo, hi}; const bf16x2_t r = __builtin_convertvector(v, bf16x2_t); return __builtin_bit_cast(unsigned, r); }
DI float bflo(unsigned w) { return __uint_as_float(w << 16); }
DI float bfhi(unsigned w) { return __uint_as_float(w & 0xffff0000u); }
DI float bf2f(bf16_t b) { return __uint_as_float(((unsigned)b) << 16); }
DI bf16_t f2bf(float f) { return (bf16_t)(pk2(f, 0.f) & 0xffffu); }
DI float sigmoid_(float x) { return __builtin_amdgcn_rcpf(1.f + __expf(-x)); }
DI float silu_(float x) { return x * sigmoid_(x); }
DI float softplus_(float x) { return x > 20.f ? x : log1pf(__expf(x)); }
DI float logsigmoid_(float x) { return -softplus_(-x); }
DI float gelu_(float x) { const float u = 0.7978845608f * (x + 0.044715f * x * x * x); const float t = 1.f - 2.f * __builtin_amdgcn_rcpf(1.f + __expf(2.f * u)); return 0.5f * x * (1.f + t); }
DI float wsum(float v) {
#pragma unroll
    for (int o = 1; o < 64; o <<= 1) v += __shfl_xor(v, o);
    return v; }
DI float wmax(float v) {
#pragma unroll
    for (int o = 1; o < 64; o <<= 1) v = fmaxf(v, __shfl_xor(v, o));
    return v; }
DI void unpack8(const u32x4 v, float (&f)[8]) { f[0] = bflo(v.x); f[1] = bfhi(v.x); f[2] = bflo(v.y); f[3] = bfhi(v.y); f[4] = bflo(v.z); f[5] = bfhi(v.z); f[6] = bflo(v.w); f[7] = bfhi(v.w); }
DI u32x4 pack8(const float (&f)[8]) { u32x4 o; o.x = pk2(f[0], f[1]); o.y = pk2(f[2], f[3]); o.z = pk2(f[4], f[5]); o.w = pk2(f[6], f[7]); return o; }
#define LDS_WAIT() asm volatile("s_waitcnt lgkmcnt(0)" ::: "memory")
DI void wscan_sum(float a0, float a1, int lane, float& c0, float& c1) {
    const float s = a0 + a1; float x = s;
#pragma unroll
    for (int o = 1; o < 64; o <<= 1) { const float y = __shfl_up(x, o); if (lane >= o) x += y; }
    const float ex = x - s; c0 = ex + a0; c1 = c0 + a1; }
DI void wscan_max(float a0, float a1, int lane, float& c0, float& c1) {
    const float s = fmaxf(a0, a1); float x = s;
#pragma unroll
    for (int o = 1; o < 64; o <<= 1) { const float y = __shfl_up(x, o); if (lane >= o) x = fmaxf(x, y); }
    float ex = __shfl_up(x, 1); if (lane == 0) ex = -INFINITY;
    c0 = fmaxf(ex, a0); c1 = fmaxf(c0, a1); }

namespace pg8 {
constexpr int BM = 256, BK = 64, HALF = 128, HTB = HALF * BK * 2, STAGE_BYTES = 8 * HTB;
DI int lds_byte(int r, int c) { const int st = (r >> 4) * 2 + (c >> 5), rr = r & 15, cc = c & 31, ob = rr * 64 + cc * 2; return st * 1024 + (ob ^ (((ob >> 9) & 1) << 5)); }
DI void stage_rc(int b, int& R, int& C) { const int st = b / 1024, sb = b % 1024, swz = sb ^ (((sb >> 9) & 1) << 5); R = (st >> 1) * 16 + swz / 64; C = (st & 1) * 32 + (swz % 64) / 2; }
DI int perm32(int rho) { const int n = rho >> 4, i = rho & 15; return 8 * (i >> 2) + 4 * n + (i & 3); }
struct Unit { const char* A; const char* B; int row0, col0, aux; };
typedef f32x4 Acc[2][2][4][2];

template <class Epi, class Sched, bool GATHER>
DI void gemm_phase(ldsp lds, const int K, const int lda, const int ldb, const Sched& S, const Epi& E) {
    const int tid = threadIdx.x, wid = __builtin_amdgcn_readfirstlane(tid >> 6), lane = tid & 63, wr = wid >> 2, wc = wid & 3, fr = lane & 15, fq = lane >> 4;
    const int nt = K / BK;
    unsigned voffA[2], voffB[2]; int RA[2], CA[2];
#pragma unroll
    for (int i = 0; i < 2; ++i) { int R, C; stage_rc(tid * 16 + i * 8192, R, C); const int Rb = Epi::PERM ? ((R & ~31) + perm32(R & 31)) : R;
        RA[i] = R; CA[i] = C; voffA[i] = (unsigned)(R * lda + C) * 2u; voffB[i] = (unsigned)(Rb * ldb + C) * 2u; }
    const unsigned hstepA = (unsigned)HALF * (unsigned)lda * 2u, hstepB = (unsigned)HALF * (unsigned)ldb * 2u;
    const size_t kstep = (size_t)(BK * 2);
    const unsigned ldsw = (unsigned)wid * 1024u;
    const int aoff = lds_byte(wr * 64 + fr, fq * 8), boff = lds_byte(wc * 32 + fr, fq * 8);
    unsigned vc[2][2], vn[2][2];
#define PG8_SA(b, h) (((b) * 2 + (h)) * HTB)
#define PG8_SB(b, h) ((4 + (b) * 2 + (h)) * HTB)
#define PG8_AOFF(h, i, NX) (GATHER ? ((NX) ? vn[h][i] : vc[h][i]) : (voffA[i] + (unsigned)(h) * hstepA))
#define PG8_STAGE_A(bufoff, gbase, h, NX) do { _Pragma("unroll") for (int _i = 0; _i < 2; ++_i) \
        __builtin_amdgcn_global_load_lds((const unsigned*)((const char*)(gbase) + PG8_AOFF(h, _i, NX)), (LAS unsigned*)(lds + (bufoff) + ldsw + _i * 8192), 16, 0, 0); } while (0)
#define PG8_STAGE_B(bufoff, gbase) do { _Pragma("unroll") for (int _i = 0; _i < 2; ++_i) \
        __builtin_amdgcn_global_load_lds((const unsigned*)((const char*)(gbase) + voffB[_i]), (LAS unsigned*)(lds + (bufoff) + ldsw + _i * 8192), 16, 0, 0); } while (0)
#define PG8_LDA(dst, b, h) do { _Pragma("unroll") for (int m = 0; m < 4; ++m) _Pragma("unroll") for (int k = 0; k < 2; ++k) dst[m][k] = *(const LAS bf16x8*)(lds + PG8_SA(b, h) + aoff + m * 2048 + k * 1024); } while (0)
#define PG8_LDB(dst, b, h) do { _Pragma("unroll") for (int n = 0; n < 2; ++n) _Pragma("unroll") for (int k = 0; k < 2; ++k) dst[n][k] = *(const LAS bf16x8*)(lds + PG8_SB(b, h) + boff + n * 2048 + k * 1024); } while (0)
#define PG8_MMA(ai, bj, At, Bt) do { __builtin_amdgcn_s_setprio(1); _Pragma("unroll") for (int m = 0; m < 4; ++m) _Pragma("unroll") for (int n = 0; n < 2; ++n) _Pragma("unroll") for (int k = 0; k < 2; ++k) \
        acc[ai][bj][m][n] = __builtin_amdgcn_mfma_f32_16x16x32_bf16(Bt[n][k], At[m][k], acc[ai][bj][m][n], 0, 0, 0); __builtin_amdgcn_s_setprio(0); } while (0)
#define PG8_WAIT_V(n) asm volatile("s_waitcnt vmcnt(" #n ")" ::: "memory")
#define PG8_WAIT_L(n) asm volatile("s_waitcnt lgkmcnt(" #n ")" ::: "memory")
#define PG8_BAR __builtin_amdgcn_s_barrier()
#define PG8_SCHED __builtin_amdgcn_sched_barrier(0)
    Unit cur, nxt; int ui = 0;
    if (!S.next(0, cur)) return;
    Acc acc;
#pragma unroll
    for (int a = 0; a < 2; ++a)
#pragma unroll
        for (int b = 0; b < 2; ++b)
#pragma unroll
            for (int m = 0; m < 4; ++m)
#pragma unroll
                for (int n = 0; n < 2; ++n) acc[a][b][m][n] = (f32x4){0.f, 0.f, 0.f, 0.f};
    bf16x8 At[4][2], B0[2][2], B1[2][2];
    const char* cA = cur.A; const char* cB = cur.B;
    if constexpr (GATHER) {
#pragma unroll
        for (int h = 0; h < 2; ++h)
#pragma unroll
            for (int i = 0; i < 2; ++i) { vc[h][i] = ((unsigned)S.grow(cur, RA[i] + 128 * h) * (unsigned)lda + (unsigned)CA[i]) * 2u; vn[h][i] = vc[h][i]; }
    }
    PG8_STAGE_B(PG8_SB(0, 0), cB); PG8_STAGE_B(PG8_SB(0, 1), cB + hstepB); PG8_STAGE_A(PG8_SA(0, 0), cA, 0, false); PG8_STAGE_A(PG8_SA(0, 1), cA, 1, false);
    if (wr == 1) PG8_BAR;
    PG8_WAIT_V(2); PG8_BAR;
    PG8_STAGE_B(PG8_SB(1, 0), cB + kstep); PG8_STAGE_A(PG8_SA(1, 0), cA + kstep, 0, false); PG8_STAGE_B(PG8_SB(1, 1), cB + hstepB + kstep);
    PG8_WAIT_V(6); PG8_BAR;
    for (;;) {
        const bool has_next = S.next(ui + 1, nxt);
        const char* nA = has_next ? nxt.A : cA; const char* nB = has_next ? nxt.B : cB;
        if constexpr (GATHER) {
            if (has_next) {
#pragma unroll
                for (int h = 0; h < 2; ++h)
#pragma unroll
                    for (int i = 0; i < 2; ++i) vn[h][i] = ((unsigned)S.grow(nxt, RA[i] + 128 * h) * (unsigned)lda + (unsigned)CA[i]) * 2u;
            }
        }
        for (int t = 0; t < nt; t += 2) {
            const bool last = (t == nt - 2);
            const char* a1 = cA + (size_t)(t + 1) * kstep;
            const char* a2 = last ? nA : cA + (size_t)(t + 2) * kstep; const char* b2 = last ? nB : cB + (size_t)(t + 2) * kstep;
            const char* a3 = a2 + kstep; const char* b3 = b2 + kstep;
            PG8_LDB(B0, 0, 0); PG8_LDB(B1, 0, 1); PG8_SCHED; PG8_LDA(At, 0, 0); PG8_STAGE_A(PG8_SA(1, 1), a1, 1, false);
            PG8_WAIT_V(8); PG8_WAIT_L(0); PG8_BAR; PG8_MMA(0, 0, At, B0); PG8_MMA(0, 1, At, B1); PG8_BAR; PG8_SCHED;
            PG8_LDA(At, 0, 1); PG8_STAGE_B(PG8_SB(0, 0), b2); PG8_STAGE_B(PG8_SB(0, 1), b2 + hstepB); PG8_STAGE_A(PG8_SA(0, 0), a2, 0, last);
            PG8_WAIT_V(8); PG8_WAIT_L(0); PG8_BAR; PG8_MMA(1, 0, At, B0); PG8_MMA(1, 1, At, B1); PG8_BAR; PG8_SCHED;
            PG8_LDB(B0, 1, 0); PG8_LDB(B1, 1, 1); PG8_SCHED; PG8_LDA(At, 1, 0); PG8_STAGE_A(PG8_SA(0, 1), a2, 1, last);
            PG8_WAIT_V(8); PG8_WAIT_L(0); PG8_BAR; PG8_MMA(0, 0, At, B0); PG8_MMA(0, 1, At, B1); PG8_BAR; PG8_SCHED;
            PG8_LDA(At, 1, 1); PG8_STAGE_B(PG8_SB(1, 0), b3); PG8_STAGE_B(PG8_SB(1, 1), b3 + hstepB); PG8_STAGE_A(PG8_SA(1, 0), a3, 0, last);
            PG8_WAIT_V(8); PG8_WAIT_L(0); PG8_BAR; PG8_MMA(1, 0, At, B0); PG8_MMA(1, 1, At, B1); PG8_BAR; PG8_SCHED;
        }
        if (wr == 0) PG8_BAR;
        E(acc, cur, wr, wc, fr, fq);
        if (!has_next) break;
#pragma unroll
        for (int a = 0; a < 2; ++a)
#pragma unroll
            for (int b = 0; b < 2; ++b)
#pragma unroll
                for (int m = 0; m < 4; ++m)
#pragma unroll
                    for (int n = 0; n < 2; ++n) acc[a][b][m][n] = (f32x4){0.f, 0.f, 0.f, 0.f};
        cur = nxt; cA = nA; cB = nB; ++ui;
        if constexpr (GATHER) {
#pragma unroll
            for (int h = 0; h < 2; ++h)
#pragma unroll
                for (int i = 0; i < 2; ++i) vc[h][i] = vn[h][i];
        }
        if (wr == 1) PG8_BAR;
    }
    PG8_WAIT_V(0);
    PG8_BAR;
#undef PG8_SA
#undef PG8_SB
#undef PG8_AOFF
#undef PG8_STAGE_A
#undef PG8_STAGE_B
#undef PG8_LDA
#undef PG8_LDB
#undef PG8_MMA
#undef PG8_WAIT_V
#undef PG8_WAIT_L
#undef PG8_BAR
#undef PG8_SCHED
}

struct Tile2D {
    const char* A; const char* B; int nM, nN, nwg, G, c; size_t tA, tB;
    DI void init(const void* A_, const void* B_, int M, int N, int lda, int ldb, int G_, int c_) { A = (const char*)A_; B = (const char*)B_; nM = M / 256; nN = N / 256; nwg = nM * nN; G = G_; c = c_; tA = (size_t)256 * lda * 2; tB = (size_t)256 * ldb * 2; }
    DI bool next(int i, Unit& u) const {
        const long L = (long)i * G + c; if (L >= nwg) return false;
        int wgid = (int)L; { const int q = nwg / 8, r = nwg % 8, xcd = wgid % 8, off = wgid / 8; wgid = (xcd < r ? xcd * (q + 1) : r * (q + 1) + (xcd - r) * q) + off; }
        const int nig = 8 * nN, gid = wgid / nig, fm = gid * 8, gsz = (nM - fm) < 8 ? (nM - fm) : 8;
        const int pm = fm + ((wgid % nig) % gsz), pn = (wgid % nig) / gsz;
        u.A = A + (size_t)pm * tA; u.B = B + (size_t)pn * tB; u.row0 = pm * 256; u.col0 = pn * 256; u.aux = 0; return true;
    }
    DI int grow(const Unit&, int) const { return 0; }
};
struct GluOrder { Tile2D t; DI bool next(int i, Unit& u) const { if (!t.next(i, u)) return false; u.col0 >>= 1; return true; } DI int grow(const Unit&, int) const { return 0; } };
struct MoeGU {
    const char* XN; const char* W; const LAS int* tile_e; const LAS int* gtab; int nunits, G, c;
    DI bool next(int i, Unit& u) const {
        const int L = i * G + c; if (L >= nunits || i >= 4) return false;
        const int gm = L >> 2, j = L & 3, e = tile_e[gm];
        u.A = XN; u.B = W + ((size_t)e * 1024 + (size_t)j * 256) * 2048 * 2; u.row0 = gm * 256; u.col0 = j * 128; u.aux = i; return true;
    }
    DI int grow(const Unit& u, int r) const { return gtab[u.aux * 256 + r]; }
};
struct MoeDown {
    const char* HID; const char* W; const LAS int* tile_e; int nunits, G, c;
    DI bool next(int i, Unit& u) const {
        const int L = i * G + c; if (L >= nunits) return false;
        const int gm = L >> 3, pn = L & 7, e = tile_e[gm];
        u.A = HID + (size_t)gm * 256 * 512 * 2; u.B = W + ((size_t)e * 2048 + (size_t)pn * 256) * 512 * 2; u.row0 = gm * 256; u.col0 = pn * 256; u.aux = e; return true;
    }
    DI int grow(const Unit&, int) const { return 0; }
};

struct EpiBf16 {
    static constexpr bool PERM = true;
    bf16_t* O; int ldc;
    DI void operator()(const Acc& acc, const Unit& u, int wr, int wc, int fr, int fq) const {
#pragma unroll
        for (int ai = 0; ai < 2; ++ai)
#pragma unroll
            for (int m = 0; m < 4; ++m) { bf16_t* rowp = O + (size_t)(u.row0 + ai * HALF + wr * 64 + m * 16 + fr) * ldc + u.col0 + wc * 32 + 8 * fq;
#pragma unroll
                for (int bj = 0; bj < 2; ++bj) { const f32x4 v0 = acc[ai][bj][m][0], v1 = acc[ai][bj][m][1];
                    u32x4 w; w.x = pk2(v0[0], v0[1]); w.y = pk2(v0[2], v0[3]); w.z = pk2(v1[0], v1[1]); w.w = pk2(v1[2], v1[3]);
                    *(u32x4*)(rowp + bj * HALF) = w; } }
    }
};
struct EpiBf16S {
    static constexpr bool PERM = true;
    bf16_t* O; int ldc; const float* rs;
    DI void operator()(const Acc& acc, const Unit& u, int wr, int wc, int fr, int fq) const {
#pragma unroll
        for (int ai = 0; ai < 2; ++ai)
#pragma unroll
            for (int m = 0; m < 4; ++m) { const int row = u.row0 + ai * HALF + wr * 64 + m * 16 + fr; const float r = rs[row]; bf16_t* rowp = O + (size_t)row * ldc + u.col0 + wc * 32 + 8 * fq;
#pragma unroll
                for (int bj = 0; bj < 2; ++bj) { const f32x4 v0 = acc[ai][bj][m][0] * r, v1 = acc[ai][bj][m][1] * r;
                    u32x4 w; w.x = pk2(v0[0], v0[1]); w.y = pk2(v0[2], v0[3]); w.z = pk2(v1[0], v1[1]); w.w = pk2(v1[2], v1[3]);
                    *(u32x4*)(rowp + bj * HALF) = w; } }
    }
};
template <bool RES_BF16> struct EpiResBf16 {
    static constexpr bool PERM = true;
    const void* res; bf16_t* out; int ldc;
    DI void operator()(const Acc& acc, const Unit& u, int wr, int wc, int fr, int fq) const {
#pragma unroll
        for (int ai = 0; ai < 2; ++ai)
#pragma unroll
            for (int m = 0; m < 4; ++m) { const size_t off = (size_t)(u.row0 + ai * HALF + wr * 64 + m * 16 + fr) * ldc + u.col0 + wc * 32 + 8 * fq;
#pragma unroll
                for (int bj = 0; bj < 2; ++bj) { float r[8];
                    if constexpr (RES_BF16) unpack8(*(const u32x4*)((const bf16_t*)res + off + bj * HALF), r);
                    else { const f32x4 r0 = *(const f32x4*)((const float*)res + off + bj * HALF), r1 = *(const f32x4*)((const float*)res + off + bj * HALF + 4); r[0] = r0[0]; r[1] = r0[1]; r[2] = r0[2]; r[3] = r0[3]; r[4] = r1[0]; r[5] = r1[1]; r[6] = r1[2]; r[7] = r1[3]; }
                    const f32x4 v0 = acc[ai][bj][m][0], v1 = acc[ai][bj][m][1];
                    u32x4 w; w.x = pk2(r[0] + v0[0], r[1] + v0[1]); w.y = pk2(r[2] + v0[2], r[3] + v0[3]); w.z = pk2(r[4] + v1[0], r[5] + v1[1]); w.w = pk2(r[6] + v1[2], r[7] + v1[3]);
                    *(u32x4*)(out + off + bj * HALF) = w; } }
    }
};
struct EpiGateUp {
    static constexpr bool PERM = true;
    bf16_t* O; int ldc; const LAS int* gtab; const float* rstd;
    DI void operator()(const Acc& acc, const Unit& u, int wr, int wc, int fr, int fq) const {
#pragma unroll
        for (int ai = 0; ai < 2; ++ai)
#pragma unroll
            for (int m = 0; m < 4; ++m) { const int r = ai * HALF + wr * 64 + m * 16 + fr; bf16_t* rowp = O + (size_t)(u.row0 + r) * ldc + u.col0 + wc * 32 + 8 * fq;
                const float rs = rstd[gtab[u.aux * 256 + r]];
                float o[8];
#pragma unroll
                for (int n = 0; n < 2; ++n)
#pragma unroll
                    for (int j = 0; j < 4; ++j) o[n * 4 + j] = silu_(acc[ai][0][m][n][j] * rs) * (acc[ai][1][m][n][j] * rs);
                *(u32x4*)rowp = pack8(o); }
    }
};
struct EpiGlu {
    static constexpr bool PERM = true;
    bf16_t* O; int ldc; const float* bias;
    DI void operator()(const Acc& acc, const Unit& u, int wr, int wc, int fr, int fq) const {
        const int cb = u.col0 + wc * 32 + 8 * fq;
        float bv[8], bg[8];
#pragma unroll
        for (int j = 0; j < 8; ++j) { bv[j] = bias[cb + j]; bg[j] = bias[512 + cb + j]; }
#pragma unroll
        for (int ai = 0; ai < 2; ++ai)
#pragma unroll
            for (int m = 0; m < 4; ++m) { bf16_t* rowp = O + (size_t)(u.row0 + ai * HALF + wr * 64 + m * 16 + fr) * ldc + cb;
                float o[8];
#pragma unroll
                for (int n = 0; n < 2; ++n)
#pragma unroll
                    for (int j = 0; j < 4; ++j) o[n * 4 + j] = (acc[ai][0][m][n][j] + bv[n * 4 + j]) * sigmoid_(acc[ai][1][m][n][j] + bg[n * 4 + j]);
                *(u32x4*)rowp = pack8(o); }
    }
};
}

#define XB_TMO      128
#define XB_XCNT(j)  (256  + 64 * (j))
#define XB_XSUB(j)  (1280 + 64 * (j))
#define XB_XGEN(j)  (2304 + 64 * (j))
#define XB_TOP      3328
#define XB_TOPGEN   3392
#define XCD_BAR_WORDS 3456
#define XB_SPIN_CAP (1u << 18)
__device__ __forceinline__ unsigned xb_ld(unsigned* p)              { return __hip_atomic_load(p, __ATOMIC_RELAXED, __HIP_MEMORY_SCOPE_AGENT); }
__device__ __forceinline__ unsigned xb_add(unsigned* p, unsigned v) { return __hip_atomic_fetch_add(p, v, __ATOMIC_RELAXED, __HIP_MEMORY_SCOPE_AGENT); }
__device__ __forceinline__ unsigned xb_xcc_id() { return (unsigned)__builtin_amdgcn_s_getreg((3 << 11) | 20) & 0xFu; }
#define XB_SPIN(cond, bar) do { unsigned _sp = 0; while (cond) { __builtin_amdgcn_s_sleep(1); \
    if ((++_sp & 255u) == 0u) { if (xb_ld(&(bar)[XB_TMO])) break; if (_sp > XB_SPIN_CAP) { atomicAdd(&(bar)[XB_TMO], 1u); break; } } } } while (0)
struct XcdBarrier { unsigned* bar; unsigned x; volatile LAS unsigned* st; };
__device__ __forceinline__ XcdBarrier xcd_barrier_post(unsigned* bar, volatile LAS unsigned* st) {
    XcdBarrier b; b.bar = bar; b.x = xb_xcc_id(); b.st = st;
    if (threadIdx.x == 0) (void)xb_add(&bar[XB_XCNT(b.x)], 1u);
    return b;
}
__device__ __forceinline__ void xcd_barrier_complete(unsigned* bar, unsigned x, unsigned& nloc, unsigned& nx) {
    const unsigned G = gridDim.x * gridDim.y * gridDim.z;
    unsigned sum, cnt, mine, sp = 0u;
    for (;;) {
        sum = 0u; cnt = 0u; mine = 0u;
#pragma unroll
        for (unsigned j = 0; j < 16; ++j) { const unsigned c = xb_ld(&bar[XB_XCNT(j)]); sum += c; cnt += (c > 0u) ? 1u : 0u; mine = (j == x) ? c : mine; }
        if (sum == G) break;
        __builtin_amdgcn_s_sleep(1);
        if ((++sp & 255u) == 0u) { if (xb_ld(&bar[XB_TMO])) break; if (sp > XB_SPIN_CAP) { atomicAdd(&bar[XB_TMO], 1u); break; } }
    }
    nloc = mine > 0u ? mine : 1u; nx = cnt > 0u ? cnt : 1u;
}
__device__ __forceinline__ void xcd_barrier(const XcdBarrier& b) {
    asm volatile("s_waitcnt vmcnt(0)" ::: "memory");
    __syncthreads();
    if (threadIdx.x == 0) {
        unsigned* bar = b.bar;
        __builtin_amdgcn_s_waitcnt(0);
        unsigned nloc = b.st[0], nx = b.st[1];
        if (nloc == 0u) { xcd_barrier_complete(bar, b.x, nloc, nx); b.st[0] = nloc; b.st[1] = nx; }
        const unsigned old = xb_add(&bar[XB_XSUB(b.x)], 1u);
        const unsigned gen = old / nloc;
        if (old + 1u == (gen + 1u) * nloc) {
            __builtin_amdgcn_fence(__ATOMIC_RELEASE, "agent");
            asm volatile("s_waitcnt vmcnt(0)" ::: "memory");
            const unsigned og = xb_add(&bar[XB_TOP], 1u);
            const unsigned tg = og / nx;
            if (og + 1u == (tg + 1u) * nx) xb_add(&bar[XB_TOPGEN], 1u);
            else XB_SPIN(xb_ld(&bar[XB_TOPGEN]) == tg, bar);
            __builtin_amdgcn_fence(__ATOMIC_ACQUIRE, "agent");
            xb_add(&bar[XB_XGEN(b.x)], 1u);
            asm volatile("s_waitcnt vmcnt(0)" ::: "memory");
        } else {
            XB_SPIN(xb_ld(&bar[XB_XGEN(b.x)]) == gen, bar);
            __builtin_amdgcn_fence(__ATOMIC_ACQUIRE, "agent");
            asm volatile("s_waitcnt vmcnt(0)" ::: "memory");
        }
    }
    __syncthreads();
}

struct Args { const float* in[38]; float* out; unsigned char* ws; int ph_lo, ph_hi; };
enum { I_X = 0, I_EVEN_NORM, I_EVEN_WIN, I_RET_NORM, I_SSD_CONVW, I_SSD_CONVB, I_SSD_DTB, I_SSD_ALOG, I_SSD_D, I_SSD_NORM, I_EVEN_WOUT, I_ODD_NORM, I_ODD_WIN, I_ML_CONVW, I_ML_CONVB,
       I_ML_IB, I_ML_FB, I_ML_NORM, I_S5_ARE, I_S5_AIM, I_S5_LOGDT, I_S5_BRE, I_S5_BIM, I_S5_CRE, I_S5_CIM, I_S5_D, I_S5_WGLU, I_S5_BGLU, I_ODD_WOUT, I_MOE_NORM, I_MOE_RG, I_MOE_RGB,
       I_MOE_RE, I_MOE_REB, I_MOE_WG, I_MOE_WU, I_MOE_WD, I_FINAL_NORM };

struct Frame { ldsp lds; int tid, lane, wave, G, bx; unsigned char* ws; };

DI int permb_row(int nt, int i) { return 64 * (nt >> 2) + 16 * (i >> 2) + 4 * (nt & 3) + (i & 3); }
DI int permb_off(int nt) { return (nt >> 2) * 128 + (nt & 3) * 8; }
DI int tr_lane_off_p(int lane, int pitch) { return (8 * (lane >> 4) + ((lane & 15) >> 2)) * pitch + (lane & 3) * 32; }
template <int NT, int KS, bool PERMB = false>
DI void mma16(f32x4 (&acc)[NT], ldsp Arows, int pitchA, ldsp Bt, int pitchB, int fr, int fq, int nt_lim = NT, int ks_lim = KS) {
    constexpr int NB = NT < 8 ? NT : 8;
#pragma unroll
    for (int ks = 0; ks < KS; ++ks) {
        if (ks < ks_lim) {
            const bf16x8 a = *(const LAS bf16x8*)(Arows + fr * pitchA + (ks * 32 + fq * 8) * 2);
#pragma unroll
            for (int n0 = 0; n0 < NT; n0 += NB) {
                if (n0 < nt_lim) {
                    bf16x8 b[NB];
#pragma unroll
                    for (int i = 0; i < NB; ++i) b[i] = *(const LAS bf16x8*)(Bt + (PERMB ? permb_row(n0 + i, fr) : ((n0 + i) * 16 + fr)) * pitchB + (ks * 32 + fq * 8) * 2);
#pragma unroll
                    for (int i = 0; i < NB; ++i) acc[n0 + i] = __builtin_amdgcn_mfma_f32_16x16x32_bf16(b[i], a, acc[n0 + i], 0, 0, 0);
                }
            }
        }
    }
}
typedef short s16x4 __attribute__((ext_vector_type(4)));
DI int tr_lane_off(int lane, int pitch) { return (8 * (lane >> 4) + ((lane & 15) >> 2)) * pitch + (lane & 3) * 8; }
DI bf16x8 tr_frag(ldsp trb, int off, int pitch) {
    const s16x4 v0 = __builtin_amdgcn_ds_read_tr16_b64_v4i16((LAS s16x4*)(trb + off)), v1 = __builtin_amdgcn_ds_read_tr16_b64_v4i16((LAS s16x4*)(trb + off + 4 * pitch));
    return __builtin_shufflevector(v0, v1, 0, 1, 2, 3, 4, 5, 6, 7);
}
template <int NT> DI void zero_acc(f32x4 (&acc)[NT]) {
#pragma unroll
    for (int i = 0; i < NT; ++i) acc[i] = (f32x4){0.f, 0.f, 0.f, 0.f}; }

DI void conv8(const bf16_t* P, int pos, const float* cw, int C, const float* cb, float (&y)[8]) {
    const f32x4 b0 = *(const f32x4*)cb, b1 = *(const f32x4*)(cb + 4);
    y[0] = b0[0]; y[1] = b0[1]; y[2] = b0[2]; y[3] = b0[3]; y[4] = b1[0]; y[5] = b1[1]; y[6] = b1[2]; y[7] = b1[3];
#pragma unroll
    for (int tap = 0; tap < 4; ++tap) {
        if (pos - 3 + tap >= 0) {
            const u32x4 xv = *(const u32x4*)(P + (ptrdiff_t)(tap - 3) * PLD); float x[8]; unpack8(xv, x);
            const f32x4 w0 = *(const f32x4*)(cw + tap * C), w1 = *(const f32x4*)(cw + tap * C + 4);
            y[0] += w0[0] * x[0]; y[1] += w0[1] * x[1]; y[2] += w0[2] * x[2]; y[3] += w0[3] * x[3];
            y[4] += w1[0] * x[4]; y[5] += w1[1] * x[5]; y[6] += w1[2] * x[6]; y[7] += w1[3] * x[7];
        }
    }
}

#ifndef TS_BLOCK
#define TS_BLOCK 100
#endif
#ifndef TS_SEL
#define TS_SEL 0
#endif
#ifndef TS_SCALE
#define TS_SCALE 10.f
#endif
constexpr size_t WS_TS = WS_SMALL + 200704;
#if DBG == 40
#define TSTAMP(k) do { if (blockIdx.x == TS_BLOCK && threadIdx.x == 0) ((unsigned long long*)(F.ws + WS_TS))[k] = __builtin_amdgcn_s_memrealtime(); } while (0)
#else
#define TSTAMP(k) do {} while (0)
#endif
struct TrItem { const float* W; int N; bf16_t* WT; int ldt, k0, n0, drow0; const float* gain; };
DI void tr_load(const TrItem& t, int lane, float (&r)[32]) {
    const int n = t.n0 + (lane & 31);
#pragma unroll
    for (int i = 0; i < 32; ++i) { const int kk = 2 * i + (lane >> 5); r[i] = (n < t.N) ? __builtin_nontemporal_load(t.W + (size_t)(t.k0 + kk) * t.N + n) : 0.f; }
}
DI void tr_finish(const TrItem& t, LAS float* scr, int lane, const float (&r)[32]) {
#pragma unroll
    for (int i = 0; i < 32; ++i) { const int kk = 2 * i + (lane >> 5); scr[kk * 33 + (lane & 31)] = r[i]; }
    LDS_WAIT();
    const int c = lane & 7;
    f32x4 g0 = (f32x4){1.f, 1.f, 1.f, 1.f}, g1 = g0; if (t.gain) { g0 = *(const f32x4*)(t.gain + t.k0 + 8 * c); g1 = *(const f32x4*)(t.gain + t.k0 + 8 * c + 4); }
#pragma unroll
    for (int j = 0; j < 4; ++j) { const int nn = (lane >> 3) + 8 * j; const LAS float* s = scr + (8 * c) * 33 + nn;
        u32x4 o; o.x = pk2(s[0 * 33] * g0[0], s[1 * 33] * g0[1]); o.y = pk2(s[2 * 33] * g0[2], s[3 * 33] * g0[3]); o.z = pk2(s[4 * 33] * g1[0], s[5 * 33] * g1[1]); o.w = pk2(s[6 * 33] * g1[2], s[7 * 33] * g1[3]);
        *(u32x4*)(t.WT + (size_t)(t.drow0 + nn) * t.ldt + t.k0 + 8 * c) = o; }
    LDS_WAIT();
}
template <class MakeItem>
DI void tr_stream(int first, int end, int stride, LAS float* scr, int lane, const MakeItem& mk) {
    if (first >= end) return;
    float ra[32], rb[32]; TrItem ta = mk(first), tb = ta; tr_load(ta, lane, ra);
    for (int it = first; it < end; it += 2 * stride) {
        const bool hb = it + stride < end; if (hb) { tb = mk(it + stride); tr_load(tb, lane, rb); }
        tr_finish(ta, scr, lane, ra);
        if (!hb) break;
        const bool ha = it + 2 * stride < end; if (ha) { ta = mk(it + 2 * stride); tr_load(ta, lane, ra); }
        tr_finish(tb, scr, lane, rb);
        if (!ha) break;
    }
}
DI void moe_convert(const Frame& F, const Args& a, int layer, int m_lo, int m_hi, int wi, int nw) {
    LAS float* scr = (LAS float*)(F.lds + F.wave * 16384);
    const int gw = wi * 8 + F.wave, NGW = nw * 8;
    bf16_t* Wgu = (bf16_t*)(F.ws + WS_WGU); bf16_t* Wd = (bf16_t*)(F.ws + WS_WD);
    const float* wg = a.in[I_MOE_WG]; const float* wu = a.in[I_MOE_WU]; const float* wd = a.in[I_MOE_WD]; const float* gn = a.in[I_MOE_NORM] + layer * 2048;
    tr_stream(m_lo * 16384 + gw, m_hi * 16384, NGW, scr, F.lane, [&](int it) { TrItem t;
        const int mat = it >> 14, r = it & 16383, e = r >> 9, q = r & 511;
        if (mat < 2) { const int kb = q >> 4, nb = q & 15, n0 = nb * 32;
            t.W = (mat == 0 ? wg : wu) + (size_t)(layer * 32 + e) * 2048 * 512; t.N = 512; t.WT = Wgu + (size_t)e * 1024 * 2048; t.ldt = 2048; t.k0 = kb * 64; t.n0 = n0; t.drow0 = (n0 >> 7) * 256 + (mat ? 128 : 0) + (n0 & 127); t.gain = gn;
        } else { const int kb = q >> 6, nb = q & 63, n0 = nb * 32;
            t.W = wd + (size_t)(layer * 32 + e) * 512 * 2048; t.N = 2048; t.WT = Wd + (size_t)e * 2048 * 512; t.ldt = 512; t.k0 = kb * 64; t.n0 = n0; t.drow0 = n0; t.gain = nullptr; }
        return t; });
}
DI void norm_row_bf16(const float* xr, const float* g, bf16_t* o, int lane) {
    f32x4 v[8]; float ss = 0.f;
#pragma unroll
    for (int j = 0; j < 8; ++j) { v[j] = *(const f32x4*)(xr + (lane + 64 * j) * 4); ss += v[j][0] * v[j][0] + v[j][1] * v[j][1] + v[j][2] * v[j][2] + v[j][3] * v[j][3]; }
    const float rstd = rsqrtf(wsum(ss) * (1.f / D) + EPS);
#pragma unroll
    for (int j = 0; j < 8; ++j) { const f32x4 gg = *(const f32x4*)(g + (lane + 64 * j) * 4);
        u32x2 w; w.x = pk2(v[j][0] * rstd * gg[0], v[j][1] * rstd * gg[1]); w.y = pk2(v[j][2] * rstd * gg[2], v[j][3] * rstd * gg[3]);
        *(u32x2*)(o + (lane + 64 * j) * 4) = w; }
}
DI void phase_prologue(const Frame& F, const Args& a) {
    LAS float* scr = (LAS float*)(F.lds + F.wave * 16384);
    const int gw = F.bx * 8 + F.wave, NGW = F.G * 8;
    bf16_t* Win0 = (bf16_t*)(F.ws + WS_WIN0); bf16_t* Wout0 = (bf16_t*)(F.ws + WS_WOUT0); bf16_t* Win1 = (bf16_t*)(F.ws + WS_WIN1); bf16_t* Wout1 = (bf16_t*)(F.ws + WS_WOUT1); bf16_t* Wglu = (bf16_t*)(F.ws + WS_WGLU);
    constexpr int I_IN = 32 * 209, I_OUT = 32 * 64, I_GLU = 8 * 32;
    { const float* win0 = a.in[I_EVEN_WIN]; const float* win1 = a.in[I_ODD_WIN]; const float* wo0 = a.in[I_EVEN_WOUT]; const float* wo1 = a.in[I_ODD_WOUT]; const float* wgl = a.in[I_S5_WGLU];
      const float* g0 = a.in[I_EVEN_NORM]; const float* g1 = a.in[I_ODD_NORM];
      tr_stream(gw, 2 * I_IN + 2 * I_OUT + I_GLU, NGW, scr, F.lane, [&](int it) { TrItem t; int r = it; t.gain = nullptr;
        if (r < I_IN) { t.W = win0; t.N = N0; t.WT = Win0; t.ldt = 2048; t.k0 = (r / 209) * 64; t.n0 = (r % 209) * 32; t.drow0 = t.n0; t.gain = g0; return t; } r -= I_IN;
        if (r < I_IN) { t.W = win1; t.N = N1; t.WT = Win1; t.ldt = 2048; t.k0 = (r / 209) * 64; t.n0 = (r % 209) * 32; t.drow0 = t.n0; t.gain = g1; return t; } r -= I_IN;
        if (r < I_OUT) { t.W = wo0; t.N = 2048; t.WT = Wout0; t.ldt = 2048; t.k0 = (r >> 6) * 64; t.n0 = (r & 63) * 32; t.drow0 = t.n0; return t; } r -= I_OUT;
        if (r < I_OUT) { t.W = wo1; t.N = 2048; t.WT = Wout1; t.ldt = 2048; t.k0 = (r >> 6) * 64; t.n0 = (r & 63) * 32; t.drow0 = t.n0; return t; } r -= I_OUT;
        { const int kb = r >> 5, nb = r & 31, n0 = nb * 32, nn = n0 & 511; t.W = wgl; t.N = 1024; t.WT = Wglu; t.ldt = 512; t.k0 = kb * 64; t.n0 = n0; t.drow0 = (nn >> 7) * 256 + (n0 >= 512 ? 128 : 0) + (nn & 127); }
        return t; }); }
    moe_convert(F, a, 0, 0, 2, F.bx, F.G);
    const int gt = F.bx * 512 + F.tid, NT_ = F.G * 512;
    for (int r2_ = 0; r2_ < KNOB_B; ++r2_) {
    for (int i = gt; i < 2 * 224 * 256; i += NT_) { const int l = i / (224 * 256), r = i % (224 * 256); *(u32x4*)((l ? Win1 : Win0) + (size_t)6688 * 2048 + (size_t)r * 8) = (u32x4){0u, 0u, 0u, 0u}; }
    float* COS = (float*)(F.ws + WS_COS); float* SIN = (float*)(F.ws + WS_SIN);
    for (int i = gt; i < 4096 * 64; i += NT_) { const int pos = i >> 6, k = i & 63; const float inv = 1.0f / powf(10000.f, (float)(2 * k) / 128.f); const float ang = (float)pos * inv; COS[i] = cosf(ang); SIN[i] = sinf(ang); }
    bf16_t* RTH = (bf16_t*)(F.ws + WS_RT); bf16_t* RTL = (bf16_t*)(F.ws + WS_RT + 512 * 1024);
    for (int i = gt; i < 2 * 48 * 2048; i += NT_) { const int l = i / (48 * 2048), r = i % (48 * 2048), j = r >> 11, k = r & 2047; const float g = a.in[I_MOE_NORM][l * 2048 + k];
        float w = 0.f; if (j < 4) w = a.in[I_MOE_RG][(size_t)(l * 2048 + k) * 4 + j]; else if (j < 36) w = a.in[I_MOE_RE][(size_t)(l * 2048 + k) * 32 + (j - 4)];
        const float v = g * w; const bf16_t hi = f2bf(v); RTH[i] = hi; RTL[i] = f2bf(v - bf2f(hi)); }
    { f32x2* A128 = (f32x2*)(F.ws + WS_S5T) + 2048; bf16_t* KERN = (bf16_t*)(F.ws + WS_S5K); f32x2* WT = (f32x2*)(F.ws + WS_S5W); bf16_t* CT = (bf16_t*)(F.ws + WS_S5C); bf16_t* GT = (bf16_t*)(F.ws + WS_S5G);
      const float* ARE = a.in[I_S5_ARE]; const float* AIM = a.in[I_S5_AIM]; const float* LDT = a.in[I_S5_LOGDT];
      for (int i = gt; i < 2048; i += NT_) { const int g = i >> 6; const double dt = exp((double)LDT[g]), are = ARE[i], aim = AIM[i]; const double m128 = exp(128.0 * are * dt);
          A128[i] = (f32x2){(float)(m128 * cos(128.0 * aim * dt)), (float)(m128 * sin(128.0 * aim * dt))}; }
      { LAS float* PWr = (LAS float*)F.lds; LAS float* PWi = PWr + 2048; LAS float* BBr = PWr + 4096; LAS float* BBi = PWr + 5120; LAS float* Cr = PWr + 6144; LAS float* Ci = PWr + 7168;
        for (int kt = F.bx; kt < 128; kt += F.G) { const int g = kt >> 2, tb = kt & 3; const float dt = __expf(LDT[g]);
            __syncthreads();
            for (int i = F.tid; i < 2048; i += 512) { const int n = i & 63, gn = g * 64 + n; const float tau = (float)(tb * 32 + (i >> 6)), pm = __expf(ARE[gn] * dt * tau); PWr[i] = pm * cosf(AIM[gn] * dt * tau); PWi[i] = pm * sinf(AIM[gn] * dt * tau); }
            for (int i = F.tid; i < 1024; i += 512) { const int n = i >> 4, q = i & 15, gn = g * 64 + n; const float are = ARE[gn], aim = AIM[gn];
                const float mg = __expf(are * dt), br = mg * cosf(aim * dt), bi = mg * sinf(aim * dt), den = are * are + aim * aim, nr = br - 1.f;
                const float cr = (nr * are + bi * aim) / den, ci = (bi * are - nr * aim) / den; const float bre = a.in[I_S5_BRE][(size_t)gn * 16 + q], bim = a.in[I_S5_BIM][(size_t)gn * 16 + q];
                BBr[i] = cr * bre - ci * bim; BBi[i] = cr * bim + ci * bre; }
            for (int i = F.tid; i < 1024; i += 512) { Cr[i] = a.in[I_S5_CRE][(size_t)g * 1024 + i]; Ci[i] = a.in[I_S5_CIM][(size_t)g * 1024 + i]; }
            __syncthreads();
            const int tl = F.tid >> 4, c = F.tid & 15;
            float acc[16];
#pragma unroll
            for (int q = 0; q < 16; ++q) acc[q] = 0.f;
            for (int n = 0; n < 64; ++n) { const float c_re = Cr[c * 64 + n], c_im = Ci[c * 64 + n], pr = PWr[tl * 64 + n], pi = PWi[tl * 64 + n];
                const float tr = c_re * pr - c_im * pi, ti = c_re * pi + c_im * pr;
#pragma unroll
                for (int q = 0; q < 16; ++q) acc[q] += tr * BBr[n * 16 + q] - ti * BBi[n * 16 + q]; }
            bf16_t* o = KERN + (size_t)(g * 16 + c) * 2048 + (tb * 32 + tl) * 16;
            *(u32x4*)o = (u32x4){pk2(acc[0], acc[1]), pk2(acc[2], acc[3]), pk2(acc[4], acc[5]), pk2(acc[6], acc[7])};
            *(u32x4*)(o + 8) = (u32x4){pk2(acc[8], acc[9]), pk2(acc[10], acc[11]), pk2(acc[12], acc[13]), pk2(acc[14], acc[15])}; }
        __syncthreads(); }
      bf16_t* PW = GT; bf16_t* BB = GT + (size_t)32 * 128 * 128;
      for (int i = gt; i < 32 * 64 * 128; i += NT_) { const int g = i >> 13, n = (i >> 7) & 63, j = i & 127, gn = g * 64 + n; const float dt = __expf(LDT[g]), are = ARE[gn], aim = AIM[gn];
          const float e = (float)(127 - j), pm = __expf(are * dt * e);
          *(unsigned*)(PW + (size_t)(g * 128 + j) * 128 + 2 * n) = pk2(pm * cosf(aim * dt * e), pm * sinf(aim * dt * e));
          const float e1 = (float)(j + 1), qm = __expf(are * dt * e1); WT[(size_t)(g * 128 + j) * 64 + n] = (f32x2){qm * cosf(aim * dt * e1), qm * sinf(aim * dt * e1)}; }
      for (int i = gt; i < 2048; i += NT_) { const int g = i >> 6; const float dt = __expf(LDT[g]), are = ARE[i], aim = AIM[i];
          const float mg = __expf(are * dt), br = mg * cosf(aim * dt), bi = mg * sinf(aim * dt), den = are * are + aim * aim, nr = br - 1.f;
          const float cr = (nr * are + bi * aim) / den, ci = (bi * are - nr * aim) / den;
          const float* bre = a.in[I_S5_BRE] + (size_t)i * 16; const float* bim = a.in[I_S5_BIM] + (size_t)i * 16;
          bf16_t* o0 = BB + (size_t)(g * 128 + 2 * (i & 63)) * 32; bf16_t* o1 = o0 + 32;
#pragma unroll
          for (int q = 0; q < 16; q += 2) { const float r0 = cr * bre[q] - ci * bim[q], i0_ = cr * bim[q] + ci * bre[q], r1 = cr * bre[q + 1] - ci * bim[q + 1], i1_ = cr * bim[q + 1] + ci * bre[q + 1];
              *(unsigned*)(o0 + q) = pk2(r0, r1); *(unsigned*)(o1 + q) = pk2(i0_, i1_); *(unsigned*)(o0 + 16 + q) = 0u; *(unsigned*)(o1 + 16 + q) = 0u; } }
      for (int i = gt; i < 32 * 16 * 64; i += NT_) { const int n = i & 63; *(unsigned*)(CT + (size_t)(i >> 6) * 128 + 2 * n) = pk2(a.in[I_S5_CRE][i], -a.in[I_S5_CIM][i]); } }
    }
    { bf16_t* H = (bf16_t*)(F.ws + WS_H); float* RS0 = (float*)(F.ws + WS_RSTD0);
      for (int m = gw; m < T; m += NGW) { const float* xr = a.in[I_X] + (size_t)m * D; bf16_t* o = H + (size_t)m * D; float ss = 0.f;
#pragma unroll
          for (int j = 0; j < 8; ++j) { const f32x4 v = *(const f32x4*)(xr + (F.lane + 64 * j) * 4); u32x2 w; w.x = pk2(v[0], v[1]); w.y = pk2(v[2], v[3]); *(u32x2*)(o + (F.lane + 64 * j) * 4) = w;
              const float r0 = bflo(w.x), r1 = bfhi(w.x), r2 = bflo(w.y), r3 = bfhi(w.y); ss += (r0 * r0 + r1 * r1) + (r2 * r2 + r3 * r3); }
          const float rstd = rsqrtf(wsum(ss) * (1.f / D) + EPS); if (F.lane == 0) RS0[m] = rstd; } }
}

DI float ret_loggamma(int h) { return log1pf(-exp2f(-5.f - (float)h)); }
DI void rot8(const bf16_t* p, const float* cs, const float* sn, float scale, float (&r1)[8], float (&r2)[8]) {
    float a[8], b[8]; unpack8(*(const u32x4*)p, a); unpack8(*(const u32x4*)(p + 64), b);
    const f32x4 c0 = *(const f32x4*)cs, c1 = *(const f32x4*)(cs + 4), s0 = *(const f32x4*)sn, s1 = *(const f32x4*)(sn + 4);
    const float c[8] = {c0[0], c0[1], c0[2], c0[3], c1[0], c1[1], c1[2], c1[3]}, s[8] = {s0[0], s0[1], s0[2], s0[3], s1[0], s1[1], s1[2], s1[3]};
#pragma unroll
    for (int j = 0; j < 8; ++j) { r1[j] = (a[j] * c[j] - b[j] * s[j]) * scale; r2[j] = (a[j] * s[j] + b[j] * c[j]) * scale; }
}
constexpr int PT = 272;

DI void phase_pre0(const Frame& F, const Args& a) {
    const bf16_t* PR = (const bf16_t*)(F.ws + WS_PROJ);
    float* DTV = (float*)(F.ws + WS_ROWS); float* ACUM = DTV + 262144;
    const int gw = F.bx * 8 + F.wave, NGW = F.G * 8;
    for (int task = gw; task < 2048; task += NGW) { const int hd = task & 15, c = (task >> 4) & 31, b = task >> 9; const size_t row0 = (size_t)(b * SEQ + c * 128);
        const bf16_t* P = PR + row0 * PLD + P0_DT + hd; const int s0 = 2 * F.lane, s1 = s0 + 1; const float db = a.in[I_SSD_DTB][hd], A = -__expf(a.in[I_SSD_ALOG][hd]);
        const float d0 = softplus_(bf2f(P[(size_t)s0 * PLD]) + db), d1 = softplus_(bf2f(P[(size_t)s1 * PLD]) + db);
        float c0, c1; wscan_sum(d0 * A, d1 * A, F.lane, c0, c1);
        DTV[(row0 + s0) * 16 + hd] = d0; DTV[(row0 + s1) * 16 + hd] = d1; ACUM[(row0 + s0) * 16 + hd] = c0; ACUM[(row0 + s1) * 16 + hd] = c1;
        if (F.lane == 63) ((float*)(F.ws + WS_SMALL))[(b * 32 + c) * 16 + hd] = c1; }
    const int gt = F.bx * 512 + F.tid, NT_ = F.G * 512;
    const float* cw = a.in[I_SSD_CONVW]; const float* cb = a.in[I_SSD_CONVB];
    bf16_t* XC = (bf16_t*)(F.ws + WS_XC);
    for (int task = F.bx * 384 + F.tid; F.tid < 384 && task < 512 * 192; task += F.G * 384) { const int ch = (task % 192) * 8, r0 = (task / 192) * 32;
        float w[4][8], bs[8];
#pragma unroll
        for (int tp = 0; tp < 4; ++tp) { const f32x4 w0 = *(const f32x4*)(cw + tp * 1536 + ch), w1 = *(const f32x4*)(cw + tp * 1536 + ch + 4); w[tp][0] = w0[0]; w[tp][1] = w0[1]; w[tp][2] = w0[2]; w[tp][3] = w0[3]; w[tp][4] = w1[0]; w[tp][5] = w1[1]; w[tp][6] = w1[2]; w[tp][7] = w1[3]; }
        { const f32x4 b0 = *(const f32x4*)(cb + ch), b1 = *(const f32x4*)(cb + ch + 4); bs[0] = b0[0]; bs[1] = b0[1]; bs[2] = b0[2]; bs[3] = b0[3]; bs[4] = b1[0]; bs[5] = b1[1]; bs[6] = b1[2]; bs[7] = b1[3]; }
        const bf16_t* src = PR + (size_t)r0 * PLD + P0_XBC + ch; bf16_t* dst = XC + (size_t)r0 * 1536 + ch;
        float x1[8], x2[8], x3[8];
        if ((r0 & (SEQ - 1)) != 0) { unpack8(*(const u32x4*)(src - PLD), x1); unpack8(*(const u32x4*)(src - 2 * PLD), x2); unpack8(*(const u32x4*)(src - 3 * PLD), x3); }
        else {
#pragma unroll
            for (int j = 0; j < 8; ++j) { x1[j] = 0.f; x2[j] = 0.f; x3[j] = 0.f; } }
#pragma unroll 8
        for (int i = 0; i < 32; ++i) { float x0[8], y[8]; unpack8(*(const u32x4*)(src + (size_t)i * PLD), x0);
#pragma unroll
            for (int j = 0; j < 8; ++j) { y[j] = silu_(bs[j] + w[0][j] * x3[j] + w[1][j] * x2[j] + w[2][j] * x1[j] + w[3][j] * x0[j]); x3[j] = x2[j]; x2[j] = x1[j]; x1[j] = x0[j]; }
            *(u32x4*)(dst + (size_t)i * 1536) = pack8(y); }
    }
}

DI void ret_local_unit(const Frame& F_, const Args& a, int u) {
    Frame F = F_; { int tz = F_.tid; asm volatile("" : "+v"(tz)); F.tid = tz; F.lane = tz & 63; }
    const int b = u >> 8, c = (u >> 3) & 31, h = u & 7, w = F.wave;
    const bf16_t* P = (const bf16_t*)(F.ws + WS_PROJ) + (size_t)(b * SEQ + c * 128) * PLD;
    const float* COS = (const float*)(F.ws + WS_COS); const float* SIN = (const float*)(F.ws + WS_SIN);
    ldsp KI = F.lds, VI = F.lds + 34816;
    const float lg = ret_loggamma(h);
#pragma unroll
    for (int i = 0; i < 4; ++i) { const int item = F.tid + 512 * i, s = item >> 4, e0 = (item & 15) * 8; *(LAS u32x4*)(VI + s * PT + e0 * 2) = *(const u32x4*)(P + (size_t)s * PLD + P0_V + h * 128 + e0); }
#pragma unroll
    for (int i = 0; i < 2; ++i) { const int item = F.tid + 512 * i, s = item >> 3, d0 = (item & 7) * 8, pos = c * 128 + s;
        float r1[8], r2[8]; rot8(P + (size_t)s * PLD + P0_K + h * 128 + d0, COS + pos * 64 + d0, SIN + pos * 64 + d0, 0.08838834764831845f * __expf(lg * (float)(127 - s)), r1, r2);
        *(LAS u32x4*)(KI + s * PT + d0 * 2) = pack8(r1); *(LAS u32x4*)(KI + s * PT + (d0 + 64) * 2) = pack8(r2); }
    __syncthreads();
    const int fr = F.lane & 15, fq = F.lane >> 4;
    ldsp ktr = KI + (8 * (F.lane >> 4) + ((F.lane & 15) >> 2)) * PT + (F.lane & 3) * 32, vtr = VI + tr_lane_off(F.lane, PT) + (16 * w) * 2;
    f32x4 acc[8]; zero_acc(acc);
#pragma unroll
    for (int ks = 0; ks < 4; ++ks) { const bf16x8 av = tr_frag(vtr, ks * 32 * PT, PT); bf16x8 bv[8];
#pragma unroll
        for (int nt = 0; nt < 8; ++nt) bv[nt] = tr_frag(ktr, ks * 32 * PT + (nt >> 2) * 128 + (nt & 3) * 8, PT);
#pragma unroll
        for (int nt = 0; nt < 8; ++nt) acc[nt] = __builtin_amdgcn_mfma_f32_16x16x32_bf16(bv[nt], av, acc[nt], 0, 0, 0); }
    bf16_t* dst = (bf16_t*)(F.ws + WS_RET_DS) + ((size_t)((b * 8 + h) * 32 + c) * 128 + 16 * w + fr) * 128 + fq * 16;
#pragma unroll
    for (int p = 0; p < 2; ++p) { u32x4 o0, o1; o0.x = pk2(acc[4 * p][0], acc[4 * p][1]); o0.y = pk2(acc[4 * p][2], acc[4 * p][3]); o0.z = pk2(acc[4 * p + 1][0], acc[4 * p + 1][1]); o0.w = pk2(acc[4 * p + 1][2], acc[4 * p + 1][3]);
        o1.x = pk2(acc[4 * p + 2][0], acc[4 * p + 2][1]); o1.y = pk2(acc[4 * p + 2][2], acc[4 * p + 2][3]); o1.z = pk2(acc[4 * p + 3][0], acc[4 * p + 3][1]); o1.w = pk2(acc[4 * p + 3][2], acc[4 * p + 3][3]);
        *(u32x4*)(dst + p * 64) = o0; *(u32x4*)(dst + p * 64 + 8) = o1; }
    __syncthreads();
}

DI void ssd_local_unit(const Frame& F_, const Args& a, int u) {
    Frame F = F_; { int tz = F_.tid; asm volatile("" : "+v"(tz)); F.tid = tz; F.lane = tz & 63; }
    const int b = u >> 7, c = (u >> 2) & 31, g = (u >> 1) & 1, hh = u & 1, hd0 = g * 8 + hh * 4, w = F.wave;
    const size_t row0 = (size_t)(b * SEQ + c * 128);
    const bf16_t* XC = (const bf16_t*)(F.ws + WS_XC) + row0 * 1536; const float* DTV = (const float*)(F.ws + WS_ROWS) + row0 * 16; const float* ACUM = DTV + 262144;
    constexpr int PX = 528;
    ldsp XI = F.lds, BI = F.lds + 67584; LAS float* sc = (LAS float*)(F.lds + 102400);
    u32x4 xr[8], br[4];
#pragma unroll
    for (int i = 0; i < 8; ++i) { const int item = F.tid + 512 * i, s = item >> 5, ch = (item & 31) * 8; xr[i] = *(const u32x4*)(XC + (size_t)s * 1536 + hd0 * 64 + ch); }
#pragma unroll
    for (int i = 0; i < 4; ++i) { const int item = F.tid + 512 * i, s = item >> 4, n0 = (item & 15) * 8; br[i] = *(const u32x4*)(XC + (size_t)s * 1536 + 1024 + g * 128 + n0); }
    { const int s = F.tid >> 2, r = F.tid & 3; sc[F.tid] = DTV[s * 16 + hd0 + r] * __expf(ACUM[127 * 16 + hd0 + r] - ACUM[s * 16 + hd0 + r]); }
#pragma unroll
    for (int i = 0; i < 4; ++i) { const int item = F.tid + 512 * i, s = item >> 4, n0 = (item & 15) * 8; *(LAS u32x4*)(BI + s * PT + n0 * 2) = br[i]; }
    __syncthreads();
#pragma unroll
    for (int i = 0; i < 8; ++i) { const int item = F.tid + 512 * i, s = item >> 5, ch = (item & 31) * 8; const float f = sc[s * 4 + (ch >> 6)]; float y[8]; unpack8(xr[i], y);
#pragma unroll
        for (int j = 0; j < 8; ++j) y[j] *= f;
        *(LAS u32x4*)(XI + s * PX + ch * 2) = pack8(y); }
    __syncthreads();
    const int fr = F.lane & 15, fq = F.lane >> 4;
    ldsp xtr = XI + tr_lane_off(F.lane, PX) + (32 * w) * 2, btr = BI + (8 * (F.lane >> 4) + ((F.lane & 15) >> 2)) * PT + (F.lane & 3) * 32;
    f32x4 acc[2][8]; zero_acc(acc[0]); zero_acc(acc[1]);
#pragma unroll
    for (int ks = 0; ks < 4; ++ks) { const bf16x8 a0 = tr_frag(xtr, ks * 32 * PX, PX), a1 = tr_frag(xtr, ks * 32 * PX + 32, PX); bf16x8 bv[8];
#pragma unroll
        for (int nt = 0; nt < 8; ++nt) bv[nt] = tr_frag(btr, ks * 32 * PT + (nt >> 2) * 128 + (nt & 3) * 8, PT);
#pragma unroll
        for (int nt = 0; nt < 8; ++nt) { acc[0][nt] = __builtin_amdgcn_mfma_f32_16x16x32_bf16(bv[nt], a0, acc[0][nt], 0, 0, 0); acc[1][nt] = __builtin_amdgcn_mfma_f32_16x16x32_bf16(bv[nt], a1, acc[1][nt], 0, 0, 0); } }
#pragma unroll
    for (int rt = 0; rt < 2; ++rt) { const int rr = 32 * w + 16 * rt + fr, r = rr >> 6, p = rr & 63;
        bf16_t* dst = (bf16_t*)(F.ws + WS_SSD_DS) + (((size_t)(b * 32 + c) * 16 + hd0 + r) * 64 + p) * 128 + fq * 16;
#pragma unroll
        for (int q = 0; q < 2; ++q) { u32x4 o0, o1; o0.x = pk2(acc[rt][4 * q][0], acc[rt][4 * q][1]); o0.y = pk2(acc[rt][4 * q][2], acc[rt][4 * q][3]); o0.z = pk2(acc[rt][4 * q + 1][0], acc[rt][4 * q + 1][1]); o0.w = pk2(acc[rt][4 * q + 1][2], acc[rt][4 * q + 1][3]);
            o1.x = pk2(acc[rt][4 * q + 2][0], acc[rt][4 * q + 2][1]); o1.y = pk2(acc[rt][4 * q + 2][2], acc[rt][4 * q + 2][3]); o1.z = pk2(acc[rt][4 * q + 3][0], acc[rt][4 * q + 3][1]); o1.w = pk2(acc[rt][4 * q + 3][2], acc[rt][4 * q + 3][3]);
            *(u32x4*)(dst + q * 64) = o0; *(u32x4*)(dst + q * 64 + 8) = o1; } }
    __syncthreads();
}

DI void phase_even_scan(const Frame& F, const Args& a) {
    const int gt = F.bx * 512 + F.tid, NT_ = F.G * 512;
    for (int i = gt; i < 131072; i += NT_) {
        const int bh = i >> 12, v = i & 4095; const float g128 = __expf(ret_loggamma(bh & 7) * 128.f);
        const bf16_t* src = (const bf16_t*)(F.ws + WS_RET_DS) + (size_t)bh * 32 * 16384 + v * 4; bf16_t* dst = (bf16_t*)(F.ws + WS_RET_S) + (size_t)bh * 32 * 16384 + v * 4;
        f32x4 run = (f32x4){0.f, 0.f, 0.f, 0.f};
#pragma unroll 16
        for (int c = 0; c < 32; ++c) { const u32x2 xv = *(const u32x2*)(src + (size_t)c * 16384); const f32x4 x = (f32x4){bflo(xv.x), bfhi(xv.x), bflo(xv.y), bfhi(xv.y)};
            u32x2 w; w.x = pk2(run[0], run[1]); w.y = pk2(run[2], run[3]); *(u32x2*)(dst + (size_t)c * 16384) = w; run = run * g128 + x; }
    }
    const float* AEND = (const float*)(F.ws + WS_SMALL);
    for (int i = gt; i < 131072; i += NT_) {
        const int bhd = i >> 11, v = i & 2047, b = bhd >> 4, hd = bhd & 15;
        const bf16_t* src = (const bf16_t*)(F.ws + WS_SSD_DS) + ((size_t)(b * 32) * 16 + hd) * 8192 + v * 4; bf16_t* dst = (bf16_t*)(F.ws + WS_SSD_S) + ((size_t)(b * 32) * 16 + hd) * 8192 + v * 4;
        f32x4 run = (f32x4){0.f, 0.f, 0.f, 0.f};
#pragma unroll 16
        for (int c = 0; c < 32; ++c) { const u32x2 xv = *(const u32x2*)(src + (size_t)c * 16 * 8192); const f32x4 x = (f32x4){bflo(xv.x), bfhi(xv.x), bflo(xv.y), bfhi(xv.y)}; const float dec = __expf(AEND[(b * 32 + c) * 16 + hd]);
            u32x2 w; w.x = pk2(run[0], run[1]); w.y = pk2(run[2], run[3]); *(u32x2*)(dst + (size_t)c * 16 * 8192) = w; run = run * dec + x; }
    }
}

DI void ret_out_unit(const Frame& F_, const Args& a, int u) {
    Frame F = F_; { int tz = F_.tid; asm volatile("" : "+v"(tz)); F.tid = tz; F.lane = tz & 63; }
    const int b = u >> 8, c = (u >> 3) & 31, h = u & 7, w = F.wave;
    const size_t row0 = (size_t)(b * SEQ + c * 128);
    const bf16_t* P = (const bf16_t*)(F.ws + WS_PROJ) + row0 * PLD;
    const float* COS = (const float*)(F.ws + WS_COS); const float* SIN = (const float*)(F.ws + WS_SIN);
    ldsp Q = F.lds, KX = F.lds + 34816, VT = F.lds + 69632, ST = F.lds + 104448;
    const float lg = ret_loggamma(h);
#pragma unroll
    for (int i = 0; i < 2; ++i) { const int item = F.tid + 512 * i, s = item >> 3, d0 = (item & 7) * 8, pos = c * 128 + s;
        float r1[8], r2[8];
        rot8(P + (size_t)s * PLD + h * 128 + d0, COS + pos * 64 + d0, SIN + pos * 64 + d0, 1.f, r1, r2);
        *(LAS u32x4*)(Q + s * PT + d0 * 2) = pack8(r1); *(LAS u32x4*)(Q + s * PT + (d0 + 64) * 2) = pack8(r2);
        rot8(P + (size_t)s * PLD + P0_K + h * 128 + d0, COS + pos * 64 + d0, SIN + pos * 64 + d0, 0.08838834764831845f, r1, r2);
        *(LAS u32x4*)(KX + s * PT + d0 * 2) = pack8(r1); *(LAS u32x4*)(KX + s * PT + (d0 + 64) * 2) = pack8(r2); }
    const bf16_t* Sg = (const bf16_t*)(F.ws + WS_RET_S) + (size_t)((b * 8 + h) * 32 + c) * 16384;
#pragma unroll
    for (int i = 0; i < 4; ++i) { const int item = F.tid + 512 * i, s = item >> 4, e0 = (item & 15) * 8;
        *(LAS u32x4*)(VT + s * PT + e0 * 2) = *(const u32x4*)(P + (size_t)s * PLD + P0_V + h * 128 + e0);
        *(LAS u32x4*)(ST + s * PT + e0 * 2) = *(const u32x4*)(Sg + (size_t)s * 128 + e0); }
    __syncthreads();
    const int fr = F.lane & 15, fq = F.lane >> 4, l = 16 * w + fr;
    u32x4 gpre[4];
    { const bf16_t* gp_ = P + (size_t)l * PLD + P0_G + h * 128 + 16 * fq; gpre[0] = *(const u32x4*)gp_; gpre[1] = *(const u32x4*)(gp_ + 8); gpre[2] = *(const u32x4*)(gp_ + 64); gpre[3] = *(const u32x4*)(gp_ + 72); }
    f32x4 as[8]; zero_acc(as);
    mma16<8, 4>(as, Q + (16 * w) * PT, PT, KX, PT, fr, fq, w + 1, 4);
    f32x4 ao[8]; zero_acc(ao);
    mma16<8, 4, true>(ao, Q + (16 * w) * PT, PT, ST, PT, fr, fq);
    { const float qd = __expf(lg * (float)(l + 1));
#pragma unroll
      for (int nt = 0; nt < 8; ++nt) ao[nt] = ao[nt] * qd; }
    __syncthreads();
    ldsp Pm = KX;
#pragma unroll
    for (int nt = 0; nt < 8; ++nt) if (nt <= (w | 1)) { float pv[4];
#pragma unroll
        for (int j = 0; j < 4; ++j) { const int s = nt * 16 + fq * 4 + j; pv[j] = (nt <= w && s <= l) ? as[nt][j] * __expf(lg * (float)(l - s)) : 0.f; }
        u32x2 pw; pw.x = pk2(pv[0], pv[1]); pw.y = pk2(pv[2], pv[3]); *(LAS u32x2*)(Pm + l * PT + (nt * 16 + fq * 4) * 2) = pw; }
    __syncthreads();
    { ldsp vtr = VT + tr_lane_off_p(F.lane, PT);
#pragma unroll
      for (int ks = 0; ks < 4; ++ks) if (ks <= (w >> 1)) { const bf16x8 av = *(const LAS bf16x8*)(Pm + l * PT + (ks * 32 + fq * 8) * 2); bf16x8 bv[8];
#pragma unroll
          for (int nt = 0; nt < 8; ++nt) bv[nt] = tr_frag(vtr, ks * 32 * PT + permb_off(nt), PT);
#pragma unroll
          for (int nt = 0; nt < 8; ++nt) ao[nt] = __builtin_amdgcn_mfma_f32_16x16x32_bf16(bv[nt], av, ao[nt], 0, 0, 0); } }
    float sm = 0.f;
#pragma unroll
    for (int nt = 0; nt < 8; ++nt) sm += ao[nt][0] + ao[nt][1] + ao[nt][2] + ao[nt][3];
    sm += __shfl_xor(sm, 16); sm += __shfl_xor(sm, 32);
    const float mean = sm * (1.f / 128.f); float vs = 0.f;
#pragma unroll
    for (int nt = 0; nt < 8; ++nt)
#pragma unroll
        for (int j = 0; j < 4; ++j) { const float d = ao[nt][j] - mean; vs += d * d; }
    vs += __shfl_xor(vs, 16); vs += __shfl_xor(vs, 32);
    const float rstd = rsqrtf(vs * (1.f / 128.f) + EPS);
    const float* ng = a.in[I_RET_NORM] + h * 128;
    bf16_t* orow = (bf16_t*)(F.ws + WS_MIX) + (row0 + l) * 2048 + h * 128;
#pragma unroll
    for (int p = 0; p < 2; ++p) { const int e = 64 * p + 16 * fq; float gg[16]; { float t0[8], t1[8]; unpack8(gpre[2 * p], t0); unpack8(gpre[2 * p + 1], t1);
#pragma unroll
            for (int q = 0; q < 8; ++q) { gg[q] = t0[q]; gg[8 + q] = t1[q]; } }
        float o[16];
#pragma unroll
        for (int t = 0; t < 4; ++t) { const f32x4 nn = *(const f32x4*)(ng + e + 4 * t);
#pragma unroll
            for (int j = 0; j < 4; ++j) o[4 * t + j] = (ao[4 * p + t][j] - mean) * rstd * nn[j] * silu_(gg[4 * t + j]); }
        u32x4 o0, o1; o0.x = pk2(o[0], o[1]); o0.y = pk2(o[2], o[3]); o0.z = pk2(o[4], o[5]); o0.w = pk2(o[6], o[7]); o1.x = pk2(o[8], o[9]); o1.y = pk2(o[10], o[11]); o1.z = pk2(o[12], o[13]); o1.w = pk2(o[14], o[15]);
        *(u32x4*)(orow + e) = o0; *(u32x4*)(orow + e + 8) = o1; }
    __syncthreads();
}

DI void ssd_out_unit(const Frame& F_, const Args& a, int u) {
    Frame F = F_; { int tz = F_.tid; asm volatile("" : "+v"(tz)); F.tid = tz; F.lane = tz & 63; }
    const int b = u >> 6, c = (u >> 1) & 31, g = u & 1, w = F.wave;
    const size_t row0 = (size_t)(b * SEQ + c * 128);
    const bf16_t* P = (const bf16_t*)(F.ws + WS_PROJ) + row0 * PLD; const bf16_t* XC = (const bf16_t*)(F.ws + WS_XC) + row0 * 1536;
    const float* DTV = (const float*)(F.ws + WS_ROWS) + row0 * 16 + g * 8; const float* ACUM = DTV + 262144;
    constexpr int PXS = 144;
    ldsp CM = F.lds, BM = F.lds + 34816, XS = F.lds + 34816, Pm = F.lds + 69632, SS = F.lds + 104448;
    LAS float* acum = (LAS float*)(F.lds + 121856); LAS float* dts = (LAS float*)(F.lds + 125952);
#pragma unroll
    for (int i = 0; i < 2; ++i) { const int idx = F.tid + 512 * i, s = idx >> 3, r = idx & 7; acum[idx] = ACUM[s * 16 + r]; dts[idx] = DTV[s * 16 + r]; }
#pragma unroll
    for (int i = 0; i < 4; ++i) { const int item = F.tid + 512 * i, s = item >> 4, n0 = (item & 15) * 8;
        *(LAS u32x4*)(CM + s * PT + n0 * 2) = *(const u32x4*)(XC + (size_t)s * 1536 + 1280 + g * 128 + n0); *(LAS u32x4*)(BM + s * PT + n0 * 2) = *(const u32x4*)(XC + (size_t)s * 1536 + 1024 + g * 128 + n0); }
    const bf16_t* Sg = (const bf16_t*)(F.ws + WS_SSD_S) + ((size_t)(b * 32 + c) * 16 + g * 8) * 8192;
    u32x4 xr[2], sr[2];
#define SSD_LOAD(r) do { _Pragma("unroll") for (int i = 0; i < 2; ++i) { const int item = F.tid + 512 * i; xr[i] = *(const u32x4*)(XC + (size_t)(item >> 3) * 1536 + (g * 8 + (r)) * 64 + (item & 7) * 8); \
        sr[i] = *(const u32x4*)(Sg + (size_t)(r) * 8192 + (item >> 4) * 128 + (item & 15) * 8); } } while (0)
    SSD_LOAD(0);
    __syncthreads();
    const int fr = F.lane & 15, fq = F.lane >> 4, l = 16 * w + fr;
    f32x4 cbm[8]; zero_acc(cbm);
    mma16<8, 4>(cbm, CM + (16 * w) * PT, PT, BM, PT, fr, fq);
    __syncthreads();
    float ssq = 0.f;
    const f32x4 dsk0 = *(const f32x4*)(a.in[I_SSD_D] + g * 8), dsk1 = *(const f32x4*)(a.in[I_SSD_D] + g * 8 + 4);
    bf16_t* orow = (bf16_t*)(F.ws + WS_MIX) + (row0 + l) * 2048 + 1024 + g * 512; const float* ng = a.in[I_SSD_NORM] + g * 512;
    ldsp xtr = XS + tr_lane_off_p(F.lane, PXS);
#pragma unroll 1
    for (int r = 0; r < 8; ++r) {
        const int hd = g * 8 + r;
#pragma unroll
        for (int i = 0; i < 2; ++i) { const int item = F.tid + 512 * i; *(LAS u32x4*)(XS + (item >> 3) * PXS + (item & 7) * 16) = xr[i]; *(LAS u32x4*)(SS + (item >> 4) * PT + (item & 15) * 16) = sr[i]; }
        __syncthreads();
        if (r < 7) SSD_LOAD(r + 1);
        const u32x4 zra = *(const u32x4*)(P + (size_t)l * PLD + P0_Z + hd * 64 + 16 * fq), zrb = *(const u32x4*)(P + (size_t)l * PLD + P0_Z + hd * 64 + 16 * fq + 8);
        f32x4 acc[4]; zero_acc(acc);
        mma16<4, 4, true>(acc, CM + (16 * w) * PT, PT, SS, PT, fr, fq);
        const float al = acum[l * 8 + r];
        { const float ea = __expf(al);
#pragma unroll
          for (int nt = 0; nt < 4; ++nt) acc[nt] = acc[nt] * ea; }
#pragma unroll
        for (int nt = 0; nt < 8; ++nt) if (nt <= (w | 1)) { float pv[4];
#pragma unroll
            for (int j = 0; j < 4; ++j) { const int s = nt * 16 + fq * 4 + j; pv[j] = (nt <= w && s <= l) ? cbm[nt][j] * __expf(al - acum[s * 8 + r]) * dts[s * 8 + r] : 0.f; }
            u32x2 pw; pw.x = pk2(pv[0], pv[1]); pw.y = pk2(pv[2], pv[3]); *(LAS u32x2*)(Pm + l * PT + (nt * 16 + fq * 4) * 2) = pw; }
        LDS_WAIT();
#pragma unroll
        for (int ks = 0; ks < 4; ++ks) if (ks <= (w >> 1)) { const bf16x8 av = *(const LAS bf16x8*)(Pm + l * PT + (ks * 32 + fq * 8) * 2); bf16x8 bv[4];
#pragma unroll
            for (int nt = 0; nt < 4; ++nt) bv[nt] = tr_frag(xtr, ks * 32 * PXS + permb_off(nt), PXS);
#pragma unroll
            for (int nt = 0; nt < 4; ++nt) acc[nt] = __builtin_amdgcn_mfma_f32_16x16x32_bf16(bv[nt], av, acc[nt], 0, 0, 0); }
        const float dsk = (r < 4) ? ((r & 2) ? ((r & 1) ? dsk0[3] : dsk0[2]) : ((r & 1) ? dsk0[1] : dsk0[0])) : ((r & 2) ? ((r & 1) ? dsk1[3] : dsk1[2]) : ((r & 1) ? dsk1[1] : dsk1[0]));
        { const int p = 16 * fq; float xs[16], zz[16], y[16];
            { float t0[8], t1[8]; unpack8(*(const LAS u32x4*)(XS + l * PXS + p * 2), t0); unpack8(*(const LAS u32x4*)(XS + l * PXS + p * 2 + 16), t1);
#pragma unroll
              for (int q = 0; q < 8; ++q) { xs[q] = t0[q]; xs[8 + q] = t1[q]; }
              unpack8(zra, t0); unpack8(zrb, t1);
#pragma unroll
              for (int q = 0; q < 8; ++q) { zz[q] = t0[q]; zz[8 + q] = t1[q]; } }
#pragma unroll
            for (int t = 0; t < 4; ++t)
#pragma unroll
                for (int j = 0; j < 4; ++j) { const float v = (acc[t][j] + dsk * xs[4 * t + j]) * silu_(zz[4 * t + j]); y[4 * t + j] = v; ssq += v * v; }
            u32x4 o0, o1; o0.x = pk2(y[0], y[1]); o0.y = pk2(y[2], y[3]); o0.z = pk2(y[4], y[5]); o0.w = pk2(y[6], y[7]); o1.x = pk2(y[8], y[9]); o1.y = pk2(y[10], y[11]); o1.z = pk2(y[12], y[13]); o1.w = pk2(y[14], y[15]);
            *(u32x4*)(orow + r * 64 + p) = o0; *(u32x4*)(orow + r * 64 + p + 8) = o1; }
        __syncthreads();
    }
#undef SSD_LOAD
    ssq += __shfl_xor(ssq, 16); ssq += __shfl_xor(ssq, 32);
    const float rstd = rsqrtf(ssq * (1.f / 512.f) + EPS);
    asm volatile("s_waitcnt vmcnt(0)" ::: "memory");
#pragma unroll 4
    for (int r = 0; r < 8; ++r)
#pragma unroll
        for (int hf = 0; hf < 2; ++hf) { const int p = r * 64 + 16 * fq + 8 * hf; float y[8]; unpack8(*(const u32x4*)(orow + p), y); const f32x4 n0 = *(const f32x4*)(ng + p), n1 = *(const f32x4*)(ng + p + 4);
            u32x4 o; o.x = pk2(y[0] * rstd * n0[0], y[1] * rstd * n0[1]); o.y = pk2(y[2] * rstd * n0[2], y[3] * rstd * n0[3]); o.z = pk2(y[4] * rstd * n1[0], y[5] * rstd * n1[1]); o.w = pk2(y[6] * rstd * n1[2], y[7] * rstd * n1[3]);
            *(u32x4*)(orow + p) = o; }
    __syncthreads();
}

constexpr size_t WS_RSTD = WS_SMALL + 131072;
DI void phase_router(const Frame& F, const Args& a, int layer) {
    const bf16_t* H = (const bf16_t*)(F.ws + WS_H); const bf16_t* RTH = (const bf16_t*)(F.ws + WS_RT) + (size_t)layer * 48 * 2048; const bf16_t* RTL = (const bf16_t*)(F.ws + WS_RT + 512 * 1024) + (size_t)layer * 48 * 2048;
    unsigned* cnt = (unsigned*)(F.ws + WS_CTL) + CW_CNT + layer * 32 * 64;
    int* LIST = (int*)(F.ws + WS_LIST); int* SLOT = (int*)(F.ws + WS_SLOT); float* RSTD = (float*)(F.ws + WS_RSTD);
    const int fr = F.lane & 15, fq = F.lane >> 4, t = F.wave & 3, kh = F.wave >> 2;
    constexpr int PR_ = 1040;
    ldsp TH = F.lds, TL = F.lds + 49920;
    LAS float* part = (LAS float*)(F.lds + 102400 + (size_t)t * 4096);
    for (int tg = F.bx; tg < 256; tg += F.G) {
        const int row0 = (tg * 4 + t) * 16;
        const bf16_t* ap = H + (size_t)(row0 + fr) * 2048 + kh * 256 + fq * 8;
        u32x4 ab[2][8];
#pragma unroll
        for (int i = 0; i < 8; ++i) ab[0][i] = *(const u32x4*)(ap + i * 32);
        f32x4 acc[3]; zero_acc(acc); float ss = 0.f;
#pragma unroll
        for (int kc = 0; kc < 4; ++kc) {
            __syncthreads();
#pragma unroll
            for (int hb = 0; hb < 2; ++hb) { u32x4 th[3], tl[3];
#pragma unroll
                for (int i = 0; i < 3; ++i) { const int item = F.tid + 512 * (3 * hb + i), col = item >> 6, c8 = (item & 63) * 8; th[i] = *(const u32x4*)(RTH + (size_t)col * 2048 + kc * 512 + c8); tl[i] = *(const u32x4*)(RTL + (size_t)col * 2048 + kc * 512 + c8); }
#pragma unroll
                for (int i = 0; i < 3; ++i) { const int item = F.tid + 512 * (3 * hb + i), col = item >> 6, c8 = (item & 63) * 8; *(LAS u32x4*)(TH + col * PR_ + c8 * 2) = th[i]; *(LAS u32x4*)(TL + col * PR_ + c8 * 2) = tl[i]; }
                asm volatile("" ::: "memory"); }
            __syncthreads();
            if (kc < 3) {
#pragma unroll
                for (int i = 0; i < 8; ++i) ab[(kc + 1) & 1][i] = *(const u32x4*)(ap + (kc + 1) * 512 + i * 32); }
#pragma unroll
            for (int ks = 0; ks < 8; ++ks) { const u32x4 av = ab[kc & 1][ks];
                float x[8]; unpack8(av, x);
                ss += (x[0] * x[0] + x[1] * x[1]) + (x[2] * x[2] + x[3] * x[3]) + (x[4] * x[4] + x[5] * x[5]) + (x[6] * x[6] + x[7] * x[7]);
                const bf16x8 ah = __builtin_bit_cast(bf16x8, av);
#pragma unroll
                for (int ct = 0; ct < 3; ++ct) { const int bo = (ct * 16 + fr) * PR_ + (kh * 256 + ks * 32 + fq * 8) * 2;
                    const bf16x8 bhv = *(const LAS bf16x8*)(TH + bo), blv = *(const LAS bf16x8*)(TL + bo);
                    acc[ct] = __builtin_amdgcn_mfma_f32_16x16x32_bf16(ah, bhv, acc[ct], 0, 0, 0);
                    acc[ct] = __builtin_amdgcn_mfma_f32_16x16x32_bf16(ah, blv, acc[ct], 0, 0, 0); }
                if (ks & 1) asm volatile("" : "+v"(ss) :: "memory"); }
        }
        ss += __shfl_xor(ss, 16); ss += __shfl_xor(ss, 32);
        if (kh == 1) {
#pragma unroll
            for (int ct = 0; ct < 3; ++ct)
#pragma unroll
                for (int j = 0; j < 4; ++j) part[(4 * fq + j) * 48 + ct * 16 + fr] = acc[ct][j];
            if (fq == 0) part[768 + fr] = ss;
        }
        __syncthreads();
        if (kh == 0) {
            ss += part[768 + fr];
            const float rstd = rsqrtf(ss * (1.f / D) + EPS);
#pragma unroll
            for (int ct = 0; ct < 3; ++ct)
#pragma unroll
                for (int j = 0; j < 4; ++j) part[(4 * fq + j) * 48 + ct * 16 + fr] += acc[ct][j];
            LDS_WAIT();
            if (fq == 0) part[768 + fr] = rstd;
            LDS_WAIT();
            if (F.lane < 16) {
                const int r = F.lane, tok = row0 + r; const float rr = part[768 + r];
                float gl[4]; float mx = -INFINITY; int gi = 0;
#pragma unroll
                for (int j = 0; j < 4; ++j) { gl[j] = part[r * 48 + j] * rr + a.in[I_MOE_RGB][layer * 4 + j]; if (gl[j] > mx) { mx = gl[j]; gi = j; } }
                float se = 0.f;
#pragma unroll
                for (int j = 0; j < 4; ++j) se += __expf(gl[j] - mx);
                const float gw = 1.f / se;
                float v1 = -INFINITY, v2 = -INFINITY; int i1 = 0, i2 = 0;
                for (int k = 0; k < 8; ++k) { const float v = part[r * 48 + 4 + gi * 8 + k] * rr + a.in[I_MOE_REB][layer * 32 + gi * 8 + k];
                    if (v > v1) { v2 = v1; i2 = i1; v1 = v; i1 = k; } else if (v > v2) { v2 = v; i2 = k; } }
                const float e2 = __expf(v2 - v1), w1 = gw / (1.f + e2), w2 = gw * e2 / (1.f + e2);
                const int e0 = gi * 8 + i1, e1 = gi * 8 + i2;
                const int r0 = (int)__hip_atomic_fetch_add(cnt + e0 * 64, 1u, __ATOMIC_RELAXED, __HIP_MEMORY_SCOPE_AGENT);
                const int r1 = (int)__hip_atomic_fetch_add(cnt + e1 * 64, 1u, __ATOMIC_RELAXED, __HIP_MEMORY_SCOPE_AGENT);
                LIST[e0 * T + r0] = tok; LIST[e1 * T + r1] = tok; RSTD[tok] = rr;
                int* sp = SLOT + (size_t)tok * 8; sp[0] = e0; sp[1] = r0; sp[2] = __float_as_int(w1); sp[3] = e1; sp[4] = r1; sp[5] = __float_as_int(w2);
            }
        }
        __syncthreads();
    }
}
DI int moe_tables(const Frame& F, int layer) {
    const unsigned* cnt = (const unsigned*)(F.ws + WS_CTL) + CW_CNT + layer * 32 * 64;
    LAS int* tile_e = (LAS int*)(F.lds + LDS_TAB); LAS int* tstart = tile_e + 192; LAS int* ecnt = tile_e + 224;
    if (F.tid < 32) ecnt[F.tid] = (int)__hip_atomic_load(cnt + F.tid * 64, __ATOMIC_RELAXED, __HIP_MEMORY_SCOPE_AGENT);
    __syncthreads();
    if (F.tid == 0) { int acc = 0;
        for (int e = 0; e < 32; ++e) { const int mt = (ecnt[e] + 255) >> 8; tstart[e] = acc;
            for (int k = 0; k < mt; ++k) tile_e[acc + k] = e; acc += mt; }
        tile_e[191] = acc; }
    __syncthreads();
    return tile_e[191];
}
DI void phase_moe_gateup(const Frame& F, const Args& a, int layer) {
    const int ntiles = moe_tables(F, layer);
    LAS int* tile_e = (LAS int*)(F.lds + LDS_TAB); LAS int* tstart = tile_e + 192; LAS int* ecnt = tile_e + 224; LAS int* gtab = (LAS int*)(F.lds + LDS_TAB + 1024);
    const int* LIST = (const int*)(F.ws + WS_LIST);
    for (int i = 0; i < 4; ++i) { const int L = i * F.G + F.bx; if (L >= ntiles * 4) break;
        const int gm = L >> 2, e = tile_e[gm], rbase = (gm - tstart[e]) * 256;
        if (F.tid < 256) { const int rank = rbase + F.tid; gtab[i * 256 + F.tid] = (rank < ecnt[e]) ? LIST[e * T + rank] : 0; } }
    __syncthreads();
    pg8::MoeGU S; S.XN = (const char*)(F.ws + WS_H); S.W = (const char*)(F.ws + WS_WGU); S.tile_e = tile_e; S.gtab = gtab; S.nunits = ntiles * 4; S.G = F.G; S.c = F.bx;
    pg8::EpiGateUp E{(bf16_t*)(F.ws + WS_HID), 512, gtab, (const float*)(F.ws + WS_RSTD)};
    pg8::gemm_phase<pg8::EpiGateUp, pg8::MoeGU, true>(F.lds, 2048, 2048, 2048, S, E);
    { const int rem = (ntiles * 4) % F.G; __syncthreads();
      if (rem == 0) moe_convert(F, a, layer, 2, 3, F.bx, F.G); else if (F.bx >= rem) moe_convert(F, a, layer, 2, 3, F.bx - rem, F.G - rem); }
}
DI void phase_moe_down(const Frame& F, const Args& a, int layer) {
    const int ntiles = moe_tables(F, layer);
    LAS int* tile_e = (LAS int*)(F.lds + LDS_TAB);
    pg8::MoeDown S; S.HID = (const char*)(F.ws + WS_HID); S.W = (const char*)(F.ws + WS_WD); S.tile_e = tile_e; S.nunits = ntiles * 8; S.G = F.G; S.c = F.bx;
    pg8::EpiBf16 E{(bf16_t*)(F.ws + WS_Y), 2048};
    pg8::gemm_phase<pg8::EpiBf16, pg8::MoeDown, false>(F.lds, 512, 512, 512, S, E);
}
template <bool LAST>
DI void phase_combine(const Frame& F, const Args& a, int layer) {
    (void)moe_tables(F, layer);
    LAS int* tstart = (LAS int*)(F.lds + LDS_TAB) + 192;
    const int* SLOT = (const int*)(F.ws + WS_SLOT); const bf16_t* Y = (const bf16_t*)(F.ws + WS_Y); bf16_t* H = (bf16_t*)(F.ws + WS_H); float* RS1 = (float*)(F.ws + WS_RSTD1);
    const float* gn = a.in[I_FINAL_NORM];
    const int gw = F.bx * 8 + F.wave, NGW = F.G * 8;
    u32x2 hn[8], p0n[8], p1n[8]; float w0n = 0.f, w1n = 0.f; int sa[6] = {0, 0, 0, 0, 0, 0};
#define CMB_SLOT(m) do { if ((m) < T) { const int* sp = SLOT + (size_t)(m) * 8; sa[0] = sp[0]; sa[1] = sp[1]; sa[2] = sp[2]; sa[3] = sp[3]; sa[4] = sp[4]; sa[5] = sp[5]; } } while (0)
#define CMB_LOAD(m) do { if ((m) < T) { const bf16_t* y0 = Y + (size_t)(tstart[sa[0]] * 256 + sa[1]) * 2048; const bf16_t* y1 = Y + (size_t)(tstart[sa[3]] * 256 + sa[4]) * 2048; const bf16_t* hr_ = H + (size_t)(m) * 2048; \
        w0n = __int_as_float(sa[2]); w1n = __int_as_float(sa[5]); \
        _Pragma("unroll") for (int j = 0; j < 8; ++j) { const int o = (F.lane + 64 * j) * 4; hn[j] = *(const u32x2*)(hr_ + o); p0n[j] = *(const u32x2*)(y0 + o); p1n[j] = *(const u32x2*)(y1 + o); } } } while (0)
    CMB_SLOT(gw); CMB_LOAD(gw); CMB_SLOT(gw + NGW);
    for (int m = gw; m < T; m += NGW) {
        u32x2 hv[8], p0[8], p1[8]; const float w0 = w0n, w1 = w1n;
#pragma unroll
        for (int j = 0; j < 8; ++j) { hv[j] = hn[j]; p0[j] = p0n[j]; p1[j] = p1n[j]; }
        CMB_LOAD(m + NGW); CMB_SLOT(m + 2 * NGW);
        bf16_t* hr = H + (size_t)m * 2048;
        f32x4 v[8]; float ss = 0.f;
#pragma unroll
        for (int j = 0; j < 8; ++j) { const int o = (F.lane + 64 * j) * 4;
            v[j][0] = bflo(hv[j].x) + w0 * bflo(p0[j].x) + w1 * bflo(p1[j].x); v[j][1] = bfhi(hv[j].x) + w0 * bfhi(p0[j].x) + w1 * bfhi(p1[j].x);
            v[j][2] = bflo(hv[j].y) + w0 * bflo(p0[j].y) + w1 * bflo(p1[j].y); v[j][3] = bfhi(hv[j].y) + w0 * bfhi(p0[j].y) + w1 * bfhi(p1[j].y);
            if (!LAST) { u32x2 wv; wv.x = pk2(v[j][0], v[j][1]); wv.y = pk2(v[j][2], v[j][3]); *(u32x2*)(hr + o) = wv; v[j] = (f32x4){bflo(wv.x), bfhi(wv.x), bflo(wv.y), bfhi(wv.y)}; }
            ss += v[j][0] * v[j][0] + v[j][1] * v[j][1] + v[j][2] * v[j][2] + v[j][3] * v[j][3]; }
        const float rstd = rsqrtf(wsum(ss) * (1.f / D) + EPS);
        if (LAST) {
            float* orow = a.out + (size_t)m * 2048;
#pragma unroll
            for (int j = 0; j < 8; ++j) { const int o = (F.lane + 64 * j) * 4; const f32x4 gg = *(const f32x4*)(gn + o);
                *(f32x4*)(orow + o) = (f32x4){v[j][0] * rstd * gg[0], v[j][1] * rstd * gg[1], v[j][2] * rstd * gg[2], v[j][3] * rstd * gg[3]}; }
        } else if (F.lane == 0) RS1[m] = rstd;
    }
#undef CMB_SLOT
#undef CMB_LOAD
}

DI void phase_pre1(const Frame& F, const Args& a) {
    const bf16_t* PR = (const bf16_t*)(F.ws + WS_PROJ);
    float* BCUM = (float*)(F.ws + WS_ROWS); float* GMB = BCUM + 65536; float* PMAX = BCUM + 131072; float* WV = BCUM + 196608;
    const int gw = F.bx * 8 + F.wave, NGW = F.G * 8;
    for (int task = gw; task < 512; task += NGW) { const int h = task & 3, c = (task >> 2) & 31, b = task >> 7, bh = b * 4 + h; const size_t row0 = (size_t)(b * SEQ + c * 128);
        const bf16_t* P = PR + row0 * PLD; const int s0 = 2 * F.lane, s1 = s0 + 1; const float fb = a.in[I_ML_FB][h], ib = a.in[I_ML_IB][h];
        const float lf0 = logsigmoid_(bf2f(P[(size_t)s0 * PLD + P1_F + h]) + fb), lf1 = logsigmoid_(bf2f(P[(size_t)s1 * PLD + P1_F + h]) + fb);
        const float ig0 = bf2f(P[(size_t)s0 * PLD + P1_I + h]) + ib, ig1 = bf2f(P[(size_t)s1 * PLD + P1_I + h]) + ib;
        float bc0, bc1; wscan_sum(lf0, lf1, F.lane, bc0, bc1);
        const float g0 = ig0 - bc0, g1 = ig1 - bc1; float pm0, pm1; wscan_max(g0, g1, F.lane, pm0, pm1);
        const float blast = __shfl(bc1, 63); const float wl0 = blast + g0, wl1 = blast + g1; const float mloc = wmax(fmaxf(wl0, wl1));
        BCUM[(row0 + s0) * 4 + h] = bc0; BCUM[(row0 + s1) * 4 + h] = bc1; GMB[(row0 + s0) * 4 + h] = g0; GMB[(row0 + s1) * 4 + h] = g1;
        PMAX[(row0 + s0) * 4 + h] = pm0; PMAX[(row0 + s1) * 4 + h] = pm1; WV[(row0 + s0) * 4 + h] = __expf(wl0 - mloc); WV[(row0 + s1) * 4 + h] = __expf(wl1 - mloc);
        if (F.lane == 0) { float* MS = (float*)(F.ws + WS_SMALL + 16384); MS[(bh * 32 + c) * 2] = blast; MS[(bh * 32 + c) * 2 + 1] = mloc; } }
    const int gt = F.bx * 512 + F.tid, NT_ = F.G * 512;
    const float* cw = a.in[I_ML_CONVW]; const float* cb = a.in[I_ML_CONVB];
    bf16_t* QC = (bf16_t*)(F.ws + WS_QC); bf16_t* KC = (bf16_t*)(F.ws + WS_KC);
    for (int task = F.bx * 384 + F.tid; F.tid < 384 && task < 256 * 384; task += F.G * 384) { const int ch = (task % 384) * 8, r0 = (task / 384) * 64;
        float w[4][8], bs[8];
#pragma unroll
        for (int tp = 0; tp < 4; ++tp) { const f32x4 w0 = *(const f32x4*)(cw + tp * 3072 + ch), w1 = *(const f32x4*)(cw + tp * 3072 + ch + 4); w[tp][0] = w0[0]; w[tp][1] = w0[1]; w[tp][2] = w0[2]; w[tp][3] = w0[3]; w[tp][4] = w1[0]; w[tp][5] = w1[1]; w[tp][6] = w1[2]; w[tp][7] = w1[3]; }
        { const f32x4 b0 = *(const f32x4*)(cb + ch), b1 = *(const f32x4*)(cb + ch + 4); bs[0] = b0[0]; bs[1] = b0[1]; bs[2] = b0[2]; bs[3] = b0[3]; bs[4] = b1[0]; bs[5] = b1[1]; bs[6] = b1[2]; bs[7] = b1[3]; }
        const bf16_t* src = PR + (size_t)r0 * PLD + ch; const float sc = ch < 1536 ? 0.05103103630798288f : 1.f;
        bf16_t* dst = (ch < 1536 ? QC + ch : KC + (ch - 1536)) + (size_t)r0 * 1536;
        float x1[8], x2[8], x3[8];
        if ((r0 & (SEQ - 1)) != 0) { unpack8(*(const u32x4*)(src - PLD), x1); unpack8(*(const u32x4*)(src - 2 * PLD), x2); unpack8(*(const u32x4*)(src - 3 * PLD), x3); }
        else {
#pragma unroll
            for (int j = 0; j < 8; ++j) { x1[j] = 0.f; x2[j] = 0.f; x3[j] = 0.f; } }
#pragma unroll 8
        for (int i = 0; i < 64; ++i) { float x0[8], y[8]; unpack8(*(const u32x4*)(src + (size_t)i * PLD), x0);
#pragma unroll
            for (int j = 0; j < 8; ++j) { y[j] = silu_(bs[j] + w[0][j] * x3[j] + w[1][j] * x2[j] + w[2][j] * x1[j] + w[3][j] * x0[j]) * sc; x3[j] = x2[j]; x2[j] = x1[j]; x1[j] = x0[j]; }
            *(u32x4*)(dst + (size_t)i * 1536) = pack8(y); }
    }
}

DI void mlstm_local_unit(const Frame& F_, const Args& a, int u) {
    Frame F = F_; { int tz = F_.tid; asm volatile("" : "+v"(tz)); F.tid = tz; F.lane = tz & 63; }
    const int h = u & 3, c = (u >> 2) & 31, b = u >> 7, bh = b * 4 + h, w = F.wave;
    const size_t row0 = (size_t)(b * SEQ + c * 128);
    const bf16_t* P = (const bf16_t*)(F.ws + WS_PROJ) + row0 * PLD;
    constexpr int PK = 784;
    ldsp KI = F.lds, VI = F.lds + 100352;
    const bf16_t* KC = (const bf16_t*)(F.ws + WS_KC) + row0 * 1536 + h * 384; const float* WV = (const float*)(F.ws + WS_ROWS) + 196608 + row0 * 4 + h;
    u32x4 kr[12];
#pragma unroll
    for (int i = 0; i < 12; ++i) { const int item = F.tid + 512 * i, s = item / 48, d0 = (item % 48) * 8; kr[i] = *(const u32x4*)(KC + (size_t)s * 1536 + d0); }
    u32x4 vr[4];
#pragma unroll
    for (int i = 0; i < 4; ++i) { const int item = F.tid + 512 * i, s = item >> 4, e0 = (item & 15) * 8; vr[i] = *(const u32x4*)(P + (size_t)s * PLD + P1_V + h * 384 + e0); }
#pragma unroll
    for (int i = 0; i < 12; ++i) { const int item = F.tid + 512 * i, s = item / 48, d0 = (item % 48) * 8; const float ws_ = WV[s * 4]; float y[8]; unpack8(kr[i], y);
#pragma unroll
        for (int j = 0; j < 8; ++j) y[j] *= ws_;
        *(LAS u32x4*)(KI + s * PK + d0 * 2) = pack8(y); }
    const int fr = F.lane & 15, fq = F.lane >> 4;
    ldsp ktr = KI + (8 * (F.lane >> 4) + ((F.lane & 15) >> 2)) * PK + (F.lane & 3) * 32, vtr = VI + tr_lane_off(F.lane, PT) + (16 * w) * 2;
    const bf16x8 ones = {0x3F80, 0x3F80, 0x3F80, 0x3F80, 0x3F80, 0x3F80, 0x3F80, 0x3F80};
#pragma unroll 1
    for (int et = 0; et < 3; ++et) {
#pragma unroll
        for (int i = 0; i < 4; ++i) { const int item = F.tid + 512 * i, s = item >> 4, e0 = (item & 15) * 8; *(LAS u32x4*)(VI + s * PT + e0 * 2) = vr[i]; }
        __syncthreads();
        if (et < 2) {
#pragma unroll
            for (int i = 0; i < 4; ++i) { const int item = F.tid + 512 * i, s = item >> 4, e0 = (item & 15) * 8; vr[i] = *(const u32x4*)(P + (size_t)s * PLD + P1_V + h * 384 + (et + 1) * 128 + e0); } }
        f32x4 acc[24]; zero_acc(acc); f32x4 an[3]; zero_acc(an);
        {
#pragma unroll
        for (int ks = 0; ks < 4; ++ks) { const bf16x8 av = tr_frag(vtr, ks * 32 * PT, PT);
#pragma unroll
            for (int n0 = 0; n0 < 24; n0 += 8) { bf16x8 bv[8];
#pragma unroll
                for (int i = 0; i < 8; ++i) bv[i] = tr_frag(ktr, ks * 32 * PK + ((n0 + i) >> 2) * 128 + ((n0 + i) & 3) * 8, PK);
#pragma unroll
                for (int i = 0; i < 8; ++i) acc[n0 + i] = __builtin_amdgcn_mfma_f32_16x16x32_bf16(bv[i], av, acc[n0 + i], 0, 0, 0); } }
        asm volatile("" ::: "memory"); }
        if (et == 0) {
#pragma unroll
            for (int ks = 0; ks < 4; ++ks)
#pragma unroll
                for (int q = 0; q < 3; ++q) { const int nt = 3 * w + q; const bf16x8 bv = tr_frag(ktr, ks * 32 * PK + (nt >> 2) * 128 + (nt & 3) * 8, PK); an[q] = __builtin_amdgcn_mfma_f32_16x16x32_bf16(bv, ones, an[q], 0, 0, 0); }
            if (fr == 0) { float* MN = (float*)(F.ws + WS_MN) + (size_t)(bh * 32 + c) * 384 + fq * 16;
#pragma unroll
                for (int q = 0; q < 3; ++q) { const int nt = 3 * w + q; *(f32x4*)(MN + (nt >> 2) * 64 + (nt & 3) * 4) = an[q]; } } }
        bf16_t* dst = (bf16_t*)(F.ws + WS_MC) + ((size_t)(bh * 32 + c) * 384 + et * 128 + 16 * w + fr) * 384 + fq * 16;
#pragma unroll
        for (int p = 0; p < 6; ++p) { u32x4 o0, o1; o0.x = pk2(acc[4 * p][0], acc[4 * p][1]); o0.y = pk2(acc[4 * p][2], acc[4 * p][3]); o0.z = pk2(acc[4 * p + 1][0], acc[4 * p + 1][1]); o0.w = pk2(acc[4 * p + 1][2], acc[4 * p + 1][3]);
            o1.x = pk2(acc[4 * p + 2][0], acc[4 * p + 2][1]); o1.y = pk2(acc[4 * p + 2][2], acc[4 * p + 2][3]); o1.z = pk2(acc[4 * p + 3][0], acc[4 * p + 3][1]); o1.w = pk2(acc[4 * p + 3][2], acc[4 * p + 3][3]);
            *(u32x4*)(dst + p * 64) = o0; *(u32x4*)(dst + p * 64 + 8) = o1; }
        __syncthreads();
    }
}

DI void s5_local_unit(const Frame& F_, const Args& a, int u) {
    Frame F = F_; { int tz = F_.tid; asm volatile("" : "+v"(tz)); F.tid = tz; F.lane = tz & 63; }
    const int g = u >> 3, cb = u & 7, w = F.wave, fr = F.lane & 15, fq = F.lane >> 4;
    ldsp PL = F.lds, BL = F.lds + 34816, UL = F.lds + 45056 + w * 4096;
    { const bf16_t* PW = (const bf16_t*)(F.ws + WS_S5G) + (size_t)g * 128 * 128; const bf16_t* BB = (const bf16_t*)(F.ws + WS_S5G) + (size_t)32 * 128 * 128 + (size_t)g * 128 * 32;
#pragma unroll
      for (int i = 0; i < 4; ++i) { const int item = F.tid + 512 * i, j = item >> 4, c0 = (item & 15) * 8; *(LAS u32x4*)(PL + j * PT + c0 * 2) = *(const u32x4*)(PW + (size_t)j * 128 + c0); }
      { const int r = F.tid >> 2, c0 = (F.tid & 3) * 8; *(LAS u32x4*)(BL + r * 80 + c0 * 2) = *(const u32x4*)(BB + (size_t)r * 32 + c0); } }
    __syncthreads();
    bf16x8 bb[8];
#pragma unroll
    for (int nt = 0; nt < 8; ++nt) bb[nt] = *(const LAS bf16x8*)(BL + (nt * 16 + fr) * 80 + fq * 16);
#pragma unroll 1
    for (int rnd = 0; rnd < 2; ++rnd) {
        const int mi = cb * 16 + rnd * 8 + w, b = mi >> 5, c = mi & 31; const size_t row0 = (size_t)(b * SEQ + c * 128);
        { const bf16_t* P = (const bf16_t*)(F.ws + WS_PROJ) + row0 * PLD + P1_U + g * 16 + (F.lane & 1) * 8;
#pragma unroll
          for (int i = 0; i < 4; ++i) { const int t = (F.lane >> 1) + 32 * i; *(LAS u32x4*)(UL + t * 32 + (F.lane & 1) * 16) = *(const u32x4*)(P + (size_t)t * PLD); } }
        LDS_WAIT();
        f32x4 es[8]; zero_acc(es);
#pragma unroll 1
        for (int rt = 0; rt < 8; ++rt) {
            bf16x8 av = *(const LAS bf16x8*)(UL + (16 * rt + fr) * 32 + (fq & 1) * 16); if (fq >= 2) av = (bf16x8){0, 0, 0, 0, 0, 0, 0, 0};
#pragma unroll
            for (int nt = 0; nt < 8; ++nt) { const f32x4 bu = __builtin_amdgcn_mfma_f32_16x16x32_bf16(bb[nt], av, (f32x4){0.f, 0.f, 0.f, 0.f}, 0, 0, 0);
                const u32x2 pw = *(const LAS u32x2*)(PL + (16 * rt + fr) * PT + (nt * 16 + fq * 4) * 2); const float p0r = bflo(pw.x), p0i = bfhi(pw.x), p1r = bflo(pw.y), p1i = bfhi(pw.y);
                es[nt][0] += p0r * bu[0] - p0i * bu[1]; es[nt][1] += p0r * bu[1] + p0i * bu[0]; es[nt][2] += p1r * bu[2] - p1i * bu[3]; es[nt][3] += p1r * bu[3] + p1i * bu[2]; }
        }
#pragma unroll
        for (int nt = 0; nt < 8; ++nt)
#pragma unroll
            for (int j = 0; j < 4; ++j) { float v = es[nt][j]; v += __shfl_xor(v, 1); v += __shfl_xor(v, 2); v += __shfl_xor(v, 4); v += __shfl_xor(v, 8); es[nt][j] = v; }
        if (fr == 0) { float* E = (float*)(F.ws + WS_S5E) + (size_t)((b * 32 + g) * 32 + c) * 128 + fq * 4;
#pragma unroll
            for (int nt = 0; nt < 8; ++nt) *(f32x4*)(E + nt * 16) = es[nt]; }
        LDS_WAIT();
    }
    __syncthreads();
}

DI void phase_odd_scan(const Frame& F, const Args& a) {
    LAS float* scp = (LAS float*)F.lds; LAS float* scn = scp + 512; LAS float* msl = scp + 1024;
    { const float* MSg = (const float*)(F.ws + WS_SMALL + 16384); msl[F.tid] = MSg[F.tid]; msl[512 + F.tid] = MSg[512 + F.tid]; }
    __syncthreads();
    if (F.tid < 16) { const int bh = F.tid; float* MST = (float*)(F.ws + WS_SMALL + 32768); float m = -INFINITY;
        for (int c = 0; c < 32; ++c) { const float bl = msl[(bh * 32 + c) * 2], ml = msl[(bh * 32 + c) * 2 + 1]; const float mn = fmaxf(bl + m, ml);
            scp[bh * 32 + c] = __expf(bl + m - mn); scn[bh * 32 + c] = __expf(ml - mn); if (F.bx == 0) MST[bh * 32 + c] = m; m = mn; } }
    __syncthreads();
    const int gt = F.bx * 512 + F.tid, NT_ = F.G * 512;
    for (int it = gt; it < 16 * 18432; it += NT_) { const int bh = it / 18432, v = it % 18432;
        bf16_t* p = (bf16_t*)(F.ws + WS_MC) + (size_t)bh * 32 * 147456 + (size_t)v * 8;
        float run[8];
#pragma unroll
        for (int j = 0; j < 8; ++j) run[j] = 0.f;
#pragma unroll 8
        for (int c = 0; c < 32; ++c) { float x[8]; unpack8(*(const u32x4*)(p + (size_t)c * 147456), x); *(u32x4*)(p + (size_t)c * 147456) = pack8(run);
            const float sp = scp[bh * 32 + c], sn = scn[bh * 32 + c];
#pragma unroll
            for (int j = 0; j < 8; ++j) run[j] = sp * run[j] + sn * x[j]; } }
    for (int it = gt; it < 16 * 96; it += NT_) { const int bh = it / 96, v = it % 96; float* p = (float*)(F.ws + WS_MN) + (size_t)bh * 32 * 384 + v * 4;
        f32x4 run = (f32x4){0.f, 0.f, 0.f, 0.f};
        for (int c = 0; c < 32; ++c) { const f32x4 x = *(const f32x4*)(p + c * 384); *(f32x4*)(p + c * 384) = run; run = run * scp[bh * 32 + c] + x * scn[bh * 32 + c]; } }
    for (int it = gt; it < 8192; it += NT_) { const int b = it >> 11, g = (it >> 6) & 31, n = it & 63; const f32x2 a128 = ((const f32x2*)(F.ws + WS_S5T))[2048 + g * 64 + n];
        f32x2* p = (f32x2*)(F.ws + WS_S5E) + (size_t)((b * 32 + g) * 32) * 64 + n; float sr = 0.f, si = 0.f;
        for (int c = 0; c < 32; ++c) { const f32x2 e = p[c * 64]; p[c * 64] = (f32x2){sr, si}; const float nr = a128.x * sr - a128.y * si + e.x, ni = a128.x * si + a128.y * sr + e.y; sr = nr; si = ni; } }
}

#define SCHED_FENCE() __builtin_amdgcn_sched_barrier(0)
struct MlCtx { const bf16_t* P; const bf16_t* Cg; const bf16_t* Kc; int h; };
template <int I> DI void ml_load(const MlCtx& m, int tidz, u32x4 (&r)[4]) {
#pragma unroll
    for (int i = 0; i < 4; ++i) { const int item = tidz + 512 * i, s = item >> 4, c0 = (item & 15) * 8;
        if constexpr (I < 3) r[i] = *(const u32x4*)(m.Kc + (size_t)s * 1536 + I * 128 + c0);
        else if constexpr (((I - 3) & 3) < 3) r[i] = *(const u32x4*)(m.Cg + (size_t)(((I - 3) >> 2) * 128 + s) * 384 + ((I - 3) & 3) * 128 + c0);
        else r[i] = *(const u32x4*)(m.P + (size_t)s * PLD + P1_V + m.h * 384 + ((I - 3) >> 2) * 128 + c0); }
}
DI void ml_store(int tidz, ldsp buf, const u32x4 (&r)[4]) {
#pragma unroll
    for (int i = 0; i < 4; ++i) { const int item = tidz + 512 * i, s = item >> 4, c0 = (item & 15) * 8; *(LAS u32x4*)(buf + s * PT + c0 * 2) = r[i]; }
}
template <int I> DI void ml_compute(const Frame& F, ldsp buf, ldsp Pm, const bf16x8 (&qf)[12], f32x4 (&as)[8], f32x4 (&ao)[8], int fr, int fq) {
    const int w = F.wave;
    if constexpr (I < 3) {
#pragma unroll
        for (int ks = 0; ks < 4; ++ks) { bf16x8 bv[8];
#pragma unroll
            for (int nt = 0; nt < 8; ++nt) bv[nt] = *(const LAS bf16x8*)(buf + (nt * 16 + fr) * PT + (ks * 32 + fq * 8) * 2);
            SCHED_FENCE();
#pragma unroll
            for (int nt = 0; nt < 8; ++nt) as[nt] = __builtin_amdgcn_mfma_f32_16x16x32_bf16(bv[nt], qf[I * 4 + ks], as[nt], 0, 0, 0);
            SCHED_FENCE(); }
    } else if constexpr (((I - 3) & 3) < 3) {
        constexpr int j = (I - 3) & 3;
#pragma unroll
        for (int ks = 0; ks < 4; ++ks) { bf16x8 bv[8];
#pragma unroll
            for (int nt = 0; nt < 8; ++nt) bv[nt] = *(const LAS bf16x8*)(buf + permb_row(nt, fr) * PT + (ks * 32 + fq * 8) * 2);
            SCHED_FENCE();
#pragma unroll
            for (int nt = 0; nt < 8; ++nt) ao[nt] = __builtin_amdgcn_mfma_f32_16x16x32_bf16(bv[nt], qf[j * 4 + ks], ao[nt], 0, 0, 0);
            SCHED_FENCE(); }
    } else {
        ldsp vtr = buf + tr_lane_off_p(F.lane, PT);
#pragma unroll
        for (int ks = 0; ks < 4; ++ks) if (ks <= (w >> 1)) { const bf16x8 av = *(const LAS bf16x8*)(Pm + (16 * w + fr) * PT + (ks * 32 + fq * 8) * 2); bf16x8 bv[8];
#pragma unroll
            for (int nt = 0; nt < 8; ++nt) bv[nt] = tr_frag(vtr, ks * 32 * PT + permb_off(nt), PT);
            SCHED_FENCE();
#pragma unroll
            for (int nt = 0; nt < 8; ++nt) ao[nt] = __builtin_amdgcn_mfma_f32_16x16x32_bf16(bv[nt], av, ao[nt], 0, 0, 0);
            SCHED_FENCE(); }
    }
}
DI void mlstm_out_unit(const Frame& F_, const Args& a, int u) {
    Frame F = F_; { int tz = F_.tid; asm volatile("" : "+v"(tz)); F.tid = tz; F.lane = tz & 63; }
    const int h = u & 3, c = (u >> 2) & 31, b = u >> 7, bh = b * 4 + h, w = F.wave;
    const size_t row0 = (size_t)(b * SEQ + c * 128);
    MlCtx m; m.P = (const bf16_t*)(F.ws + WS_PROJ) + row0 * PLD; m.Cg = (const bf16_t*)(F.ws + WS_MC) + (size_t)(bh * 32 + c) * 147456; m.Kc = (const bf16_t*)(F.ws + WS_KC) + row0 * 1536 + h * 384; m.h = h;
    ldsp X0 = F.lds, X1 = F.lds + 34816, Pm = F.lds + 69632;
    LAS float* gmb = (LAS float*)(F.lds + 104448); LAS float* nst = gmb + 128;
    u32x4 ra[4], rb[4];
    ml_load<0>(m, F.tid, ra); ml_load<1>(m, F.tid, rb);
    const float* ROWS = (const float*)(F.ws + WS_ROWS) + row0 * 4 + h;
    if (F.tid < 128) gmb[F.tid] = ROWS[65536 + F.tid * 4]; else nst[F.tid - 128] = ((const float*)(F.ws + WS_MN))[(size_t)(bh * 32 + c) * 384 + F.tid - 128];
    const int fr = F.lane & 15, fq = F.lane >> 4, l = 16 * w + fr;
    const float bl = ROWS[l * 4], pml = ROWS[131072 + l * 4], mst = ((const float*)(F.ws + WS_SMALL + 32768))[bh * 32 + c];
    const float mil = bl + mst, mtl = fmaxf(bl + pml, mil), iscl = __expf(mil - mtl);
    bf16x8 qf[12]; float qn = 0.f;
    { const bf16_t* qrow = (const bf16_t*)(F.ws + WS_QC) + (row0 + l) * 1536 + h * 384 + fq * 8;
#pragma unroll
      for (int ks = 0; ks < 12; ++ks) qf[ks] = __builtin_bit_cast(bf16x8, *(const u32x4*)(qrow + ks * 32)); }
    ml_store(F.tid, X0, ra);
    __syncthreads();
#pragma unroll
    for (int ks = 0; ks < 12; ++ks) { float y[8]; unpack8(__builtin_bit_cast(u32x4, qf[ks]), y);
#pragma unroll
        for (int j = 0; j < 8; ++j) qn += y[j] * nst[ks * 32 + fq * 8 + j]; }
    qn += __shfl_xor(qn, 16); qn += __shfl_xor(qn, 32);
    f32x4 as[8]; zero_acc(as); f32x4 ao[8]; zero_acc(ao);
    float den = 0.f, dn = 0.f, sm = 0.f, sq = 0.f;
    bf16_t* orow = (bf16_t*)(F.ws + WS_MIX) + (row0 + l) * 2048 + h * 384;
#define ML_STEP(I) do { int tidz = F.tid; asm volatile("" : "+v"(tidz)); \
        if constexpr ((I) + 2 < 15) { if constexpr ((I) & 1) ml_load<(I) + 2>(m, tidz, rb); else ml_load<(I) + 2>(m, tidz, ra); } \
        SCHED_FENCE(); \
        ml_compute<I>(F, ((I) & 1) ? X1 : X0, Pm, qf, as, ao, fr, fq); \
        if constexpr ((I) + 1 < 15) ml_store(tidz, (((I) + 1) & 1) ? X1 : X0, (((I) + 1) & 1) ? rb : ra); \
        SCHED_FENCE(); \
        if constexpr ((I) == 2) { \
            _Pragma("unroll") for (int nt = 0; nt < 8; ++nt) if (nt <= (w | 1)) { float pv[4]; \
                _Pragma("unroll") for (int j = 0; j < 4; ++j) { const int s = nt * 16 + fq * 4 + j; pv[j] = (nt <= w && s <= l) ? as[nt][j] * __expf(bl + gmb[s] - mtl) : 0.f; den += pv[j]; } \
                u32x2 pw; pw.x = pk2(pv[0], pv[1]); pw.y = pk2(pv[2], pv[3]); *(LAS u32x2*)(Pm + l * PT + (nt * 16 + fq * 4) * 2) = pw; } \
            den += __shfl_xor(den, 16); den += __shfl_xor(den, 32); den += iscl * qn; dn = __builtin_amdgcn_rcpf(fmaxf(fabsf(den), __expf(-mtl))); } \
        if constexpr ((I) >= 3 && (((I) - 3) & 3) == 2) { _Pragma("unroll") for (int nt = 0; nt < 8; ++nt) ao[nt] = ao[nt] * iscl; } \
        if constexpr ((I) >= 3 && (((I) - 3) & 3) == 3) { constexpr int et_ = ((I) - 3) >> 2; \
            _Pragma("unroll") for (int p_ = 0; p_ < 2; ++p_) { u32x4 o0, o1; \
                { const f32x4 h0 = ao[4 * p_] * dn, h1 = ao[4 * p_ + 1] * dn, h2 = ao[4 * p_ + 2] * dn, h3 = ao[4 * p_ + 3] * dn; \
                  sm += ((h0[0] + h0[1]) + (h0[2] + h0[3])) + ((h1[0] + h1[1]) + (h1[2] + h1[3])) + ((h2[0] + h2[1]) + (h2[2] + h2[3])) + ((h3[0] + h3[1]) + (h3[2] + h3[3])); \
                  sq += ((h0[0] * h0[0] + h0[1] * h0[1]) + (h0[2] * h0[2] + h0[3] * h0[3])) + ((h1[0] * h1[0] + h1[1] * h1[1]) + (h1[2] * h1[2] + h1[3] * h1[3])) + ((h2[0] * h2[0] + h2[1] * h2[1]) + (h2[2] * h2[2] + h2[3] * h2[3])) + ((h3[0] * h3[0] + h3[1] * h3[1]) + (h3[2] * h3[2] + h3[3] * h3[3])); \
                  o0.x = pk2(h0[0], h0[1]); o0.y = pk2(h0[2], h0[3]); o0.z = pk2(h1[0], h1[1]); o0.w = pk2(h1[2], h1[3]); o1.x = pk2(h2[0], h2[1]); o1.y = pk2(h2[2], h2[3]); o1.z = pk2(h3[0], h3[1]); o1.w = pk2(h3[2], h3[3]); } \
                *(u32x4*)(orow + et_ * 128 + 64 * p_ + 16 * fq) = o0; *(u32x4*)(orow + et_ * 128 + 64 * p_ + 16 * fq + 8) = o1; } \
            _Pragma("unroll") for (int nt = 0; nt < 8; ++nt) ao[nt] = (f32x4){0.f, 0.f, 0.f, 0.f}; } \
        __syncthreads(); } while (0)
    ML_STEP(0); ML_STEP(1); ML_STEP(2); ML_STEP(3); ML_STEP(4); ML_STEP(5); ML_STEP(6); ML_STEP(7); ML_STEP(8); ML_STEP(9); ML_STEP(10); ML_STEP(11); ML_STEP(12); ML_STEP(13); ML_STEP(14);
#undef ML_STEP
    sm += __shfl_xor(sm, 16); sm += __shfl_xor(sm, 32); sq += __shfl_xor(sq, 16); sq += __shfl_xor(sq, 32);
    const float mean = sm * (1.f / 384.f); const float var = fmaxf(sq * (1.f / 384.f) - mean * mean, 0.f);
    const float rstd = rsqrtf(var + EPS);
    const bf16_t* orow_g = m.P + (size_t)l * PLD + P1_O + h * 384; const float* ng = a.in[I_ML_NORM] + h * 384;
    asm volatile("s_waitcnt vmcnt(0)" ::: "memory");
#pragma unroll 6
    for (int k = 0; k < 12; ++k) { const int e = (k >> 1) * 64 + 16 * fq + 8 * (k & 1); float hv[8], ov[8]; unpack8(*(const u32x4*)(orow + e), hv); unpack8(*(const u32x4*)(orow_g + e), ov);
        const f32x4 n0 = *(const f32x4*)(ng + e), n1 = *(const f32x4*)(ng + e + 4); const float nn[8] = {n0[0], n0[1], n0[2], n0[3], n1[0], n1[1], n1[2], n1[3]}; float o[8];
#pragma unroll
        for (int q = 0; q < 8; ++q) o[q] = (hv[q] - mean) * rstd * nn[q] * sigmoid_(ov[q]);
        *(u32x4*)(orow + e) = pack8(o); }
    __syncthreads();
}

DI void s5_out_unit(const Frame& F_, const Args& a, int u) {
    Frame F = F_; { int tz = F_.tid; asm volatile("" : "+v"(tz)); F.tid = tz; F.lane = tz & 63; }
    const int g = u >> 3, cb = u & 7, w = F.wave;
    constexpr int PKN = 4112;
    ldsp KN = F.lds, WL = F.lds + 65792, CL = F.lds + 100608, UL = F.lds + 104960 + w * 4096;
    { const bf16_t* Kg = (const bf16_t*)(F.ws + WS_S5K) + (size_t)g * 16 * 2048;
#pragma unroll
      for (int i = 0; i < 8; ++i) { const int item = F.tid + 512 * i, r = item >> 8, c0 = (item & 255) * 8; *(LAS u32x4*)(KN + r * PKN + c0 * 2) = *(const u32x4*)(Kg + (size_t)r * 2048 + c0); }
      const float* Wg = (const float*)(F.ws + WS_S5W) + (size_t)g * 128 * 128;
#pragma unroll
      for (int i = 0; i < 4; ++i) { const int item = F.tid + 512 * i, t = item >> 4, c0 = (item & 15) * 8; const f32x4 w0 = *(const f32x4*)(Wg + (size_t)t * 128 + c0), w1 = *(const f32x4*)(Wg + (size_t)t * 128 + c0 + 4);
          *(LAS u32x4*)(WL + t * PT + c0 * 2) = (u32x4){pk2(w0[0], w0[1]), pk2(w0[2], w0[3]), pk2(w1[0], w1[1]), pk2(w1[2], w1[3])}; }
      if (F.tid < 256) { const int r = F.tid >> 4, c0 = (F.tid & 15) * 8; *(LAS u32x4*)(CL + r * PT + c0 * 2) = *(const u32x4*)((const bf16_t*)(F.ws + WS_S5C) + (size_t)(g * 16 + r) * 128 + c0); } }
    __syncthreads();
    const int fr = F.lane & 15, fq = F.lane >> 4;
    const f32x4 dk = *(const f32x4*)(a.in[I_S5_D] + g * 16 + fq * 4);
    bf16x8 cf[4];
#pragma unroll
    for (int k2 = 0; k2 < 4; ++k2) cf[k2] = *(const LAS bf16x8*)(CL + fr * PT + (k2 * 32 + fq * 8) * 2);
#pragma unroll 1
    for (int rnd = 0; rnd < 2; ++rnd) {
        const int mi = cb * 16 + rnd * 8 + w, b = mi >> 5, c = mi & 31; const size_t row0 = (size_t)(b * SEQ + c * 128);
        { const bf16_t* P = (const bf16_t*)(F.ws + WS_PROJ) + row0 * PLD + P1_U + g * 16 + (F.lane & 1) * 8;
#pragma unroll
          for (int i = 0; i < 4; ++i) { const int t = (F.lane >> 1) + 32 * i; *(LAS u32x4*)(UL + t * 32 + (F.lane & 1) * 16) = *(const u32x4*)(P + (size_t)t * PLD); } }
        f32x4 acc[8]; zero_acc(acc);
        {
            const float* Sin = (const float*)(F.ws + WS_S5E) + (size_t)((b * 32 + g) * 32 + c) * 128 + fq * 8;
#pragma unroll
            for (int k2 = 0; k2 < 4; ++k2) { const f32x4 s0 = *(const f32x4*)(Sin + k2 * 32), s1 = *(const f32x4*)(Sin + k2 * 32 + 4);
#pragma unroll
                for (int rt = 0; rt < 8; ++rt) { float wv_[8]; unpack8(*(const LAS u32x4*)(WL + (16 * rt + fr) * PT + (k2 * 32 + fq * 8) * 2), wv_);
                    u32x4 z; z.x = pk2(wv_[0] * s0[0] - wv_[1] * s0[1], wv_[0] * s0[1] + wv_[1] * s0[0]); z.y = pk2(wv_[2] * s0[2] - wv_[3] * s0[3], wv_[2] * s0[3] + wv_[3] * s0[2]);
                    z.z = pk2(wv_[4] * s1[0] - wv_[5] * s1[1], wv_[4] * s1[1] + wv_[5] * s1[0]); z.w = pk2(wv_[6] * s1[2] - wv_[7] * s1[3], wv_[6] * s1[3] + wv_[7] * s1[2]);
                    acc[rt] = __builtin_amdgcn_mfma_f32_16x16x32_bf16(cf[k2], __builtin_bit_cast(bf16x8, z), acc[rt], 0, 0, 0); } }
        }
        LDS_WAIT();
        {
            ldsp kb = KN + fr * PKN + fq * 16; const int tl = fr - (fq >> 1); ldsp ua = UL + (fq & 1) * 16;
#define FIR_SEG(SEG) _Pragma("unroll 2") for (int ks = 8 * (SEG); ks < 8 * (SEG) + 8; ++ks) { const bf16x8 kf = *(const LAS bf16x8*)(kb + ks * 64); bf16x8 av[8]; \
            _Pragma("unroll") for (int rt = (SEG); rt < 8; ++rt) { const int tr_ = 16 * rt - 2 * ks + tl; av[rt] = *(const LAS bf16x8*)(ua + (tr_ < 0 ? 0 : tr_) * 32); \
                if (rt == (SEG)) { if (tr_ < 0) av[rt] = (bf16x8){0, 0, 0, 0, 0, 0, 0, 0}; } } \
            _Pragma("unroll") for (int rt = (SEG); rt < 8; ++rt) acc[rt] = __builtin_amdgcn_mfma_f32_16x16x32_bf16(kf, av[rt], acc[rt], 0, 0, 0); }
            FIR_SEG(0) FIR_SEG(1) FIR_SEG(2) FIR_SEG(3) FIR_SEG(4) FIR_SEG(5) FIR_SEG(6) FIR_SEG(7)
#undef FIR_SEG
        }
        bf16_t* Y5 = (bf16_t*)(F.ws + WS_Y5) + row0 * 512 + g * 16 + fq * 4;
#pragma unroll
        for (int rt = 0; rt < 8; ++rt) { const int t = 16 * rt + fr; const u32x2 uv = *(const LAS u32x2*)(UL + t * 32 + fq * 8);
            u32x2 o; o.x = pk2(gelu_(acc[rt][0] + dk[0] * bflo(uv.x)), gelu_(acc[rt][1] + dk[1] * bfhi(uv.x))); o.y = pk2(gelu_(acc[rt][2] + dk[2] * bflo(uv.y)), gelu_(acc[rt][3] + dk[3] * bfhi(uv.y)));
            *(u32x2*)(Y5 + (size_t)t * 512) = o; }
        LDS_WAIT();
    }
    __syncthreads();
}

__global__ void __launch_bounds__(512, 2) fwd(Args a) {
    extern __shared__ __attribute__((aligned(16))) unsigned char shm[];
    Frame F; F.lds = (ldsp)shm; F.tid = threadIdx.x; F.lane = F.tid & 63; F.wave = __builtin_amdgcn_readfirstlane(F.tid >> 6); F.G = gridDim.x; F.bx = blockIdx.x; F.ws = a.ws;
    volatile LAS unsigned* LC = (volatile LAS unsigned*)(F.lds + LDS_CTL);
    if (F.tid < 128) LC[F.tid] = 0u;
    __syncthreads();
#if MK_SINGLE
    XcdBarrier bar = xcd_barrier_post((unsigned*)(F.ws + WS_CTL) + CW_BAR, LC + 8);
#define GRID_BAR() xcd_barrier(bar)
#else
#define GRID_BAR() do {} while (0)
#endif
    const int lo = a.ph_lo, hi = a.ph_hi;
#ifdef ONLY_PHASE
#define IN(k) ((k) == ONLY_PHASE && lo <= (k) && (k) < hi)
#else
#define IN(k) (lo <= (k) && (k) < hi)
#endif
#define SEAM(k) do { if (IN(k) && IN((k) + 1)) GRID_BAR(); } while (0)
    bf16_t* XN = (bf16_t*)(F.ws + WS_XN); bf16_t* MIX = (bf16_t*)(F.ws + WS_MIX); bf16_t* PROJ = (bf16_t*)(F.ws + WS_PROJ);

    if (IN(PH_PRO)) { phase_prologue(F, a); } SEAM(PH_PRO);
    if (IN(PH_INPROJ0)) { pg8::Tile2D S; S.init(F.ws + WS_H, F.ws + WS_WIN0, T, PLD, 2048, 2048, F.G, F.bx); pg8::EpiBf16S E{PROJ, PLD, (const float*)(F.ws + WS_RSTD0)};
        pg8::gemm_phase<pg8::EpiBf16S, pg8::Tile2D, false>(F.lds, 2048, 2048, 2048, S, E); } SEAM(PH_INPROJ0);
    if (IN(PH_PRE0)) { phase_pre0(F, a); } SEAM(PH_PRE0);
    if (IN(PH_LOCAL0)) { for (int u = F.bx; u < 1536; u += F.G) { if (u < 512) ssd_local_unit(F, a, u); else ret_local_unit(F, a, u - 512); } } SEAM(PH_LOCAL0);
    if (IN(PH_SCAN0)) { phase_even_scan(F, a); } SEAM(PH_SCAN0);
    if (IN(PH_OUT0)) { for (int u = F.bx; u < 1280; u += F.G) { if (u < 256) ssd_out_unit(F, a, u); else ret_out_unit(F, a, u - 256); } } SEAM(PH_OUT0);
    if (IN(PH_OUTPROJ0)) { pg8::Tile2D S; S.init(MIX, F.ws + WS_WOUT0, T, 2048, 2048, 2048, F.G, F.bx); pg8::EpiResBf16<true> E{F.ws + WS_H, (bf16_t*)(F.ws + WS_H), 2048};
        pg8::gemm_phase<pg8::EpiResBf16<true>, pg8::Tile2D, false>(F.lds, 2048, 2048, 2048, S, E); } SEAM(PH_OUTPROJ0);
    if (IN(PH_ROUTER0)) { phase_router(F, a, 0); } SEAM(PH_ROUTER0);
    if (IN(PH_GATEUP0)) { phase_moe_gateup(F, a, 0); } SEAM(PH_GATEUP0);
    if (IN(PH_DOWN0)) { phase_moe_down(F, a, 0); } SEAM(PH_DOWN0);
    if (IN(PH_COMBINE0)) { phase_combine<false>(F, a, 0); __syncthreads(); moe_convert(F, a, 1, 0, 2, F.bx, F.G); } SEAM(PH_COMBINE0);
    if (IN(PH_INPROJ1)) { pg8::Tile2D S; S.init(F.ws + WS_H, F.ws + WS_WIN1, T, PLD, 2048, 2048, F.G, F.bx); pg8::EpiBf16S E{PROJ, PLD, (const float*)(F.ws + WS_RSTD1)};
        pg8::gemm_phase<pg8::EpiBf16S, pg8::Tile2D, false>(F.lds, 2048, 2048, 2048, S, E); } SEAM(PH_INPROJ1);
    if (IN(PH_PRE1)) { phase_pre1(F, a); } SEAM(PH_PRE1);
    if (IN(PH_LOCAL1)) { TSTAMP(0); for (int u = F.bx; u < 768; u += F.G) { if (u < 256) { for (int r_ = 0; r_ < S5_REP; ++r_) s5_local_unit(F, a, u); } else { for (int r_ = 0; r_ < ML_REP; ++r_) mlstm_local_unit(F, a, u - 256); } TSTAMP(1 + (u >> 8)); } } SEAM(PH_LOCAL1);
    if (IN(PH_SCAN1)) { phase_odd_scan(F, a); } SEAM(PH_SCAN1);
    if (IN(PH_OUT1)) { TSTAMP(4); for (int u = F.bx; u < 768; u += F.G) { if (u < 256) { for (int r_ = 0; r_ < S5_REP; ++r_) s5_out_unit(F, a, u); } else { for (int r_ = 0; r_ < ML_REP; ++r_) mlstm_out_unit(F, a, u - 256); } TSTAMP(5 + (u >> 8)); } } SEAM(PH_OUT1);
    if (IN(PH_GLU)) { pg8::Tile2D S; S.init(F.ws + WS_Y5, F.ws + WS_WGLU, T, 1024, 512, 512, F.G, F.bx); pg8::EpiGlu E{MIX + 1536, 2048, a.in[I_S5_BGLU]};
        pg8::GluOrder GS{S};
        pg8::gemm_phase<pg8::EpiGlu, pg8::GluOrder, false>(F.lds, 512, 512, 512, GS, E); } SEAM(PH_GLU);
    if (IN(PH_OUTPROJ1)) { pg8::Tile2D S; S.init(MIX, F.ws + WS_WOUT1, T, 2048, 2048, 2048, F.G, F.bx); pg8::EpiResBf16<true> E{F.ws + WS_H, (bf16_t*)(F.ws + WS_H), 2048};
        pg8::gemm_phase<pg8::EpiResBf16<true>, pg8::Tile2D, false>(F.lds, 2048, 2048, 2048, S, E); } SEAM(PH_OUTPROJ1);
    if (IN(PH_ROUTER1)) { phase_router(F, a, 1); } SEAM(PH_ROUTER1);
    if (IN(PH_GATEUP1)) { phase_moe_gateup(F, a, 1); } SEAM(PH_GATEUP1);
    if (IN(PH_DOWN1)) { phase_moe_down(F, a, 1); } SEAM(PH_DOWN1);
    if (IN(PH_COMBINE1)) { phase_combine<true>(F, a, 1); }
#undef IN
#undef SEAM
}


#if DBG
constexpr size_t WS_DBG = WS_SMALL + 65536;
__device__ __forceinline__ void dbg_pub(float err, unsigned char* ws) {
    __shared__ unsigned red_;
    if (threadIdx.x == 0) red_ = 0u; __syncthreads();
    if (!(err >= 0.f)) err = __builtin_nanf("");
    atomicMax(&red_, __float_as_uint(err)); __syncthreads();
    if (threadIdx.x == 0) atomicMax((unsigned*)(ws + WS_DBG), red_);
    __syncthreads();
}
__device__ __forceinline__ float dbg_bsum(float v, float* sh) {
    __syncthreads(); sh[threadIdx.x] = v; __syncthreads();
    float t = 0.f; for (int i = 0; i < (int)blockDim.x; ++i) t += sh[i];
    __syncthreads(); return t;
}
__global__ void dbg_dump(float* out, const unsigned char* ws) {
    const size_t i = (size_t)blockIdx.x * blockDim.x + threadIdx.x; const size_t N = (size_t)T * D;
    if (i < N) { float v = 0.f; if (i == 0) { const float E = *(const float*)(ws + WS_DBG); float t = 10.f + log10f(fmaxf(E, 1e-12f)); t = fminf(fmaxf(t, 0.5f), 30.f); if (!(E == E)) t = 25.f; v = sqrtf((float)N * t); } out[i] = v; }
}
#define PRJ(row, col) bf2f(((const bf16_t*)(a.ws + WS_PROJ))[(size_t)(row) * PLD + (col)])
#define MIXV(row, col) bf2f(((const bf16_t*)(a.ws + WS_MIX))[(size_t)(row) * 2048 + (col)])
__device__ __forceinline__ float dbg_conv_(const bf16_t* prj, const float* cw, const float* cb, int C, size_t row, int pos, int col0, int ch) {
    float y = cb[ch];
    for (int tap = 0; tap < 4; ++tap) if (pos - 3 + tap >= 0) y += cw[tap * C + ch] * bf2f(prj[(size_t)(row - 3 + tap) * PLD + col0 + ch]);
    return y / (1.f + expf(-y));
}
#define dbg_conv(a, layer1, row, pos, col0, ch) dbg_conv_((const bf16_t*)((a).ws + WS_PROJ), (a).in[(layer1) ? I_ML_CONVW : I_SSD_CONVW], (a).in[(layer1) ? I_ML_CONVB : I_SSD_CONVB], (layer1) ? 3072 : 1536, row, pos, col0, ch)
__global__ void dbg_check_proj(Args a, int layer1) {
    const int tid = threadIdx.x + blockIdx.x * blockDim.x; const int NN = layer1 ? N1 : N0; const int row = (tid * 7919 + 13) % T, col = (tid * 104729 + 7) % NN;
    const float* x = (layer1 ? a.out : a.in[I_X]) + (size_t)row * D; const float* g = a.in[layer1 ? I_ODD_NORM : I_EVEN_NORM]; const float* W = a.in[layer1 ? I_ODD_WIN : I_EVEN_WIN];
    float ss = 0.f; for (int k = 0; k < D; ++k) ss += x[k] * x[k];
    const float rstd = rsqrtf(ss / D + EPS); float ref = 0.f;
    for (int k = 0; k < D; ++k) ref += x[k] * rstd * g[k] * W[(size_t)k * NN + col];
    dbg_pub(fabsf(PRJ(row, col) - ref) / (fabsf(ref) + 0.25f), a.ws);
}
__global__ void dbg_check_outproj(Args a, int layer1, const float* hprev) {
    const int tid = threadIdx.x + blockIdx.x * blockDim.x; const int row = (tid * 7919 + 13) % T, col = (tid * 104729 + 7) % D;
    const float* W = a.in[layer1 ? I_ODD_WOUT : I_EVEN_WOUT]; float ref = 0.f;
    for (int k = 0; k < 2048; ++k) ref += MIXV(row, k) * W[(size_t)k * D + col];
    const float r0 = hprev[(size_t)row * D + col];
    dbg_pub(fabsf(a.out[(size_t)row * D + col] - (r0 + ref)) / (fabsf(ref) + 0.25f), a.ws);
}
__global__ void dbg_check_ret(Args a) {
    __shared__ float qs[128], ks[128], sh[128];
    const int i = blockIdx.x, b = i & 3, h = (i >> 2) & 7, pos = (i * 977 + 131 + (i & 1) * 60) % SEQ, e = threadIdx.x; const size_t rb = (size_t)b * SEQ;
    const float lg = log1pf(-exp2f(-5.f - (float)h)); const int dd = e & 63; const float inv = 1.0f / powf(10000.f, (float)(2 * dd) / 128.f);
    { const float ang = (float)pos * inv, c = cosf(ang), sn = sinf(ang); const float t1 = PRJ(rb + pos, h * 128 + dd), t2 = PRJ(rb + pos, h * 128 + dd + 64); qs[e] = e < 64 ? t1 * c - t2 * sn : t1 * sn + t2 * c; }
    float o = 0.f;
    for (int s = 0; s <= pos; ++s) {
        __syncthreads();
        { const float ang = (float)s * inv, c = cosf(ang), sn = sinf(ang); const float t1 = PRJ(rb + s, P0_K + h * 128 + dd), t2 = PRJ(rb + s, P0_K + h * 128 + dd + 64); ks[e] = (e < 64 ? t1 * c - t2 * sn : t1 * sn + t2 * c) * 0.08838834764831845f; }
        __syncthreads();
        float sc = 0.f;
#pragma unroll 4
        for (int d = 0; d < 128; ++d) sc += qs[d] * ks[d];
        o += sc * expf(lg * (float)(pos - s)) * PRJ(rb + s, P0_V + h * 128 + e);
    }
    const float mean = dbg_bsum(o, sh) / 128.f; const float var = dbg_bsum((o - mean) * (o - mean), sh) / 128.f;
    const float gg = PRJ(rb + pos, P0_G + h * 128 + e);
    const float ref = (o - mean) * rsqrtf(var + EPS) * a.in[I_RET_NORM][h * 128 + e] * (gg / (1.f + expf(-gg)));
    dbg_pub(fabsf(MIXV(rb + pos, h * 128 + e) - ref) / (fabsf(ref) + 0.25f), a.ws);
}
__global__ void __launch_bounds__(512) dbg_check_ssd(Args a) {
    __shared__ float bms[128], cms[128], sh[512];
    const int i = blockIdx.x, b = i & 3, g = (i >> 2) & 1, pos = (i * 977 + 131 + (i & 1) * 60) % SEQ, ch = threadIdx.x, r = ch >> 6, hd = g * 8 + r; const size_t rb = (size_t)b * SEQ;
    const float A = -expf(a.in[I_SSD_ALOG][hd]), dtb = a.in[I_SSD_DTB][hd];
    float Apos = 0.f;
    for (int s = 0; s <= pos; ++s) { const float v = PRJ(rb + s, P0_DT + hd) + dtb; const float dt = v > 20.f ? v : log1pf(expf(v)); Apos += dt * A; }
    if (ch < 128) cms[ch] = dbg_conv(a, 0, rb + pos, pos, P0_XBC, 1280 + g * 128 + ch);
    float y = 0.f, As = 0.f;
    for (int s = 0; s <= pos; ++s) {
        __syncthreads();
        if (ch < 128) bms[ch] = dbg_conv(a, 0, rb + s, s, P0_XBC, 1024 + g * 128 + ch);
        __syncthreads();
        float cb = 0.f;
#pragma unroll 4
        for (int n = 0; n < 128; ++n) cb += cms[n] * bms[n];
        const float v = PRJ(rb + s, P0_DT + hd) + dtb; const float dt = v > 20.f ? v : log1pf(expf(v)); As += dt * A;
        y += cb * expf(Apos - As) * dbg_conv(a, 0, rb + s, s, P0_XBC, g * 512 + ch) * dt;
    }
    const float xs = dbg_conv(a, 0, rb + pos, pos, P0_XBC, g * 512 + ch), z = PRJ(rb + pos, P0_Z + g * 512 + ch);
    y = (y + a.in[I_SSD_D][hd] * xs) * (z / (1.f + expf(-z)));
    const float ms = dbg_bsum(y * y, sh) / 512.f;
    const float ref = y * rsqrtf(ms + EPS) * a.in[I_SSD_NORM][g * 512 + ch];
    dbg_pub(fabsf(MIXV(rb + pos, 1024 + g * 512 + ch) - ref) / (fabsf(ref) + 0.25f), a.ws);
}
__global__ void __launch_bounds__(384) dbg_check_mlstm(Args a) {
    __shared__ float qs[384], ks[384], sh[384];
    const int i = blockIdx.x, b = i & 3, h = (i >> 2) & 3, pos = (i * 977 + 131 + (i & 1) * 60) % SEQ, e = threadIdx.x; const size_t rb = (size_t)b * SEQ;
    const float fb = a.in[I_ML_FB][h], ib = a.in[I_ML_IB][h];
    float Fpos = 0.f; for (int s = 0; s <= pos; ++s) { const float f = PRJ(rb + s, P1_F + h) + fb; Fpos += -(-f > 20.f ? -f : log1pf(expf(-f))); }
    float m = -INFINITY, Fs = 0.f; for (int s = 0; s <= pos; ++s) { const float f = PRJ(rb + s, P1_F + h) + fb; Fs += -(-f > 20.f ? -f : log1pf(expf(-f))); m = fmaxf(m, Fpos - Fs + PRJ(rb + s, P1_I + h) + ib); }
    qs[e] = dbg_conv(a, 1, rb + pos, pos, 0, h * 384 + e) * 0.05103103630798288f;
    float N = 0.f, Dn = 0.f; Fs = 0.f;
    for (int s = 0; s <= pos; ++s) {
        __syncthreads();
        ks[e] = dbg_conv(a, 1, rb + s, s, 0, 1536 + h * 384 + e);
        __syncthreads();
        float qk = 0.f;
#pragma unroll 4
        for (int d = 0; d < 384; ++d) qk += qs[d] * ks[d];
        const float f = PRJ(rb + s, P1_F + h) + fb; Fs += -(-f > 20.f ? -f : log1pf(expf(-f)));
        const float w = expf(Fpos - Fs + PRJ(rb + s, P1_I + h) + ib - m);
        N += w * qk * PRJ(rb + s, P1_V + h * 384 + e); Dn += w * qk;
    }
    const float hv = N / fmaxf(fabsf(Dn), expf(-m));
    const float mean = dbg_bsum(hv, sh) / 384.f; const float var = dbg_bsum((hv - mean) * (hv - mean), sh) / 384.f;
    const float o = PRJ(rb + pos, P1_O + h * 384 + e);
    const float ref = (hv - mean) * rsqrtf(var + EPS) * a.in[I_ML_NORM][h * 384 + e] / (1.f + expf(-o));
    dbg_pub(fabsf(MIXV(rb + pos, h * 384 + e) - ref) / (fabsf(ref) + 0.25f), a.ws);
}
__global__ void dbg_check_s5(Args a) {
    __shared__ float yr[16][64];
    const int i = blockIdx.x, b = i & 3, g = (i >> 2) & 31, pos = (i * 977 + 131 + (i & 1) * 60) % SEQ, n = threadIdx.x; const size_t rb = (size_t)b * SEQ;
    const float dt = expf(a.in[I_S5_LOGDT][g]), are = a.in[I_S5_ARE][g * 64 + n], aim = a.in[I_S5_AIM][g * 64 + n];
    const float mag = expf(are * dt), abr = mag * cosf(aim * dt), abi = mag * sinf(aim * dt), den = are * are + aim * aim, nr = abr - 1.f;
    const float cr = (nr * are + abi * aim) / den, ci = (abi * are - nr * aim) / den;
    float bbr[16], bbi[16];
#pragma unroll
    for (int c = 0; c < 16; ++c) { const float br = a.in[I_S5_BRE][(size_t)(g * 64 + n) * 16 + c], bi = a.in[I_S5_BIM][(size_t)(g * 64 + n) * 16 + c]; bbr[c] = cr * br - ci * bi; bbi[c] = cr * bi + ci * br; }
    float sr = 0.f, si = 0.f;
    for (int t = 0; t <= pos; ++t) { float ur = 0.f, ui = 0.f;
#pragma unroll
        for (int c = 0; c < 16; ++c) { const float u = PRJ(rb + t, P1_U + g * 16 + c); ur += bbr[c] * u; ui += bbi[c] * u; }
        const float nr2 = abr * sr - abi * si + ur, ni2 = abr * si + abi * sr + ui; sr = nr2; si = ni2; }
    for (int c = 0; c < 16; ++c) yr[c][n] = a.in[I_S5_CRE][(size_t)(g * 16 + c) * 64 + n] * sr - a.in[I_S5_CIM][(size_t)(g * 16 + c) * 64 + n] * si;
    __syncthreads();
    float err = 0.f;
    if (n < 16) { float y = 0.f; for (int k = 0; k < 64; ++k) y += yr[n][k]; y += a.in[I_S5_D][g * 16 + n] * PRJ(rb + pos, P1_U + g * 16 + n);
        const float u = 0.7978845608f * (y + 0.044715f * y * y * y); const float ref = 0.5f * y * (1.f + tanhf(u));
        const float got = bf2f(((const bf16_t*)(a.ws + WS_Y5))[(rb + pos) * 512 + g * 16 + n]); err = fabsf(got - ref) / (fabsf(ref) + 0.25f); }
    dbg_pub(err, a.ws);
}
__global__ void dbg_check_glu(Args a) {
    const int tid = threadIdx.x + blockIdx.x * blockDim.x; const int row = (tid * 7919 + 13) % T, col = (tid * 104729 + 7) % 512;
    float v = a.in[I_S5_BGLU][col], gt = a.in[I_S5_BGLU][512 + col];
    for (int k = 0; k < 512; ++k) { const float y = bf2f(((const bf16_t*)(a.ws + WS_Y5))[(size_t)row * 512 + k]); v += y * a.in[I_S5_WGLU][(size_t)k * 1024 + col]; gt += y * a.in[I_S5_WGLU][(size_t)k * 1024 + 512 + col]; }
    const float ref = v / (1.f + expf(-gt));
    dbg_pub(fabsf(MIXV(row, 1536 + col) - ref) / (fabsf(ref) + 0.25f), a.ws);
}
__global__ void dbg_check_router(Args a, int layer) {
    const int tid = threadIdx.x + blockIdx.x * blockDim.x; const int tok = (tid * 7919 + 13) % T; const float* x = a.out + (size_t)tok * D;
    float ss = 0.f; for (int k = 0; k < D; ++k) ss += x[k] * x[k];
    const float rstd = rsqrtf(ss / D + EPS); float gmax = -INFINITY, gsec = -INFINITY; int gi = 0; float se = 0.f;
    for (int j = 0; j < 4; ++j) { float l = 0.f; for (int k = 0; k < D; ++k) l += x[k] * rstd * a.in[I_MOE_NORM][layer * D + k] * a.in[I_MOE_RG][(size_t)(layer * D + k) * 4 + j]; l += a.in[I_MOE_RGB][layer * 4 + j];
        if (l > gmax) { se = se * expf(gmax - l) + 1.f; gsec = gmax; gmax = l; gi = j; } else { se += expf(l - gmax); gsec = fmaxf(gsec, l); } }
    float v1 = -INFINITY, v2 = -INFINITY, v3 = -INFINITY; int i1 = 0, i2 = 0;
    for (int j = 0; j < 8; ++j) { float l = 0.f; for (int k = 0; k < D; ++k) l += x[k] * rstd * a.in[I_MOE_NORM][layer * D + k] * a.in[I_MOE_RE][(size_t)(layer * D + k) * 32 + gi * 8 + j]; l += a.in[I_MOE_REB][layer * 32 + gi * 8 + j];
        if (l > v1) { v3 = v2; v2 = v1; i2 = i1; v1 = l; i1 = j; } else if (l > v2) { v3 = v2; v2 = l; i2 = j; } else v3 = fmaxf(v3, l); }
    const float e2 = expf(v2 - v1), w1 = (1.f / se) / (1.f + e2), w2 = (1.f / se) * e2 / (1.f + e2);
    const int* sp = (const int*)(a.ws + WS_SLOT) + (size_t)tok * 8;
    float err = 0.f;
    if (sp[0] != gi * 8 + i1 || sp[3] != gi * 8 + i2) err += (v2 - v3 > 1e-3f && v1 - v2 > 1e-3f && gmax - gsec > 1e-3f) ? 1.f : 0.f;
    else err = fabsf(__int_as_float(sp[2]) - w1) + fabsf(__int_as_float(sp[5]) - w2);
    const unsigned* cnt = (const unsigned*)(a.ws + WS_CTL) + CW_CNT + layer * 32 * 64; unsigned tot = 0; for (int e = 0; e < 32; ++e) tot += cnt[e * 64];
    if (tot != 2u * T) err += 2.f;
    if (sp[1] < 0 || sp[1] >= (int)cnt[sp[0] * 64] || ((const int*)(a.ws + WS_LIST))[sp[0] * T + sp[1]] != tok) err += 4.f;
    dbg_pub(err, a.ws);
}
__device__ __forceinline__ bool dbg_bad(float v) { return !(v - v == 0.f); }
__global__ void dbg_scan_odd(Args a) {
    const size_t gt = (size_t)blockIdx.x * blockDim.x + threadIdx.x, NT_ = (size_t)gridDim.x * blockDim.x; unsigned fl = 0u;
    const float* MS = (const float*)(a.ws + WS_SMALL + 16384); const float* MST = (const float*)(a.ws + WS_SMALL + 32768);
    for (size_t i = gt; i < 1024; i += NT_) if (dbg_bad(MS[i])) fl |= 1u;
    for (size_t i = gt; i < 512; i += NT_) { const float v = MST[i]; if ((i & 31) == 0 ? !(v == -INFINITY) : dbg_bad(v)) fl |= 2u; }
    const bf16_t* MC = (const bf16_t*)(a.ws + WS_MC); for (size_t i = gt; i < (size_t)16 * 32 * 147456; i += NT_) if (dbg_bad(bf2f(MC[i]))) fl |= 4u;
    const float* MN = (const float*)(a.ws + WS_MN); for (size_t i = gt; i < (size_t)16 * 32 * 384; i += NT_) if (dbg_bad(MN[i])) fl |= 8u;
    const bf16_t* MX = (const bf16_t*)(a.ws + WS_MIX); for (size_t i = gt; i < (size_t)T * 1536; i += NT_) if (dbg_bad(bf2f(MX[(i / 1536) * 2048 + (i % 1536)]))) fl |= 16u;
    const bf16_t* PJ = (const bf16_t*)(a.ws + WS_PROJ); for (size_t i = gt; i < (size_t)T * N1; i += NT_) if (dbg_bad(bf2f(PJ[(i / N1) * PLD + (i % N1)]))) fl |= 32u;
    if (fl) atomicOr((unsigned*)(a.ws + WS_DBG + 4), fl);
}
__global__ void dbg_count_mc(Args a) {
    const size_t gt = (size_t)blockIdx.x * blockDim.x + threadIdx.x, NT_ = (size_t)gridDim.x * blockDim.x; unsigned n = 0;
    const bf16_t* MC = (const bf16_t*)(a.ws + WS_MC); for (size_t i = gt; i < (size_t)16 * 32 * 147456; i += NT_) if (dbg_bad(bf2f(MC[i]))) ++n;
    if (n) atomicAdd((unsigned*)(a.ws + WS_DBG + 4), n);
}
__global__ void dbg_count_fin(Args a) { const unsigned n = *(const unsigned*)(a.ws + WS_DBG + 4); *(float*)(a.ws + WS_DBG) = exp10f(log10f((float)n + 1.f) - 9.f); }
__global__ void dbg_ts_fin(Args a) { const unsigned long long* ts = (const unsigned long long*)(a.ws + WS_TS); const float us = (float)(ts[TS_SEL + 1] - ts[TS_SEL]) * 0.01f; *(float*)(a.ws + WS_DBG) = exp10f(us / TS_SCALE - 10.f); }
__global__ void dbg_scan_fin(Args a) { const unsigned fl = *(const unsigned*)(a.ws + WS_DBG + 4); *(float*)(a.ws + WS_DBG) = exp10f(0.1f * (float)fl - 9.f); }
__global__ void __launch_bounds__(512) dbg_check_moe(Args a, int layer) {
    __shared__ float xs[2048], hid[512]; __shared__ int ts[33];
    const int i = blockIdx.x, tok = (i * 7919 + 13) % T, slot = i & 1, f = threadIdx.x;
    const int* sp = (const int*)(a.ws + WS_SLOT) + (size_t)tok * 8; const int e = sp[slot * 3], r = sp[slot * 3 + 1];
    if (f == 0) { const unsigned* cnt = (const unsigned*)(a.ws + WS_CTL) + CW_CNT + layer * 32 * 64; int acc = 0; for (int q = 0; q < 32; ++q) { ts[q] = acc; acc += ((int)cnt[q * 64] + 255) >> 8; } }
    for (int k = f; k < 2048; k += 512) xs[k] = bf2f(((const bf16_t*)(a.ws + WS_XN))[(size_t)tok * D + k]) * ((const float*)(a.ws + WS_RSTD))[tok];
    __syncthreads();
    const float* wg = a.in[I_MOE_WG] + (size_t)(layer * 32 + e) * 2048 * 512; const float* wu = a.in[I_MOE_WU] + (size_t)(layer * 32 + e) * 2048 * 512; const float* wd = a.in[I_MOE_WD] + (size_t)(layer * 32 + e) * 512 * 2048;
    float gg = 0.f, uu = 0.f; for (int k = 0; k < 2048; ++k) { gg += xs[k] * wg[(size_t)k * 512 + f]; uu += xs[k] * wu[(size_t)k * 512 + f]; }
    hid[f] = gg / (1.f + expf(-gg)) * uu;
    __syncthreads();
    const int col = (f * 37 + 5) % D; float ref = 0.f; for (int k = 0; k < 512; ++k) ref += hid[k] * wd[(size_t)k * D + col];
    const float got = bf2f(((const bf16_t*)(a.ws + WS_Y))[(size_t)(ts[e] * 256 + r) * D + col]);
    dbg_pub(fabsf(got - ref) / (fabsf(ref) + 0.25f), a.ws);
}
#endif

extern "C" void kernel_launch(void* const* d_in, const int* in_sizes, int n_in, void* d_out, int out_size, void* d_ws, size_t ws_size, hipStream_t stream) {
    static int grid = 0;
    if (grid == 0) {
        if (n_in != 38 || out_size != T * D || ws_size < WS_END) { fprintf(stderr, "kernel_launch: unexpected problem (n_in %d, out %d, ws %zu)\n", n_in, out_size, ws_size); grid = -1; return; }
        int dev = 0, cus = 0, per_cu = 0;
        if (hipGetDevice(&dev) != hipSuccess || hipDeviceGetAttribute(&cus, hipDeviceAttributeMultiprocessorCount, dev) != hipSuccess) { grid = -1; return; }
        if (hipFuncSetAttribute((const void*)fwd, hipFuncAttributeMaxDynamicSharedMemorySize, LDS_BYTES) != hipSuccess) { fprintf(stderr, "kernel_launch: hipFuncSetAttribute failed\n"); grid = -1; return; }
        if (hipOccupancyMaxActiveBlocksPerMultiprocessor(&per_cu, (const void*)fwd, 512, LDS_BYTES) != hipSuccess || per_cu < 1) fprintf(stderr, "kernel_launch: occupancy query reports %d\n", per_cu);
        (void)hipGetLastError();
        grid = cus;
    }
    if (grid < 0) return;
    (void)hipMemsetAsync((char*)d_ws + WS_CTL, 0, CTL_BYTES, stream);
    Args a{};
    for (int i = 0; i < 38; ++i) a.in[i] = (const float*)d_in[i];
    a.out = (float*)d_out; a.ws = (unsigned char*)d_ws;
#if DBG
    constexpr int dbg_last = (DBG == 1) ? PH_INPROJ0 : (DBG == 2 || DBG == 3) ? PH_OUT0 : (DBG == 4) ? PH_OUTPROJ0 : (DBG == 5) ? PH_ROUTER0 : (DBG == 6 || DBG == 20) ? PH_DOWN0 : (DBG == 7) ? PH_INPROJ1 : (DBG == 8 || DBG == 9 || DBG == 30) ? PH_OUT1 : (DBG == 10) ? PH_GLU : (DBG == 11) ? PH_OUTPROJ1 : (DBG == 12) ? PH_ROUTER1 : (DBG == 40) ? PH_OUT1 : PH_DOWN1;
    (void)hipMemsetAsync((char*)d_ws + WS_DBG, 0, 8, stream);
    float* hsave = (float*)((char*)d_ws + WS_PROJ);
#define DBG_ON(k) (DBG == (k) || (DBG == 20 && (k) <= 6) || (DBG == 21 && (k) >= 7))
    for (int p = 0; p <= dbg_last; ++p) {
        if (p == PH_OUTPROJ1 && DBG_ON(11)) (void)hipMemcpyAsync(hsave, d_out, (size_t)T * D * 4, hipMemcpyDeviceToDevice, stream);
        a.ph_lo = p; a.ph_hi = p + 1; hipLaunchKernelGGL(fwd, dim3(grid), dim3(512), LDS_BYTES, stream, a);
        a.ph_lo = 0; a.ph_hi = 0;
        if (p == PH_INPROJ0 && DBG_ON(1)) hipLaunchKernelGGL(dbg_check_proj, dim3(4), dim3(256), 0, stream, a, 0);
        if (p == PH_OUT0 && DBG_ON(2)) hipLaunchKernelGGL(dbg_check_ret, dim3(32), dim3(128), 0, stream, a);
        if (p == PH_OUT0 && DBG_ON(3)) hipLaunchKernelGGL(dbg_check_ssd, dim3(16), dim3(512), 0, stream, a);
        if (p == PH_OUTPROJ0 && DBG_ON(4)) hipLaunchKernelGGL(dbg_check_outproj, dim3(4), dim3(256), 0, stream, a, 0, (const float*)d_in[0]);
        if (p == PH_ROUTER0 && DBG_ON(5)) hipLaunchKernelGGL(dbg_check_router, dim3(4), dim3(128), 0, stream, a, 0);
        if (p == PH_DOWN0 && DBG_ON(6)) hipLaunchKernelGGL(dbg_check_moe, dim3(32), dim3(512), 0, stream, a, 0);
        if (p == PH_INPROJ1 && DBG_ON(7)) hipLaunchKernelGGL(dbg_check_proj, dim3(4), dim3(256), 0, stream, a, 1);
        if (p == PH_OUT1 && DBG_ON(8)) hipLaunchKernelGGL(dbg_check_mlstm, dim3(16), dim3(384), 0, stream, a);
        if (p == PH_OUT1 && DBG_ON(9)) hipLaunchKernelGGL(dbg_check_s5, dim3(64), dim3(64), 0, stream, a);
        if (p == PH_OUT1 && DBG == 30) { hipLaunchKernelGGL(dbg_scan_odd, dim3(1024), dim3(256), 0, stream, a); hipLaunchKernelGGL(dbg_scan_fin, dim3(1), dim3(1), 0, stream, a); }
        if (p == PH_OUT1 && DBG == 40) hipLaunchKernelGGL(dbg_ts_fin, dim3(1), dim3(1), 0, stream, a);
        if (p == PH_GLU && DBG_ON(10)) hipLaunchKernelGGL(dbg_check_glu, dim3(4), dim3(256), 0, stream, a);
        if (p == PH_OUTPROJ1 && DBG_ON(11)) hipLaunchKernelGGL(dbg_check_outproj, dim3(4), dim3(256), 0, stream, a, 1, (const float*)hsave);
        if (p == PH_ROUTER1 && DBG_ON(12)) hipLaunchKernelGGL(dbg_check_router, dim3(4), dim3(128), 0, stream, a, 1);
        if (p == PH_DOWN1 && DBG_ON(13)) hipLaunchKernelGGL(dbg_check_moe, dim3(32), dim3(512), 0, stream, a, 1);
    }
    hipLaunchKernelGGL(dbg_dump, dim3((T * D + 255) / 256), dim3(256), 0, stream, (float*)d_out, (const unsigned char*)d_ws);
#elif MK_SINGLE
    a.ph_lo = 0; a.ph_hi = NPHASE;
    hipLaunchKernelGGL(fwd, dim3(grid), dim3(512), LDS_BYTES, stream, a);
#else
    for (int p = 0; p < NPHASE; ++p) { a.ph_lo = p; a.ph_hi = p + 1;
        const int reps = 1 + (((REP_MASK >> p) & 1) ? REP_N : 0);
        for (int r = 0; r < reps; ++r) { if (r > 0 && (p == PH_ROUTER0 || p == PH_ROUTER1)) (void)hipMemsetAsync((char*)d_ws + WS_CTL + (size_t)CW_CNT * 4, 0, 2 * 32 * 64 * 4, stream);
            hipLaunchKernelGGL(fwd, dim3(grid), dim3(512), LDS_BYTES, stream, a); } }
#endif
}
```

```cpp
#include <hip/hip_runtime.h>
#include <cstdio>
#include <cstdint>

#ifndef MK_SINGLE
#define MK_SINGLE 1
#endif
#ifndef DBG
#define DBG 0
#endif
#ifndef ML_REP
#define ML_REP 1
#endif
#ifndef S5_REP
#define S5_REP 1
#endif
#ifndef CONV_REP
#define CONV_REP 1
#endif
#ifndef KNOB_A
#define KNOB_A 1
#endif
#ifndef KNOB_B
#define KNOB_B 1
#endif
#ifndef KNOB_C
#define KNOB_C 1
#endif
#ifndef REP_MASK
#define REP_MASK 0
#endif
#ifndef REP_N
#define REP_N 2
#endif

#define DI __device__ __forceinline__
#define LAS __attribute__((address_space(3)))
typedef unsigned short bf16_t;
typedef short bf16x8 __attribute__((ext_vector_type(8)));
typedef float f32x4 __attribute__((ext_vector_type(4)));
typedef float f32x2 __attribute__((ext_vector_type(2)));
typedef unsigned u32x4 __attribute__((ext_vector_type(4)));
typedef unsigned u32x2 __attribute__((ext_vector_type(2)));
typedef LAS unsigned char* ldsp;

constexpr int T = 16384, D = 2048, SEQ = 4096, NC = 32;
constexpr int PLD = 6912;
constexpr int N0 = 6672, N1 = 6664;
constexpr int P0_K = 1024, P0_V = 2048, P0_G = 3072, P0_Z = 4096, P0_XBC = 5120, P0_DT = 6656;
constexpr int P1_K = 1536, P1_V = 3072, P1_O = 4608, P1_I = 6144, P1_F = 6148, P1_U = 6152;
constexpr float EPS = 1e-6f;
constexpr int NPHASE = 22;
enum { PH_PRO = 0, PH_INPROJ0, PH_PRE0, PH_LOCAL0, PH_SCAN0, PH_OUT0, PH_OUTPROJ0, PH_ROUTER0, PH_GATEUP0, PH_DOWN0, PH_COMBINE0, PH_INPROJ1, PH_PRE1, PH_LOCAL1, PH_SCAN1, PH_OUT1, PH_GLU, PH_OUTPROJ1, PH_ROUTER1, PH_GATEUP1, PH_DOWN1, PH_COMBINE1 };

constexpr size_t MiB = 1u << 20;
constexpr size_t WS_CTL = 0, CTL_BYTES = 1 * MiB;
constexpr size_t WS_COS = 1 * MiB, WS_SIN = 2 * MiB;
constexpr size_t WS_RT = 3 * MiB;
constexpr size_t WS_S5T = 4 * MiB;
constexpr size_t WS_SMALL = 5 * MiB;
constexpr size_t WS_WIN0 = 8 * MiB, WS_WOUT0 = 35 * MiB, WS_WIN1 = 43 * MiB, WS_WOUT1 = 70 * MiB, WS_WGLU = 78 * MiB;
constexpr size_t WS_WGU = 80 * MiB, WS_WD = 208 * MiB;
constexpr size_t WS_XN = 272 * MiB, WS_MIX = 336 * MiB, WS_HID = 400 * MiB, WS_PROJ = 440 * MiB, WS_Y = WS_PROJ;
constexpr size_t WS_STATE = 656 * MiB;
constexpr size_t WS_RET_DS = WS_STATE, WS_RET_S = WS_STATE + 64 * MiB, WS_SSD_DS = WS_STATE + 96 * MiB, WS_SSD_S = WS_STATE + 160 * MiB;
constexpr size_t WS_MC = WS_STATE;
constexpr size_t WS_MN = WS_STATE + 144 * MiB;
constexpr size_t WS_S5E = WS_STATE + 146 * MiB;
constexpr size_t WS_Y5 = WS_STATE + 150 * MiB;
constexpr size_t WS_LIST = 856 * MiB;
constexpr size_t WS_SLOT = 858 * MiB;
constexpr size_t WS_QC = WS_XN;
constexpr size_t WS_XC = WS_XN;
constexpr size_t WS_ROWS = WS_XN + 48 * MiB;
constexpr size_t WS_KC = 860 * MiB;
constexpr size_t WS_S5K = 908 * MiB;
constexpr size_t WS_S5W = 910 * MiB;
constexpr size_t WS_S5C = 912 * MiB;
constexpr size_t WS_S5G = 913 * MiB;
constexpr size_t WS_H = 929 * MiB;
constexpr size_t WS_RSTD0 = WS_SMALL + (1u << 20) + 65536;
constexpr size_t WS_RSTD1 = WS_SMALL + (1u << 20);
constexpr size_t WS_END = 993 * MiB;
constexpr int CW_BAR = 4096;
constexpr int CW_CNT = 16384;

constexpr int LDS_TAB = 131072;
constexpr int LDS_CTL = 146944;
constexpr int LDS_BYTES = 147456;

typedef __bf16 bf16x2_t __attribute__((ext_vector_type(2)));
DI unsigned pk2(float lo, float hi) { const f32x2 v = {lo, hi}; const bf16x2_t r = __builtin_convertvector(v, bf16x2_t); return __builtin_bit_cast(unsigned, r); }
DI float bflo(unsigned w) { return __uint_as_float(w << 16); }
DI float bfhi(unsigned w) { return __uint_as_float(w & 0xffff0000u); }
DI float bf2f(bf16_t b) { return __uint_as_float(((unsigned)b) << 16); }
DI bf16_t f2bf(float f) { return (bf16_t)(pk2(f, 0.f) & 0xffffu); }
DI float sigmoid_(float x) { return __builtin_amdgcn_rcpf(1.f + __expf(-x)); }
DI float silu_(float x) { return x * sigmoid_(x); }
DI float softplus_(float x) { return x > 20.f ? x : log1pf(__expf(x)); }
DI float logsigmoid_(float x) { return -softplus_(-x); }
DI float gelu_(float x) { const float u = 0.7978845608f * (x + 0.044715f * x * x * x); const float t = 1.f - 2.f * __builtin_amdgcn_rcpf(1.f + __expf(2.f * u)); return 0.5f * x * (1.f + t); }
DI float wsum(float v) {
#pragma unroll
    for (int o = 1; o < 64; o <<= 1) v += __shfl_xor(v, o);
    return v; }
DI float wmax(float v) {
#pragma unroll
    for (int o = 1; o < 64; o <<= 1) v = fmaxf(v, __shfl_xor(v, o));
    return v; }
DI void unpack8(const u32x4 v, float (&f)[8]) { f[0] = bflo(v.x); f[1] = bfhi(v.x); f[2] = bflo(v.y); f[3] = bfhi(v.y); f[4] = bflo(v.z); f[5] = bfhi(v.z); f[6] = bflo(v.w); f[7] = bfhi(v.w); }
DI u32x4 pack8(const float (&f)[8]) { u32x4 o; o.x = pk2(f[0], f[1]); o.y = pk2(f[2], f[3]); o.z = pk2(f[4], f[5]); o.w = pk2(f[6], f[7]); return o; }
#define LDS_WAIT() asm volatile("s_waitcnt lgkmcnt(0)" ::: "memory")
DI void wscan_sum(float a0, float a1, int lane, float& c0, float& c1) {
    const float s = a0 + a1; float x = s;
#pragma unroll
    for (int o = 1; o < 64; o <<= 1) { const float y = __shfl_up(x, o); if (lane >= o) x += y; }
    const float ex = x - s; c0 = ex + a0; c1 = c0 + a1; }
DI void wscan_max(float a0, float a1, int lane, float& c0, float& c1) {
    const float s = fmaxf(a0, a1); float x = s;
#pragma unroll
    for (int o = 1; o < 64; o <<= 1) { const float y = __shfl_up(x, o); if (lane >= o) x = fmaxf(x, y); }
    float ex = __shfl_up(x, 1); if (lane == 0) ex = -INFINITY;
    c0 = fmaxf(ex, a0); c1 = fmaxf(c0, a1); }

namespace pg8 {
constexpr int BM = 256, BK = 64, HALF = 128, HTB = HALF * BK * 2, STAGE_BYTES = 8 * HTB;
DI int lds_byte(int r, int c) { const int st = (r >> 4) * 2 + (c >> 5), rr = r & 15, cc = c & 31, ob = rr * 64 + cc * 2; return st * 1024 + (ob ^ (((ob >> 9) & 1) << 5)); }
DI void stage_rc(int b, int& R, int& C) { const int st = b / 1024, sb = b % 1024, swz = sb ^ (((sb >> 9) & 1) << 5); R = (st >> 1) * 16 + swz / 64; C = (st & 1) * 32 + (swz % 64) / 2; }
DI int perm32(int rho) { const int n = rho >> 4, i = rho & 15; return 8 * (i >> 2) + 4 * n + (i & 3); }
struct Unit { const char* A; const char* B; int row0, col0, aux; };
typedef f32x4 Acc[2][2][4][2];

template <class Epi, class Sched, bool GATHER>
DI void gemm_phase(ldsp lds, const int K, const int lda, const int ldb, const Sched& S, const Epi& E) {
    const int tid = threadIdx.x, wid = __builtin_amdgcn_readfirstlane(tid >> 6), lane = tid & 63, wr = wid >> 2, wc = wid & 3, fr = lane & 15, fq = lane >> 4;
    const int nt = K / BK;
    unsigned voffA[2], voffB[2]; int RA[2], CA[2];
#pragma unroll
    for (int i = 0; i < 2; ++i) { int R, C; stage_rc(tid * 16 + i * 8192, R, C); const int Rb = Epi::PERM ? ((R & ~31) + perm32(R & 31)) : R;
        RA[i] = R; CA[i] = C; voffA[i] = (unsigned)(R * lda + C) * 2u; voffB[i] = (unsigned)(Rb * ldb + C) * 2u; }
    const unsigned hstepA = (unsigned)HALF * (unsigned)lda * 2u, hstepB = (unsigned)HALF * (unsigned)ldb * 2u;
    const size_t kstep = (size_t)(BK * 2);
    const unsigned ldsw = (unsigned)wid * 1024u;
    const int aoff = lds_byte(wr * 64 + fr, fq * 8), boff = lds_byte(wc * 32 + fr, fq * 8);
    unsigned vc[2][2], vn[2][2];
#define PG8_SA(b, h) (((b) * 2 + (h)) * HTB)
#define PG8_SB(b, h) ((4 + (b) * 2 + (h)) * HTB)
#define PG8_AOFF(h, i, NX) (GATHER ? ((NX) ? vn[h][i] : vc[h][i]) : (voffA[i] + (unsigned)(h) * hstepA))
#define PG8_STAGE_A(bufoff, gbase, h, NX) do { _Pragma("unroll") for (int _i = 0; _i < 2; ++_i) \
        __builtin_amdgcn_global_load_lds((const unsigned*)((const char*)(gbase) + PG8_AOFF(h, _i, NX)), (LAS unsigned*)(lds + (bufoff) + ldsw + _i * 8192), 16, 0, 0); } while (0)
#define PG8_STAGE_B(bufoff, gbase) do { _Pragma("unroll") for (int _i = 0; _i < 2; ++_i) \
        __builtin_amdgcn_global_load_lds((const unsigned*)((const char*)(gbase) + voffB[_i]), (LAS unsigned*)(lds + (bufoff) + ldsw + _i * 8192), 16, 0, 0); } while (0)
#define PG8_LDA(dst, b, h) do { _Pragma("unroll") for (int m = 0; m < 4; ++m) _Pragma("unroll") for (int k = 0; k < 2; ++k) dst[m][k] = *(const LAS bf16x8*)(lds + PG8_SA(b, h) + aoff + m * 2048 + k * 1024); } while (0)
#define PG8_LDB(dst, b, h) do { _Pragma("unroll") for (int n = 0; n < 2; ++n) _Pragma("unroll") for (int k = 0; k < 2; ++k) dst[n][k] = *(const LAS bf16x8*)(lds + PG8_SB(b, h) + boff + n * 2048 + k * 1024); } while (0)
#define PG8_MMA(ai, bj, At, Bt) do { __builtin_amdgcn_s_setprio(1); _Pragma("unroll") for (int m = 0; m < 4; ++m) _Pragma("unroll") for (int n = 0; n < 2; ++n) _Pragma("unroll") for (int k = 0; k < 2; ++k) \
        acc[ai][bj][m][n] = __builtin_amdgcn_mfma_f32_16x16x32_bf16(Bt[n][k], At[m][k], acc[ai][bj][m][n], 0, 0, 0); __builtin_amdgcn_s_setprio(0); } while (0)
#define PG8_WAIT_V(n) asm volatile("s_waitcnt vmcnt(" #n ")" ::: "memory")
#define PG8_WAIT_L(n) asm volatile("s_waitcnt lgkmcnt(" #n ")" ::: "memory")
#define PG8_BAR __builtin_amdgcn_s_barrier()
#define PG8_SCHED __builtin_amdgcn_sched_barrier(0)
    Unit cur, nxt; int ui = 0;
    if (!S.next(0, cur)) return;
    Acc acc;
#pragma unroll
    for (int a = 0; a < 2; ++a)
#pragma unroll
        for (int b = 0; b < 2; ++b)
#pragma unroll
            for (int m = 0; m < 4; ++m)
#pragma unroll
                for (int n = 0; n < 2; ++n) acc[a][b][m][n] = (f32x4){0.f, 0.f, 0.f, 0.f};
    bf16x8 At[4][2], B0[2][2], B1[2][2];
    const char* cA = cur.A; const char* cB = cur.B;
    if constexpr (GATHER) {
#pragma unroll
        for (int h = 0; h < 2; ++h)
#pragma unroll
            for (int i = 0; i < 2; ++i) { vc[h][i] = ((unsigned)S.grow(cur, RA[i] + 128 * h) * (unsigned)lda + (unsigned)CA[i]) * 2u; vn[h][i] = vc[h][i]; }
    }
    PG8_STAGE_B(PG8_SB(0, 0), cB); PG8_STAGE_B(PG8_SB(0, 1), cB + hstepB); PG8_STAGE_A(PG8_SA(0, 0), cA, 0, false); PG8_STAGE_A(PG8_SA(0, 1), cA, 1, false);
    if (wr == 1) PG8_BAR;
    PG8_WAIT_V(2); PG8_BAR;
    PG8_STAGE_B(PG8_SB(1, 0), cB + kstep); PG8_STAGE_A(PG8_SA(1, 0), cA + kstep, 0, false); PG8_STAGE_B(PG8_SB(1, 1), cB + hstepB + kstep);
    PG8_WAIT_V(6); PG8_BAR;
    for (;;) {
        const bool has_next = S.next(ui + 1, nxt);
        const char* nA = has_next ? nxt.A : cA; const char* nB = has_next ? nxt.B : cB;
        if constexpr (GATHER) {
            if (has_next) {
#pragma unroll
                for (int h = 0; h < 2; ++h)
#pragma unroll
                    for (int i = 0; i < 2; ++i) vn[h][i] = ((unsigned)S.grow(nxt, RA[i] + 128 * h) * (unsigned)lda + (unsigned)CA[i]) * 2u;
            }
        }
        for (int t = 0; t < nt; t += 2) {
            const bool last = (t == nt - 2);
            const char* a1 = cA + (size_t)(t + 1) * kstep;
            const char* a2 = last ? nA : cA + (size_t)(t + 2) * kstep; const char* b2 = last ? nB : cB + (size_t)(t + 2) * kstep;
            const char* a3 = a2 + kstep; const char* b3 = b2 + kstep;
            PG8_LDB(B0, 0, 0); PG8_LDB(B1, 0, 1); PG8_SCHED; PG8_LDA(At, 0, 0); PG8_STAGE_A(PG8_SA(1, 1), a1, 1, false);
            PG8_WAIT_V(8); PG8_WAIT_L(0); PG8_BAR; PG8_MMA(0, 0, At, B0); PG8_MMA(0, 1, At, B1); PG8_BAR; PG8_SCHED;
            PG8_LDA(At, 0, 1); PG8_STAGE_B(PG8_SB(0, 0), b2); PG8_STAGE_B(PG8_SB(0, 1), b2 + hstepB); PG8_STAGE_A(PG8_SA(0, 0), a2, 0, last);
            PG8_WAIT_V(8); PG8_WAIT_L(0); PG8_BAR; PG8_MMA(1, 0, At, B0); PG8_MMA(1, 1, At, B1); PG8_BAR; PG8_SCHED;
            PG8_LDB(B0, 1, 0); PG8_LDB(B1, 1, 1); PG8_SCHED; PG8_LDA(At, 1, 0); PG8_STAGE_A(PG8_SA(0, 1), a2, 1, last);
            PG8_WAIT_V(8); PG8_WAIT_L(0); PG8_BAR; PG8_MMA(0, 0, At, B0); PG8_MMA(0, 1, At, B1); PG8_BAR; PG8_SCHED;
            PG8_LDA(At, 1, 1); PG8_STAGE_B(PG8_SB(1, 0), b3); PG8_STAGE_B(PG8_SB(1, 1), b3 + hstepB); PG8_STAGE_A(PG8_SA(1, 0), a3, 0, last);
            PG8_WAIT_V(8); PG8_WAIT_L(0); PG8_BAR; PG8_MMA(1, 0, At, B0); PG8_MMA(1, 1, At, B1); PG8_BAR; PG8_SCHED;
        }
        if (wr == 0) PG8_BAR;
        E(acc, cur, wr, wc, fr, fq);
        if (!has_next) break;
#pragma unroll
        for (int a = 0; a < 2; ++a)
#pragma unroll
            for (int b = 0; b < 2; ++b)
#pragma unroll
                for (int m = 0; m < 4; ++m)
#pragma unroll
                    for (int n = 0; n < 2; ++n) acc[a][b][m][n] = (f32x4){0.f, 0.f, 0.f, 0.f};
        cur = nxt; cA = nA; cB = nB; ++ui;
        if constexpr (GATHER) {
#pragma unroll
            for (int h = 0; h < 2; ++h)
#pragma unroll
                for (int i = 0; i < 2; ++i) vc[h][i] = vn[h][i];
        }
        if (wr == 1) PG8_BAR;
    }
    PG8_WAIT_V(0);
    PG8_BAR;
#undef PG8_SA
#undef PG8_SB
#undef PG8_AOFF
#undef PG8_STAGE_A
#undef PG8_STAGE_B
#undef PG8_LDA
#undef PG8_LDB
#undef PG8_MMA
#undef PG8_WAIT_V
#undef PG8_WAIT_L
#undef PG8_BAR
#undef PG8_SCHED
}

struct Tile2D {
    const char* A; const char* B; int nM, nN, nwg, G, c; size_t tA, tB;
    DI void init(const void* A_, const void* B_, int M, int N, int lda, int ldb, int G_, int c_) { A = (const char*)A_; B = (const char*)B_; nM = M / 256; nN = N / 256; nwg = nM * nN; G = G_; c = c_; tA = (size_t)256 * lda * 2; tB = (size_t)256 * ldb * 2; }
    DI bool next(int i, Unit& u) const {
        const long L = (long)i * G + c; if (L >= nwg) return false;
        int wgid = (int)L; { const int q = nwg / 8, r = nwg % 8, xcd = wgid % 8, off = wgid / 8; wgid = (xcd < r ? xcd * (q + 1) : r * (q + 1) + (xcd - r) * q) + off; }
        const int nig = 8 * nN, gid = wgid / nig, fm = gid * 8, gsz = (nM - fm) < 8 ? (nM - fm) : 8;
        const int pm = fm + ((wgid % nig) % gsz), pn = (wgid % nig) / gsz;
        u.A = A + (size_t)pm * tA; u.B = B + (size_t)pn * tB; u.row0 = pm * 256; u.col0 = pn * 256; u.aux = 0; return true;
    }
    DI int grow(const Unit&, int) const { return 0; }
};
struct GluOrder { Tile2D t; DI bool next(int i, Unit& u) const { if (!t.next(i, u)) return false; u.col0 >>= 1; return true; } DI int grow(const Unit&, int) const { return 0; } };
struct MoeGU {
    const char* XN; const char* W; const LAS int* tile_e; const LAS int* gtab; int nunits, G, c;
    DI bool next(int i, Unit& u) const {
        const int L = i * G + c; if (L >= nunits || i >= 4) return false;
        const int gm = L >> 2, j = L & 3, e = tile_e[gm];
        u.A = XN; u.B = W + ((size_t)e * 1024 + (size_t)j * 256) * 2048 * 2; u.row0 = gm * 256; u.col0 = j * 128; u.aux = i; return true;
    }
    DI int grow(const Unit& u, int r) const { return gtab[u.aux * 256 + r]; }
};
struct MoeDown {
    const char* HID; const char* W; const LAS int* tile_e; int nunits, G, c;
    DI bool next(int i, Unit& u) const {
        const int L = i * G + c; if (L >= nunits) return false;
        const int gm = L >> 3, pn = L & 7, e = tile_e[gm];
        u.A = HID + (size_t)gm * 256 * 512 * 2; u.B = W + ((size_t)e * 2048 + (size_t)pn * 256) * 512 * 2; u.row0 = gm * 256; u.col0 = pn * 256; u.aux = e; return true;
    }
    DI int grow(const Unit&, int) const { return 0; }
};

struct EpiBf16 {
    static constexpr bool PERM = true;
    bf16_t* O; int ldc;
    DI void operator()(const Acc& acc, const Unit& u, int wr, int wc, int fr, int fq) const {
#pragma unroll
        for (int ai = 0; ai < 2; ++ai)
#pragma unroll
            for (int m = 0; m < 4; ++m) { bf16_t* rowp = O + (size_t)(u.row0 + ai * HALF + wr * 64 + m * 16 + fr) * ldc + u.col0 + wc * 32 + 8 * fq;
#pragma unroll
                for (int bj = 0; bj < 2; ++bj) { const f32x4 v0 = acc[ai][bj][m][0], v1 = acc[ai][bj][m][1];
                    u32x4 w; w.x = pk2(v0[0], v0[1]); w.y = pk2(v0[2], v0[3]); w.z = pk2(v1[0], v1[1]); w.w = pk2(v1[2], v1[3]);
                    *(u32x4*)(rowp + bj * HALF) = w; } }
    }
};
struct EpiBf16S {
    static constexpr bool PERM = true;
    bf16_t* O; int ldc; const float* rs;
    DI void operator()(const Acc& acc, const Unit& u, int wr, int wc, int fr, int fq) const {
#pragma unroll
        for (int ai = 0; ai < 2; ++ai)
#pragma unroll
            for (int m = 0; m < 4; ++m) { const int row = u.row0 + ai * HALF + wr * 64 + m * 16 + fr; const float r = rs[row]; bf16_t* rowp = O + (size_t)row * ldc + u.col0 + wc * 32 + 8 * fq;
#pragma unroll
                for (int bj = 0; bj < 2; ++bj) { const f32x4 v0 = acc[ai][bj][m][0] * r, v1 = acc[ai][bj][m][1] * r;
                    u32x4 w; w.x = pk2(v0[0], v0[1]); w.y = pk2(v0[2], v0[3]); w.z = pk2(v1[0], v1[1]); w.w = pk2(v1[2], v1[3]);
                    *(u32x4*)(rowp + bj * HALF) = w; } }
    }
};
template <bool RES_BF16> struct EpiResBf16 {
    static constexpr bool PERM = true;
    const void* res; bf16_t* out; int ldc;
    DI void operator()(const Acc& acc, const Unit& u, int wr, int wc, int fr, int fq) const {
#pragma unroll
        for (int ai = 0; ai < 2; ++ai)
#pragma unroll
            for (int m = 0; m < 4; ++m) { const size_t off = (size_t)(u.row0 + ai * HALF + wr * 64 + m * 16 + fr) * ldc + u.col0 + wc * 32 + 8 * fq;
#pragma unroll
                for (int bj = 0; bj < 2; ++bj) { float r[8];
                    if constexpr (RES_BF16) unpack8(*(const u32x4*)((const bf16_t*)res + off + bj * HALF), r);
                    else { const f32x4 r0 = *(const f32x4*)((const float*)res + off + bj * HALF), r1 = *(const f32x4*)((const float*)res + off + bj * HALF + 4); r[0] = r0[0]; r[1] = r0[1]; r[2] = r0[2]; r[3] = r0[3]; r[4] = r1[0]; r[5] = r1[1]; r[6] = r1[2]; r[7] = r1[3]; }
                    const f32x4 v0 = acc[ai][bj][m][0], v1 = acc[ai][bj][m][1];
                    u32x4 w; w.x = pk2(r[0] + v0[0], r[1] + v0[1]); w.y = pk2(r[2] + v0[2], r[3] + v0[3]); w.z = pk2(r[4] + v1[0], r[5] + v1[1]); w.w = pk2(r[6] + v1[2], r[7] + v1[3]);
                    *(u32x4*)(out + off + bj * HALF) = w; } }
    }
};
struct EpiGateUp {
    static constexpr bool PERM = true;
    bf16_t* O; int ldc; const LAS int* gtab; const float* rstd;
    DI void operator()(const Acc& acc, const Unit& u, int wr, int wc, int fr, int fq) const {
#pragma unroll
        for (int ai = 0; ai < 2; ++ai)
#pragma unroll
            for (int m = 0; m < 4; ++m) { const int r = ai * HALF + wr * 64 + m * 16 + fr; bf16_t* rowp = O + (size_t)(u.row0 + r) * ldc + u.col0 + wc * 32 + 8 * fq;
                const float rs = rstd[gtab[u.aux * 256 + r]];
                float o[8];
#pragma unroll
                for (int n = 0; n < 2; ++n)
#pragma unroll
                    for (int j = 0; j < 4; ++j) o[n * 4 + j] = silu_(acc[ai][0][m][n][j] * rs) * (acc[ai][1][m][n][j] * rs);
                *(u32x4*)rowp = pack8(o); }
    }
};
struct EpiGlu {
    static constexpr bool PERM = true;
    bf16_t* O; int ldc; const float* bias;
    DI void operator()(const Acc& acc, const Unit& u, int wr, int wc, int fr, int fq) const {
        const int cb = u.col0 + wc * 32 + 8 * fq;
        float bv[8], bg[8];
#pragma unroll
        for (int j = 0; j < 8; ++j) { bv[j] = bias[cb + j]; bg[j] = bias[512 + cb + j]; }
#pragma unroll
        for (int ai = 0; ai < 2; ++ai)
#pragma unroll
            for (int m = 0; m < 4; ++m) { bf16_t* rowp = O + (size_t)(u.row0 + ai * HALF + wr * 64 + m * 16 + fr) * ldc + cb;
                float o[8];
#pragma unroll
                for (int n = 0; n < 2; ++n)
#pragma unroll
                    for (int j = 0; j < 4; ++j) o[n * 4 + j] = (acc[ai][0][m][n][j] + bv[n * 4 + j]) * sigmoid_(acc[ai][1][m][n][j] + bg[n * 4 + j]);
                *(u32x4*)rowp = pack8(o); }
    }
};
}

#define XB_TMO      128
#define XB_XCNT(j)  (256  + 64 * (j))
#define XB_XSUB(j)  (1280 + 64 * (j))
#define XB_XGEN(j)  (2304 + 64 * (j))
#define XB_TOP      3328
#define XB_TOPGEN   3392
#define XCD_BAR_WORDS 3456
#define XB_SPIN_CAP (1u << 18)
__device__ __forceinline__ unsigned xb_ld(unsigned* p)              { return __hip_atomic_load(p, __ATOMIC_RELAXED, __HIP_MEMORY_SCOPE_AGENT); }
__device__ __forceinline__ unsigned xb_add(unsigned* p, unsigned v) { return __hip_atomic_fetch_add(p, v, __ATOMIC_RELAXED, __HIP_MEMORY_SCOPE_AGENT); }
__device__ __forceinline__ unsigned xb_xcc_id() { return (unsigned)__builtin_amdgcn_s_getreg((3 << 11) | 20) & 0xFu; }
#define XB_SPIN(cond, bar) do { unsigned _sp = 0; while (cond) { __builtin_amdgcn_s_sleep(1); \
    if ((++_sp & 255u) == 0u) { if (xb_ld(&(bar)[XB_TMO])) break; if (_sp > XB_SPIN_CAP) { atomicAdd(&(bar)[XB_TMO], 1u); break; } } } } while (0)
struct XcdBarrier { unsigned* bar; unsigned x; volatile LAS unsigned* st; };
__device__ __forceinline__ XcdBarrier xcd_barrier_post(unsigned* bar, volatile LAS unsigned* st) {
    XcdBarrier b; b.bar = bar; b.x = xb_xcc_id(); b.st = st;
    if (threadIdx.x == 0) (void)xb_add(&bar[XB_XCNT(b.x)], 1u);
    return b;
}
__device__ __forceinline__ void xcd_barrier_complete(unsigned* bar, unsigned x, unsigned& nloc, unsigned& nx) {
    const unsigned G = gridDim.x * gridDim.y * gridDim.z;
    unsigned sum, cnt, mine, sp = 0u;
    for (;;) {
        sum = 0u; cnt = 0u; mine = 0u;
#pragma unroll
        for (unsigned j = 0; j < 16; ++j) { const unsigned c = xb_ld(&bar[XB_XCNT(j)]); sum += c; cnt += (c > 0u) ? 1u : 0u; mine = (j == x) ? c : mine; }
        if (sum == G) break;
        __builtin_amdgcn_s_sleep(1);
        if ((++sp & 255u) == 0u) { if (xb_ld(&bar[XB_TMO])) break; if (sp > XB_SPIN_CAP) { atomicAdd(&bar[XB_TMO], 1u); break; } }
    }
    nloc = mine > 0u ? mine : 1u; nx = cnt > 0u ? cnt : 1u;
}
__device__ __forceinline__ void xcd_barrier(const XcdBarrier& b) {
    asm volatile("s_waitcnt vmcnt(0)" ::: "memory");
    __syncthreads();
    if (threadIdx.x == 0) {
        unsigned* bar = b.bar;
        __builtin_amdgcn_s_waitcnt(0);
        unsigned nloc = b.st[0], nx = b.st[1];
        if (nloc == 0u) { xcd_barrier_complete(bar, b.x, nloc, nx); b.st[0] = nloc; b.st[1] = nx; }
        const unsigned old = xb_add(&bar[XB_XSUB(b.x)], 1u);
        const unsigned gen = old / nloc;
        if (old + 1u == (gen + 1u) * nloc) {
            __builtin_amdgcn_fence(__ATOMIC_RELEASE, "agent");
            asm volatile("s_waitcnt vmcnt(0)" ::: "memory");
            const unsigned og = xb_add(&bar[XB_TOP], 1u);
            const unsigned tg = og / nx;
            if (og + 1u == (tg + 1u) * nx) xb_add(&bar[XB_TOPGEN], 1u);
            else XB_SPIN(xb_ld(&bar[XB_TOPGEN]) == tg, bar);
            __builtin_amdgcn_fence(__ATOMIC_ACQUIRE, "agent");
            xb_add(&bar[XB_XGEN(b.x)], 1u);
            asm volatile("s_waitcnt vmcnt(0)" ::: "memory");
        } else {
            XB_SPIN(xb_ld(&bar[XB_XGEN(b.x)]) == gen, bar);
            __builtin_amdgcn_fence(__ATOMIC_ACQUIRE, "agent");
            asm volatile("s_waitcnt vmcnt(0)" ::: "memory");
        }
    }
    __syncthreads();
}

struct Args { const float* in[38]; float* out; unsigned char* ws; int ph_lo, ph_hi; };
enum { I_X = 0, I_EVEN_NORM, I_EVEN_WIN, I_RET_NORM, I_SSD_CONVW, I_SSD_CONVB, I_SSD_DTB, I_SSD_ALOG, I_SSD_D, I_SSD_NORM, I_EVEN_WOUT, I_ODD_NORM, I_ODD_WIN, I_ML_CONVW, I_ML_CONVB,
       I_ML_IB, I_ML_FB, I_ML_NORM, I_S5_ARE, I_S5_AIM, I_S5_LOGDT, I_S5_BRE, I_S5_BIM, I_S5_CRE, I_S5_CIM, I_S5_D, I_S5_WGLU, I_S5_BGLU, I_ODD_WOUT, I_MOE_NORM, I_MOE_RG, I_MOE_RGB,
       I_MOE_RE, I_MOE_REB, I_MOE_WG, I_MOE_WU, I_MOE_WD, I_FINAL_NORM };

struct Frame { ldsp lds; int tid, lane, wave, G, bx; unsigned char* ws; };

DI int permb_row(int nt, int i) { return 64 * (nt >> 2) + 16 * (i >> 2) + 4 * (nt & 3) + (i & 3); }
DI int permb_off(int nt) { return (nt >> 2) * 128 + (nt & 3) * 8; }
DI int tr_lane_off_p(int lane, int pitch) { return (8 * (lane >> 4) + ((lane & 15) >> 2)) * pitch + (lane & 3) * 32; }
template <int NT, int KS, bool PERMB = false>
DI void mma16(f32x4 (&acc)[NT], ldsp Arows, int pitchA, ldsp Bt, int pitchB, int fr, int fq, int nt_lim = NT, int ks_lim = KS) {
    constexpr int NB = NT < 8 ? NT : 8;
#pragma unroll
    for (int ks = 0; ks < KS; ++ks) {
        if (ks < ks_lim) {
            const bf16x8 a = *(const LAS bf16x8*)(Arows + fr * pitchA + (ks * 32 + fq * 8) * 2);
#pragma unroll
            for (int n0 = 0; n0 < NT; n0 += NB) {
                if (n0 < nt_lim) {
                    bf16x8 b[NB];
#pragma unroll
                    for (int i = 0; i < NB; ++i) b[i] = *(const LAS bf16x8*)(Bt + (PERMB ? permb_row(n0 + i, fr) : ((n0 + i) * 16 + fr)) * pitchB + (ks * 32 + fq * 8) * 2);
#pragma unroll
                    for (int i = 0; i < NB; ++i) acc[n0 + i] = __builtin_amdgcn_mfma_f32_16x16x32_bf16(b[i], a, acc[n0 + i], 0, 0, 0);
                }
            }
        }
    }
}
typedef short s16x4 __attribute__((ext_vector_type(4)));
DI int tr_lane_off(int lane, int pitch) { return (8 * (lane >> 4) + ((lane & 15) >> 2)) * pitch + (lane & 3) * 8; }
DI bf16x8 tr_frag(ldsp trb, int off, int pitch) {
    const s16x4 v0 = __builtin_amdgcn_ds_read_tr16_b64_v4i16((LAS s16x4*)(trb + off)), v1 = __builtin_amdgcn_ds_read_tr16_b64_v4i16((LAS s16x4*)(trb + off + 4 * pitch));
    return __builtin_shufflevector(v0, v1, 0, 1, 2, 3, 4, 5, 6, 7);
}
template <int NT> DI void zero_acc(f32x4 (&acc)[NT]) {
#pragma unroll
    for (int i = 0; i < NT; ++i) acc[i] = (f32x4){0.f, 0.f, 0.f, 0.f}; }

DI void conv8(const bf16_t* P, int pos, const float* cw, int C, const float* cb, float (&y)[8]) {
    const f32x4 b0 = *(const f32x4*)cb, b1 = *(const f32x4*)(cb + 4);
    y[0] = b0[0]; y[1] = b0[1]; y[2] = b0[2]; y[3] = b0[3]; y[4] = b1[0]; y[5] = b1[1]; y[6] = b1[2]; y[7] = b1[3];
#pragma unroll
    for (int tap = 0; tap < 4; ++tap) {
        if (pos - 3 + tap >= 0) {
            const u32x4 xv = *(const u32x4*)(P + (ptrdiff_t)(tap - 3) * PLD); float x[8]; unpack8(xv, x);
            const f32x4 w0 = *(const f32x4*)(cw + tap * C), w1 = *(const f32x4*)(cw + tap * C + 4);
            y[0] += w0[0] * x[0]; y[1] += w0[1] * x[1]; y[2] += w0[2] * x[2]; y[3] += w0[3] * x[3];
            y[4] += w1[0] * x[4]; y[5] += w1[1] * x[5]; y[6] += w1[2] * x[6]; y[7] += w1[3] * x[7];
        }
    }
}

#ifndef TS_BLOCK
#define TS_BLOCK 100
#endif
#ifndef TS_SEL
#define TS_SEL 0
#endif
#ifndef TS_SCALE
#define TS_SCALE 10.f
#endif
constexpr size_t WS_TS = WS_SMALL + 200704;
#if DBG == 40
#define TSTAMP(k) do { if (blockIdx.x == TS_BLOCK && threadIdx.x == 0) ((unsigned long long*)(F.ws + WS_TS))[k] = __builtin_amdgcn_s_memrealtime(); } while (0)
#else
#define TSTAMP(k) do {} while (0)
#endif
struct TrItem { const float* W; int N; bf16_t* WT; int ldt, k0, n0, drow0; const float* gain; };
DI void tr_load(const TrItem& t, int lane, float (&r)[32]) {
    const int n = t.n0 + 4 * (lane & 7);
#pragma unroll
    for (int i = 0; i < 8; ++i) { const int kk = 8 * i + (lane >> 3); f32x4 v = (f32x4){0.f, 0.f, 0.f, 0.f}; if (n < t.N) v = __builtin_nontemporal_load((const f32x4*)(t.W + (size_t)(t.k0 + kk) * t.N + n));
        r[4 * i] = v[0]; r[4 * i + 1] = v[1]; r[4 * i + 2] = v[2]; r[4 * i + 3] = v[3]; }
}
DI void tr_finish(const TrItem& t, LAS float* scr, int lane, const float (&r)[32]) {
#pragma unroll
    for (int i = 0; i < 8; ++i) { const int kk = 8 * i + (lane >> 3);
#pragma unroll
        for (int j = 0; j < 4; ++j) scr[kk * 33 + 4 * (lane & 7) + j] = r[4 * i + j]; }
    LDS_WAIT();
    const int c = lane & 7;
    f32x4 g0 = (f32x4){1.f, 1.f, 1.f, 1.f}, g1 = g0; if (t.gain) { g0 = *(const f32x4*)(t.gain + t.k0 + 8 * c); g1 = *(const f32x4*)(t.gain + t.k0 + 8 * c + 4); }
#pragma unroll
    for (int j = 0; j < 4; ++j) { const int nn = (lane >> 3) + 8 * j; const LAS float* s = scr + (8 * c) * 33 + nn;
        u32x4 o; o.x = pk2(s[0 * 33] * g0[0], s[1 * 33] * g0[1]); o.y = pk2(s[2 * 33] * g0[2], s[3 * 33] * g0[3]); o.z = pk2(s[4 * 33] * g1[0], s[5 * 33] * g1[1]); o.w = pk2(s[6 * 33] * g1[2], s[7 * 33] * g1[3]);
        *(u32x4*)(t.WT + (size_t)(t.drow0 + nn) * t.ldt + t.k0 + 8 * c) = o; }
    LDS_WAIT();
}
template <class MakeItem>
DI void tr_stream(int first, int end, int stride, LAS float* scr, int lane, const MakeItem& mk) {
    if (first >= end) return;
    float ra[32], rb[32], rc[32]; TrItem ta = mk(first), tb = ta, tc = ta; tr_load(ta, lane, ra);
    if (first + stride < end) { tb = mk(first + stride); tr_load(tb, lane, rb); }
    for (int it = first; it < end; it += 3 * stride) {
        if (it + 2 * stride < end) { tc = mk(it + 2 * stride); tr_load(tc, lane, rc); }
        tr_finish(ta, scr, lane, ra);
        if (it + stride >= end) break;
        if (it + 3 * stride < end) { ta = mk(it + 3 * stride); tr_load(ta, lane, ra); }
        tr_finish(tb, scr, lane, rb);
        if (it + 2 * stride >= end) break;
        if (it + 4 * stride < end) { tb = mk(it + 4 * stride); tr_load(tb, lane, rb); }
        tr_finish(tc, scr, lane, rc);
    }
}
DI void moe_convert(const Frame& F, const Args& a, int layer, int it_lo, int it_hi, int wi, int nw) {
    LAS float* scr = (LAS float*)(F.lds + F.wave * 16384);
    const int gw = wi * 8 + F.wave, NGW = nw * 8;
    bf16_t* Wgu = (bf16_t*)(F.ws + WS_WGU); bf16_t* Wd = (bf16_t*)(F.ws + WS_WD);
    const float* wg = a.in[I_MOE_WG]; const float* wu = a.in[I_MOE_WU]; const float* wd = a.in[I_MOE_WD]; const float* gn = a.in[I_MOE_NORM] + layer * 2048;
    tr_stream(it_lo + gw, it_hi, NGW, scr, F.lane, [&](int it) { TrItem t;
        const int mat = it >> 14, r = it & 16383, e = r >> 9, q = r & 511;
        if (mat < 2) { const int kb = q >> 4, nb = q & 15, n0 = nb * 32;
            t.W = (mat == 0 ? wg : wu) + (size_t)(layer * 32 + e) * 2048 * 512; t.N = 512; t.WT = Wgu + (size_t)e * 1024 * 2048; t.ldt = 2048; t.k0 = kb * 64; t.n0 = n0; t.drow0 = (n0 >> 7) * 256 + (mat ? 128 : 0) + (n0 & 127); t.gain = gn;
        } else { const int kb = q >> 6, nb = q & 63, n0 = nb * 32;
            t.W = wd + (size_t)(layer * 32 + e) * 512 * 2048; t.N = 2048; t.WT = Wd + (size_t)e * 2048 * 512; t.ldt = 512; t.k0 = kb * 64; t.n0 = n0; t.drow0 = n0; t.gain = nullptr; }
        return t; });
}
constexpr int MOE_CV_SPLIT = 26624;
DI void inproj_tail_convert(const Frame& F, const Args& a, int layer) {
    const int rem = ((T / 256) * (PLD / 256)) % F.G; __syncthreads();
    int wi = F.bx, nw = F.G; if (rem != 0) { if (F.bx < rem) return; wi = F.bx - rem; nw = F.G - rem; }
    moe_convert(F, a, layer, MOE_CV_SPLIT, 32768, wi, nw);
    { LAS float* scr = (LAS float*)(F.lds + F.wave * 16384); const float* wo = a.in[layer ? I_ODD_WOUT : I_EVEN_WOUT]; const float* wgl = a.in[I_S5_WGLU];
      bf16_t* Wout = (bf16_t*)(F.ws + (layer ? WS_WOUT1 : WS_WOUT0)); bf16_t* Wglu = (bf16_t*)(F.ws + WS_WGLU);
      tr_stream(wi * 8 + F.wave, 2048 + (layer ? 256 : 0), nw * 8, scr, F.lane, [&](int it) { TrItem t; int r = it; t.gain = nullptr;
        if (r < 2048) { t.W = wo; t.N = 2048; t.WT = Wout; t.ldt = 2048; t.k0 = (r >> 6) * 64; t.n0 = (r & 63) * 32; t.drow0 = t.n0; return t; } r -= 2048;
        { const int kb = r >> 5, nb = r & 31, n0 = nb * 32, nn = n0 & 511; t.W = wgl; t.N = 1024; t.WT = Wglu; t.ldt = 512; t.k0 = kb * 64; t.n0 = n0; t.drow0 = (nn >> 7) * 256 + (n0 >= 512 ? 128 : 0) + (nn & 127); }
        return t; }); }
}
DI void norm_row_bf16(const float* xr, const float* g, bf16_t* o, int lane) {
    f32x4 v[8]; float ss = 0.f;
#pragma unroll
    for (int j = 0; j < 8; ++j) { v[j] = *(const f32x4*)(xr + (lane + 64 * j) * 4); ss += v[j][0] * v[j][0] + v[j][1] * v[j][1] + v[j][2] * v[j][2] + v[j][3] * v[j][3]; }
    const float rstd = rsqrtf(wsum(ss) * (1.f / D) + EPS);
#pragma unroll
    for (int j = 0; j < 8; ++j) { const f32x4 gg = *(const f32x4*)(g + (lane + 64 * j) * 4);
        u32x2 w; w.x = pk2(v[j][0] * rstd * gg[0], v[j][1] * rstd * gg[1]); w.y = pk2(v[j][2] * rstd * gg[2], v[j][3] * rstd * gg[3]);
        *(u32x2*)(o + (lane + 64 * j) * 4) = w; }
}
DI void phase_prologue(const Frame& F, const Args& a) {
    LAS float* scr = (LAS float*)(F.lds + F.wave * 16384);
    const int gw = F.bx * 8 + F.wave, NGW = F.G * 8;
    bf16_t* Win0 = (bf16_t*)(F.ws + WS_WIN0); bf16_t* Wout0 = (bf16_t*)(F.ws + WS_WOUT0); bf16_t* Win1 = (bf16_t*)(F.ws + WS_WIN1); bf16_t* Wout1 = (bf16_t*)(F.ws + WS_WOUT1); bf16_t* Wglu = (bf16_t*)(F.ws + WS_WGLU);
    constexpr int I_IN = 32 * 209, I_OUT = 32 * 64, I_GLU = 8 * 32;
    { const float* win0 = a.in[I_EVEN_WIN]; const float* win1 = a.in[I_ODD_WIN]; const float* wo0 = a.in[I_EVEN_WOUT]; const float* wo1 = a.in[I_ODD_WOUT]; const float* wgl = a.in[I_S5_WGLU];
      const float* g0 = a.in[I_EVEN_NORM]; const float* g1 = a.in[I_ODD_NORM];
      tr_stream(gw, 2 * I_IN, NGW, scr, F.lane, [&](int it) { TrItem t; int r = it; t.gain = nullptr;
        if (r < I_IN) { t.W = win0; t.N = N0; t.WT = Win0; t.ldt = 2048; t.k0 = (r / 209) * 64; t.n0 = (r % 209) * 32; t.drow0 = t.n0; t.gain = g0; return t; } r -= I_IN;
        t.W = win1; t.N = N1; t.WT = Win1; t.ldt = 2048; t.k0 = (r / 209) * 64; t.n0 = (r % 209) * 32; t.drow0 = t.n0; t.gain = g1; return t; }); (void)wo0; (void)wo1; (void)wgl; (void)Wout0; (void)Wout1; (void)Wglu; (void)I_OUT; (void)I_GLU; }
    moe_convert(F, a, 0, 0, MOE_CV_SPLIT, F.bx, F.G);
    const int gt = F.bx * 512 + F.tid, NT_ = F.G * 512;
    for (int r2_ = 0; r2_ < KNOB_B; ++r2_) {
    for (int i = gt; i < 2 * 224 * 256; i += NT_) { const int l = i / (224 * 256), r = i % (224 * 256); *(u32x4*)((l ? Win1 : Win0) + (size_t)6688 * 2048 + (size_t)r * 8) = (u32x4){0u, 0u, 0u, 0u}; }
    float* COS = (float*)(F.ws + WS_COS); float* SIN = (float*)(F.ws + WS_SIN);
    bf16_t* RTH = (bf16_t*)(F.ws + WS_RT); bf16_t* RTL = (bf16_t*)(F.ws + WS_RT + 512 * 1024);
    { f32x2* A128 = (f32x2*)(F.ws + WS_S5T) + 2048; bf16_t* KERN = (bf16_t*)(F.ws + WS_S5K); f32x2* WT = (f32x2*)(F.ws + WS_S5W); bf16_t* CT = (bf16_t*)(F.ws + WS_S5C); bf16_t* GT = (bf16_t*)(F.ws + WS_S5G);
      const float* ARE = a.in[I_S5_ARE]; const float* AIM = a.in[I_S5_AIM]; const float* LDT = a.in[I_S5_LOGDT];
      auto a128_rows = [&](int st, int NS) {
          for (int i = st; i < 2048; i += NS) { const int g = i >> 6; const double dt = exp((double)LDT[g]), are = ARE[i], aim = AIM[i]; const double m128 = exp(128.0 * are * dt);
              A128[i] = (f32x2){(float)(m128 * cos(128.0 * aim * dt)), (float)(m128 * sin(128.0 * aim * dt))}; } };
      auto side_tables = [&](int st, int NS) {
          for (int i = st; i < 4096 * 64; i += NS) { const int pos = i >> 6, k = i & 63; const float inv = 1.0f / powf(10000.f, (float)(2 * k) / 128.f); const float ang = (float)pos * inv; COS[i] = cosf(ang); SIN[i] = sinf(ang); }
          for (int i = st; i < 2 * 48 * 2048; i += NS) { const int l = i / (48 * 2048), r = i % (48 * 2048), j = r >> 11, k = r & 2047; const float g = a.in[I_MOE_NORM][l * 2048 + k];
              float w = 0.f; if (j < 4) w = a.in[I_MOE_RG][(size_t)(l * 2048 + k) * 4 + j]; else if (j < 36) w = a.in[I_MOE_RE][(size_t)(l * 2048 + k) * 32 + (j - 4)];
              const float v = g * w; const bf16_t hi = f2bf(v); RTH[i] = hi; RTL[i] = f2bf(v - bf2f(hi)); } };
      { LAS float* PWr = (LAS float*)F.lds; LAS float* PWi = PWr + 2048; LAS float* BBr = PWr + 4096; LAS float* BBi = PWr + 5120; LAS float* Cr = PWr + 6144; LAS float* Ci = PWr + 7200;
        bool side_todo = true;
        for (int kt = F.bx; kt < 256; kt += F.G) { const int g = kt >> 3, tb = kt & 7; const float dt = __expf(LDT[g]);
            __syncthreads();
            for (int i = F.tid; i < 1024; i += 512) { const int n = i & 63, gn = g * 64 + n; const float tau = (float)(tb * 16 + (i >> 6)), pm = __expf(ARE[gn] * dt * tau); PWr[(i >> 6) * 65 + n] = pm * cosf(AIM[gn] * dt * tau); PWi[(i >> 6) * 65 + n] = pm * sinf(AIM[gn] * dt * tau); }
            for (int i = F.tid; i < 1024; i += 512) { const int n = i >> 4, q = i & 15, gn = g * 64 + n; const float are = ARE[gn], aim = AIM[gn];
                const float mg = __expf(are * dt), br = mg * cosf(aim * dt), bi = mg * sinf(aim * dt), den = are * are + aim * aim, nr = br - 1.f;
                const float cr = (nr * are + bi * aim) / den, ci = (bi * are - nr * aim) / den; const float bre = a.in[I_S5_BRE][(size_t)gn * 16 + q], bim = a.in[I_S5_BIM][(size_t)gn * 16 + q];
                BBr[i] = cr * bre - ci * bim; BBi[i] = cr * bim + ci * bre; }
            for (int i = F.tid; i < 1024; i += 512) { Cr[(i >> 6) * 65 + (i & 63)] = a.in[I_S5_CRE][(size_t)g * 1024 + i]; Ci[(i >> 6) * 65 + (i & 63)] = a.in[I_S5_CIM][(size_t)g * 1024 + i]; }
            __syncthreads();
            if (F.tid < 256) {
                const int tl = F.tid >> 4, c = F.tid & 15;
                float acc[16];
#pragma unroll
                for (int q = 0; q < 16; ++q) acc[q] = 0.f;
                for (int n = 0; n < 64; ++n) { const float c_re = Cr[c * 65 + n], c_im = Ci[c * 65 + n], pr = PWr[tl * 65 + n], pi = PWi[tl * 65 + n];
                    const float tr = c_re * pr - c_im * pi, ti = c_re * pi + c_im * pr;
#pragma unroll
                    for (int q = 0; q < 16; ++q) acc[q] += tr * BBr[n * 16 + q] - ti * BBi[n * 16 + q]; }
                bf16_t* o = KERN + (size_t)(g * 16 + c) * 2048 + (tb * 16 + tl) * 16;
                *(u32x4*)o = (u32x4){pk2(acc[0], acc[1]), pk2(acc[2], acc[3]), pk2(acc[4], acc[5]), pk2(acc[6], acc[7])};
                *(u32x4*)(o + 8) = (u32x4){pk2(acc[8], acc[9]), pk2(acc[10], acc[11]), pk2(acc[12], acc[13]), pk2(acc[14], acc[15])};
                if (side_todo && F.tid < 8) a128_rows(F.bx * 8 + F.tid, F.G * 8);
            } else if (side_todo) side_tables(F.bx * 256 + F.tid - 256, F.G * 256);
            side_todo = false; }
        if (side_todo) { if (F.tid >= 256) side_tables(F.bx * 256 + F.tid - 256, F.G * 256); else if (F.tid < 8) a128_rows(F.bx * 8 + F.tid, F.G * 8); }
        __syncthreads(); }
      bf16_t* PW = GT; bf16_t* BB = GT + (size_t)32 * 128 * 128;
      for (int i = gt; i < 32 * 64 * 128; i += NT_) { const int g = i >> 13, n = (i >> 7) & 63, j = i & 127, gn = g * 64 + n; const float dt = __expf(LDT[g]), are = ARE[gn], aim = AIM[gn];
          const float e = (float)(127 - j), pm = __expf(are * dt * e);
          *(unsigned*)(PW + (size_t)(g * 128 + j) * 128 + 2 * n) = pk2(pm * cosf(aim * dt * e), pm * sinf(aim * dt * e));
          const float e1 = (float)(j + 1), qm = __expf(are * dt * e1); WT[(size_t)(g * 128 + j) * 64 + n] = (f32x2){qm * cosf(aim * dt * e1), qm * sinf(aim * dt * e1)}; }
      for (int i = gt; i < 2048; i += NT_) { const int g = i >> 6; const float dt = __expf(LDT[g]), are = ARE[i], aim = AIM[i];
          const float mg = __expf(are * dt), br = mg * cosf(aim * dt), bi = mg * sinf(aim * dt), den = are * are + aim * aim, nr = br - 1.f;
          const float cr = (nr * are + bi * aim) / den, ci = (bi * are - nr * aim) / den;
          const float* bre = a.in[I_S5_BRE] + (size_t)i * 16; const float* bim = a.in[I_S5_BIM] + (size_t)i * 16;
          bf16_t* o0 = BB + (size_t)(g * 128 + 2 * (i & 63)) * 32; bf16_t* o1 = o0 + 32;
#pragma unroll
          for (int q = 0; q < 16; q += 2) { const float r0 = cr * bre[q] - ci * bim[q], i0_ = cr * bim[q] + ci * bre[q], r1 = cr * bre[q + 1] - ci * bim[q + 1], i1_ = cr * bim[q + 1] + ci * bre[q + 1];
              *(unsigned*)(o0 + q) = pk2(r0, r1); *(unsigned*)(o1 + q) = pk2(i0_, i1_); *(unsigned*)(o0 + 16 + q) = 0u; *(unsigned*)(o1 + 16 + q) = 0u; } }
      for (int i = gt; i < 32 * 16 * 64; i += NT_) { const int n = i & 63; *(unsigned*)(CT + (size_t)(i >> 6) * 128 + 2 * n) = pk2(a.in[I_S5_CRE][i], -a.in[I_S5_CIM][i]); } }
    }
    { bf16_t* H = (bf16_t*)(F.ws + WS_H); float* RS0 = (float*)(F.ws + WS_RSTD0);
      f32x4 vn[8];
      if (gw < T) { const float* xr = a.in[I_X] + (size_t)gw * D;
#pragma unroll
          for (int j = 0; j < 8; ++j) vn[j] = *(const f32x4*)(xr + (F.lane + 64 * j) * 4); }
      for (int m = gw; m < T; m += NGW) { bf16_t* o = H + (size_t)m * D; float ss = 0.f; f32x4 vc[8];
#pragma unroll
          for (int j = 0; j < 8; ++j) vc[j] = vn[j];
          if (m + NGW < T) { const float* xr = a.in[I_X] + (size_t)(m + NGW) * D;
#pragma unroll
              for (int j = 0; j < 8; ++j) vn[j] = *(const f32x4*)(xr + (F.lane + 64 * j) * 4); }
#pragma unroll
          for (int j = 0; j < 8; ++j) { const f32x4 v = vc[j]; u32x2 w; w.x = pk2(v[0], v[1]); w.y = pk2(v[2], v[3]); *(u32x2*)(o + (F.lane + 64 * j) * 4) = w;
              const float r0 = bflo(w.x), r1 = bfhi(w.x), r2 = bflo(w.y), r3 = bfhi(w.y); ss += (r0 * r0 + r1 * r1) + (r2 * r2 + r3 * r3); }
          const float rstd = rsqrtf(wsum(ss) * (1.f / D) + EPS); if (F.lane == 0) RS0[m] = rstd; } }
}

DI float ret_loggamma(int h) { return log1pf(-exp2f(-5.f - (float)h)); }
DI void rot8(const bf16_t* p, const float* cs, const float* sn, float scale, float (&r1)[8], float (&r2)[8]) {
    float a[8], b[8]; unpack8(*(const u32x4*)p, a); unpack8(*(const u32x4*)(p + 64), b);
    const f32x4 c0 = *(const f32x4*)cs, c1 = *(const f32x4*)(cs + 4), s0 = *(const f32x4*)sn, s1 = *(const f32x4*)(sn + 4);
    const float c[8] = {c0[0], c0[1], c0[2], c0[3], c1[0], c1[1], c1[2], c1[3]}, s[8] = {s0[0], s0[1], s0[2], s0[3], s1[0], s1[1], s1[2], s1[3]};
#pragma unroll
    for (int j = 0; j < 8; ++j) { r1[j] = (a[j] * c[j] - b[j] * s[j]) * scale; r2[j] = (a[j] * s[j] + b[j] * c[j]) * scale; }
}
constexpr int PT = 272;

DI void phase_pre0(const Frame& F, const Args& a) {
    const bf16_t* PR = (const bf16_t*)(F.ws + WS_PROJ);
    float* DTV = (float*)(F.ws + WS_ROWS); float* ACUM = DTV + 262144;
    const int gw = F.bx * 8 + F.wave, NGW = F.G * 8;
    for (int task = gw; task < 2048; task += NGW) { const int hd = task & 15, c = (task >> 4) & 31, b = task >> 9; const size_t row0 = (size_t)(b * SEQ + c * 128);
        const bf16_t* P = PR + row0 * PLD + P0_DT + hd; const int s0 = 2 * F.lane, s1 = s0 + 1; const float db = a.in[I_SSD_DTB][hd], A = -__expf(a.in[I_SSD_ALOG][hd]);
        const float d0 = softplus_(bf2f(P[(size_t)s0 * PLD]) + db), d1 = softplus_(bf2f(P[(size_t)s1 * PLD]) + db);
        float c0, c1; wscan_sum(d0 * A, d1 * A, F.lane, c0, c1);
        DTV[(row0 + s0) * 16 + hd] = d0; DTV[(row0 + s1) * 16 + hd] = d1; ACUM[(row0 + s0) * 16 + hd] = c0; ACUM[(row0 + s1) * 16 + hd] = c1;
        if (F.lane == 63) ((float*)(F.ws + WS_SMALL))[(b * 32 + c) * 16 + hd] = c1; }
    const int gt = F.bx * 512 + F.tid, NT_ = F.G * 512;
    const float* cw = a.in[I_SSD_CONVW]; const float* cb = a.in[I_SSD_CONVB];
    bf16_t* XC = (bf16_t*)(F.ws + WS_XC);
    for (int task = F.bx * 384 + F.tid; F.tid < 384 && task < 512 * 192; task += F.G * 384) { const int ch = (task % 192) * 8, r0 = (task / 192) * 32;
        float w[4][8], bs[8];
#pragma unroll
        for (int tp = 0; tp < 4; ++tp) { const f32x4 w0 = *(const f32x4*)(cw + tp * 1536 + ch), w1 = *(const f32x4*)(cw + tp * 1536 + ch + 4); w[tp][0] = w0[0]; w[tp][1] = w0[1]; w[tp][2] = w0[2]; w[tp][3] = w0[3]; w[tp][4] = w1[0]; w[tp][5] = w1[1]; w[tp][6] = w1[2]; w[tp][7] = w1[3]; }
        { const f32x4 b0 = *(const f32x4*)(cb + ch), b1 = *(const f32x4*)(cb + ch + 4); bs[0] = b0[0]; bs[1] = b0[1]; bs[2] = b0[2]; bs[3] = b0[3]; bs[4] = b1[0]; bs[5] = b1[1]; bs[6] = b1[2]; bs[7] = b1[3]; }
        const bf16_t* src = PR + (size_t)r0 * PLD + P0_XBC + ch; bf16_t* dst = XC + (size_t)r0 * 1536 + ch;
        float x1[8], x2[8], x3[8];
        if ((r0 & (SEQ - 1)) != 0) { unpack8(*(const u32x4*)(src - PLD), x1); unpack8(*(const u32x4*)(src - 2 * PLD), x2); unpack8(*(const u32x4*)(src - 3 * PLD), x3); }
        else {
#pragma unroll
            for (int j = 0; j < 8; ++j) { x1[j] = 0.f; x2[j] = 0.f; x3[j] = 0.f; } }
#pragma unroll 8
        for (int i = 0; i < 32; ++i) { float x0[8], y[8]; unpack8(*(const u32x4*)(src + (size_t)i * PLD), x0);
#pragma unroll
            for (int j = 0; j < 8; ++j) { y[j] = silu_(bs[j] + w[0][j] * x3[j] + w[1][j] * x2[j] + w[2][j] * x1[j] + w[3][j] * x0[j]); x3[j] = x2[j]; x2[j] = x1[j]; x1[j] = x0[j]; }
            *(u32x4*)(dst + (size_t)i * 1536) = pack8(y); }
    }
}

DI void ret_local_unit(const Frame& F_, const Args& a, int u) {
    Frame F = F_; { int tz = F_.tid; asm volatile("" : "+v"(tz)); F.tid = tz; F.lane = tz & 63; }
    const int b = u >> 8, c = (u >> 3) & 31, h = u & 7, w = F.wave;
    const bf16_t* P = (const bf16_t*)(F.ws + WS_PROJ) + (size_t)(b * SEQ + c * 128) * PLD;
    const float* COS = (const float*)(F.ws + WS_COS); const float* SIN = (const float*)(F.ws + WS_SIN);
    ldsp KI = F.lds, VI = F.lds + 34816;
    const float lg = ret_loggamma(h);
#pragma unroll
    for (int i = 0; i < 4; ++i) { const int item = F.tid + 512 * i, s = item >> 4, e0 = (item & 15) * 8; *(LAS u32x4*)(VI + s * PT + e0 * 2) = *(const u32x4*)(P + (size_t)s * PLD + P0_V + h * 128 + e0); }
#pragma unroll
    for (int i = 0; i < 2; ++i) { const int item = F.tid + 512 * i, s = item >> 3, d0 = (item & 7) * 8, pos = c * 128 + s;
        float r1[8], r2[8]; rot8(P + (size_t)s * PLD + P0_K + h * 128 + d0, COS + pos * 64 + d0, SIN + pos * 64 + d0, 0.08838834764831845f * __expf(lg * (float)(127 - s)), r1, r2);
        *(LAS u32x4*)(KI + s * PT + d0 * 2) = pack8(r1); *(LAS u32x4*)(KI + s * PT + (d0 + 64) * 2) = pack8(r2); }
    __syncthreads();
    const int fr = F.lane & 15, fq = F.lane >> 4;
    ldsp ktr = KI + (8 * (F.lane >> 4) + ((F.lane & 15) >> 2)) * PT + (F.lane & 3) * 32, vtr = VI + tr_lane_off(F.lane, PT) + (16 * w) * 2;
    f32x4 acc[8]; zero_acc(acc);
#pragma unroll
    for (int ks = 0; ks < 4; ++ks) { const bf16x8 av = tr_frag(vtr, ks * 32 * PT, PT); bf16x8 bv[8];
#pragma unroll
        for (int nt = 0; nt < 8; ++nt) bv[nt] = tr_frag(ktr, ks * 32 * PT + (nt >> 2) * 128 + (nt & 3) * 8, PT);
#pragma unroll
        for (int nt = 0; nt < 8; ++nt) acc[nt] = __builtin_amdgcn_mfma_f32_16x16x32_bf16(bv[nt], av, acc[nt], 0, 0, 0); }
    bf16_t* dst = (bf16_t*)(F.ws + WS_RET_DS) + ((size_t)((b * 8 + h) * 32 + c) * 128 + 16 * w + fr) * 128 + fq * 16;
#pragma unroll
    for (int p = 0; p < 2; ++p) { u32x4 o0, o1; o0.x = pk2(acc[4 * p][0], acc[4 * p][1]); o0.y = pk2(acc[4 * p][2], acc[4 * p][3]); o0.z = pk2(acc[4 * p + 1][0], acc[4 * p + 1][1]); o0.w = pk2(acc[4 * p + 1][2], acc[4 * p + 1][3]);
        o1.x = pk2(acc[4 * p + 2][0], acc[4 * p + 2][1]); o1.y = pk2(acc[4 * p + 2][2], acc[4 * p + 2][3]); o1.z = pk2(acc[4 * p + 3][0], acc[4 * p + 3][1]); o1.w = pk2(acc[4 * p + 3][2], acc[4 * p + 3][3]);
        *(u32x4*)(dst + p * 64) = o0; *(u32x4*)(dst + p * 64 + 8) = o1; }
    __syncthreads();
}

DI void ssd_local_unit(const Frame& F_, const Args& a, int u) {
    Frame F = F_; { int tz = F_.tid; asm volatile("" : "+v"(tz)); F.tid = tz; F.lane = tz & 63; }
    const int b = u >> 7, c = (u >> 2) & 31, g = (u >> 1) & 1, hh = u & 1, hd0 = g * 8 + hh * 4, w = F.wave;
    const size_t row0 = (size_t)(b * SEQ + c * 128);
    const bf16_t* XC = (const bf16_t*)(F.ws + WS_XC) + row0 * 1536; const float* DTV = (const float*)(F.ws + WS_ROWS) + row0 * 16; const float* ACUM = DTV + 262144;
    constexpr int PX = 528;
    ldsp XI = F.lds, BI = F.lds + 67584; LAS float* sc = (LAS float*)(F.lds + 102400);
    u32x4 xr[8], br[4];
#pragma unroll
    for (int i = 0; i < 8; ++i) { const int item = F.tid + 512 * i, s = item >> 5, ch = (item & 31) * 8; xr[i] = *(const u32x4*)(XC + (size_t)s * 1536 + hd0 * 64 + ch); }
#pragma unroll
    for (int i = 0; i < 4; ++i) { const int item = F.tid + 512 * i, s = item >> 4, n0 = (item & 15) * 8; br[i] = *(const u32x4*)(XC + (size_t)s * 1536 + 1024 + g * 128 + n0); }
    { const int s = F.tid >> 2, r = F.tid & 3; sc[F.tid] = DTV[s * 16 + hd0 + r] * __expf(ACUM[127 * 16 + hd0 + r] - ACUM[s * 16 + hd0 + r]); }
#pragma unroll
    for (int i = 0; i < 4; ++i) { const int item = F.tid + 512 * i, s = item >> 4, n0 = (item & 15) * 8; *(LAS u32x4*)(BI + s * PT + n0 * 2) = br[i]; }
    __syncthreads();
#pragma unroll
    for (int i = 0; i < 8; ++i) { const int item = F.tid + 512 * i, s = item >> 5, ch = (item & 31) * 8; const float f = sc[s * 4 + (ch >> 6)]; float y[8]; unpack8(xr[i], y);
#pragma unroll
        for (int j = 0; j < 8; ++j) y[j] *= f;
        *(LAS u32x4*)(XI + s * PX + ch * 2) = pack8(y); }
    __syncthreads();
    const int fr = F.lane & 15, fq = F.lane >> 4;
    ldsp xtr = XI + tr_lane_off(F.lane, PX) + (32 * w) * 2, btr = BI + (8 * (F.lane >> 4) + ((F.lane & 15) >> 2)) * PT + (F.lane & 3) * 32;
    f32x4 acc[2][8]; zero_acc(acc[0]); zero_acc(acc[1]);
#pragma unroll
    for (int ks = 0; ks < 4; ++ks) { const bf16x8 a0 = tr_frag(xtr, ks * 32 * PX, PX), a1 = tr_frag(xtr, ks * 32 * PX + 32, PX); bf16x8 bv[8];
#pragma unroll
        for (int nt = 0; nt < 8; ++nt) bv[nt] = tr_frag(btr, ks * 32 * PT + (nt >> 2) * 128 + (nt & 3) * 8, PT);
#pragma unroll
        for (int nt = 0; nt < 8; ++nt) { acc[0][nt] = __builtin_amdgcn_mfma_f32_16x16x32_bf16(bv[nt], a0, acc[0][nt], 0, 0, 0); acc[1][nt] = __builtin_amdgcn_mfma_f32_16x16x32_bf16(bv[nt], a1, acc[1][nt], 0, 0, 0); } }
#pragma unroll
    for (int rt = 0; rt < 2; ++rt) { const int rr = 32 * w + 16 * rt + fr, r = rr >> 6, p = rr & 63;
        bf16_t* dst = (bf16_t*)(F.ws + WS_SSD_DS) + (((size_t)(b * 32 + c) * 16 + hd0 + r) * 64 + p) * 128 + fq * 16;
#pragma unroll
        for (int q = 0; q < 2; ++q) { u32x4 o0, o1; o0.x = pk2(acc[rt][4 * q][0], acc[rt][4 * q][1]); o0.y = pk2(acc[rt][4 * q][2], acc[rt][4 * q][3]); o0.z = pk2(acc[rt][4 * q + 1][0], acc[rt][4 * q + 1][1]); o0.w = pk2(acc[rt][4 * q + 1][2], acc[rt][4 * q + 1][3]);
            o1.x = pk2(acc[rt][4 * q + 2][0], acc[rt][4 * q + 2][1]); o1.y = pk2(acc[rt][4 * q + 2][2], acc[rt][4 * q + 2][3]); o1.z = pk2(acc[rt][4 * q + 3][0], acc[rt][4 * q + 3][1]); o1.w = pk2(acc[rt][4 * q + 3][2], acc[rt][4 * q + 3][3]);
            *(u32x4*)(dst + q * 64) = o0; *(u32x4*)(dst + q * 64 + 8) = o1; } }
    __syncthreads();
}

DI void phase_even_scan(const Frame& F, const Args& a) {
    const int gt = F.bx * 512 + F.tid, NT_ = F.G * 512;
    const float* AEND = (const float*)(F.ws + WS_SMALL);
    for (int i = gt; i < 131072; i += NT_) {
        const int bh = i >> 12, v = i & 4095; const float g128 = __expf(ret_loggamma(bh & 7) * 128.f);
        const bf16_t* srcR = (const bf16_t*)(F.ws + WS_RET_DS) + (size_t)bh * 32 * 16384 + v * 4; bf16_t* dstR = (bf16_t*)(F.ws + WS_RET_S) + (size_t)bh * 32 * 16384 + v * 4;
        const int bhd = i >> 11, v2 = i & 2047, b = bhd >> 4, hd = bhd & 15;
        const bf16_t* srcS = (const bf16_t*)(F.ws + WS_SSD_DS) + ((size_t)(b * 32) * 16 + hd) * 8192 + v2 * 4; bf16_t* dstS = (bf16_t*)(F.ws + WS_SSD_S) + ((size_t)(b * 32) * 16 + hd) * 8192 + v2 * 4;
        f32x4 runR = (f32x4){0.f, 0.f, 0.f, 0.f}, runS = runR;
#pragma unroll 16
        for (int c = 0; c < 32; ++c) { const u32x2 xr = *(const u32x2*)(srcR + (size_t)c * 16384), xs = *(const u32x2*)(srcS + (size_t)c * 16 * 8192); const float dec = __expf(AEND[(b * 32 + c) * 16 + hd]);
            u32x2 wr, wsv; wr.x = pk2(runR[0], runR[1]); wr.y = pk2(runR[2], runR[3]); wsv.x = pk2(runS[0], runS[1]); wsv.y = pk2(runS[2], runS[3]);
            *(u32x2*)(dstR + (size_t)c * 16384) = wr; *(u32x2*)(dstS + (size_t)c * 16 * 8192) = wsv;
            runR = runR * g128 + (f32x4){bflo(xr.x), bfhi(xr.x), bflo(xr.y), bfhi(xr.y)}; runS = runS * dec + (f32x4){bflo(xs.x), bfhi(xs.x), bflo(xs.y), bfhi(xs.y)}; }
    }
}

DI void ret_out_unit(const Frame& F_, const Args& a, int u) {
    Frame F = F_; { int tz = F_.tid; asm volatile("" : "+v"(tz)); F.tid = tz; F.lane = tz & 63; }
    const int b = u >> 8, c = (u >> 3) & 31, h = u & 7, w = F.wave;
    const size_t row0 = (size_t)(b * SEQ + c * 128);
    const bf16_t* P = (const bf16_t*)(F.ws + WS_PROJ) + row0 * PLD;
    const float* COS = (const float*)(F.ws + WS_COS); const float* SIN = (const float*)(F.ws + WS_SIN);
    ldsp Q = F.lds, KX = F.lds + 34816, VT = F.lds + 69632, ST = F.lds + 104448;
    const float lg = ret_loggamma(h);
#pragma unroll
    for (int i = 0; i < 2; ++i) { const int item = F.tid + 512 * i, s = item >> 3, d0 = (item & 7) * 8, pos = c * 128 + s;
        float r1[8], r2[8];
        rot8(P + (size_t)s * PLD + h * 128 + d0, COS + pos * 64 + d0, SIN + pos * 64 + d0, 1.f, r1, r2);
        *(LAS u32x4*)(Q + s * PT + d0 * 2) = pack8(r1); *(LAS u32x4*)(Q + s * PT + (d0 + 64) * 2) = pack8(r2);
        rot8(P + (size_t)s * PLD + P0_K + h * 128 + d0, COS + pos * 64 + d0, SIN + pos * 64 + d0, 0.08838834764831845f, r1, r2);
        *(LAS u32x4*)(KX + s * PT + d0 * 2) = pack8(r1); *(LAS u32x4*)(KX + s * PT + (d0 + 64) * 2) = pack8(r2); }
    const bf16_t* Sg = (const bf16_t*)(F.ws + WS_RET_S) + (size_t)((b * 8 + h) * 32 + c) * 16384;
#pragma unroll
    for (int i = 0; i < 4; ++i) { const int item = F.tid + 512 * i, s = item >> 4, e0 = (item & 15) * 8;
        *(LAS u32x4*)(VT + s * PT + e0 * 2) = *(const u32x4*)(P + (size_t)s * PLD + P0_V + h * 128 + e0);
        *(LAS u32x4*)(ST + s * PT + e0 * 2) = *(const u32x4*)(Sg + (size_t)s * 128 + e0); }
    __syncthreads();
    const int fr = F.lane & 15, fq = F.lane >> 4, l = 16 * w + fr;
    u32x4 gpre[4];
    { const bf16_t* gp_ = P + (size_t)l * PLD + P0_G + h * 128 + 16 * fq; gpre[0] = *(const u32x4*)gp_; gpre[1] = *(const u32x4*)(gp_ + 8); gpre[2] = *(const u32x4*)(gp_ + 64); gpre[3] = *(const u32x4*)(gp_ + 72); }
    f32x4 as[8]; zero_acc(as);
    mma16<8, 4>(as, Q + (16 * w) * PT, PT, KX, PT, fr, fq, w + 1, 4);
    f32x4 ao[8]; zero_acc(ao);
    mma16<8, 4, true>(ao, Q + (16 * w) * PT, PT, ST, PT, fr, fq);
    { const float qd = __expf(lg * (float)(l + 1));
#pragma unroll
      for (int nt = 0; nt < 8; ++nt) ao[nt] = ao[nt] * qd; }
    __syncthreads();
    ldsp Pm = KX;
#pragma unroll
    for (int nt = 0; nt < 8; ++nt) if (nt <= (w | 1)) { float pv[4];
#pragma unroll
        for (int j = 0; j < 4; ++j) { const int s = nt * 16 + fq * 4 + j; pv[j] = (nt <= w && s <= l) ? as[nt][j] * __expf(lg * (float)(l - s)) : 0.f; }
        u32x2 pw; pw.x = pk2(pv[0], pv[1]); pw.y = pk2(pv[2], pv[3]); *(LAS u32x2*)(Pm + l * PT + (nt * 16 + fq * 4) * 2) = pw; }
    __syncthreads();
    { ldsp vtr = VT + tr_lane_off_p(F.lane, PT);
#pragma unroll
      for (int ks = 0; ks < 4; ++ks) if (ks <= (w >> 1)) { const bf16x8 av = *(const LAS bf16x8*)(Pm + l * PT + (ks * 32 + fq * 8) * 2); bf16x8 bv[8];
#pragma unroll
          for (int nt = 0; nt < 8; ++nt) bv[nt] = tr_frag(vtr, ks * 32 * PT + permb_off(nt), PT);
#pragma unroll
          for (int nt = 0; nt < 8; ++nt) ao[nt] = __builtin_amdgcn_mfma_f32_16x16x32_bf16(bv[nt], av, ao[nt], 0, 0, 0); } }
    float sm = 0.f;
#pragma unroll
    for (int nt = 0; nt < 8; ++nt) sm += ao[nt][0] + ao[nt][1] + ao[nt][2] + ao[nt][3];
    sm += __shfl_xor(sm, 16); sm += __shfl_xor(sm, 32);
    const float mean = sm * (1.f / 128.f); float vs = 0.f;
#pragma unroll
    for (int nt = 0; nt < 8; ++nt)
#pragma unroll
        for (int j = 0; j < 4; ++j) { const float d = ao[nt][j] - mean; vs += d * d; }
    vs += __shfl_xor(vs, 16); vs += __shfl_xor(vs, 32);
    const float rstd = rsqrtf(vs * (1.f / 128.f) + EPS);
    const float* ng = a.in[I_RET_NORM] + h * 128;
    bf16_t* orow = (bf16_t*)(F.ws + WS_MIX) + (row0 + l) * 2048 + h * 128;
#pragma unroll
    for (int p = 0; p < 2; ++p) { const int e = 64 * p + 16 * fq; float gg[16]; { float t0[8], t1[8]; unpack8(gpre[2 * p], t0); unpack8(gpre[2 * p + 1], t1);
#pragma unroll
            for (int q = 0; q < 8; ++q) { gg[q] = t0[q]; gg[8 + q] = t1[q]; } }
        float o[16];
#pragma unroll
        for (int t = 0; t < 4; ++t) { const f32x4 nn = *(const f32x4*)(ng + e + 4 * t);
#pragma unroll
            for (int j = 0; j < 4; ++j) o[4 * t + j] = (ao[4 * p + t][j] - mean) * rstd * nn[j] * silu_(gg[4 * t + j]); }
        u32x4 o0, o1; o0.x = pk2(o[0], o[1]); o0.y = pk2(o[2], o[3]); o0.z = pk2(o[4], o[5]); o0.w = pk2(o[6], o[7]); o1.x = pk2(o[8], o[9]); o1.y = pk2(o[10], o[11]); o1.z = pk2(o[12], o[13]); o1.w = pk2(o[14], o[15]);
        *(u32x4*)(orow + e) = o0; *(u32x4*)(orow + e + 8) = o1; }
    __syncthreads();
}

DI void ssd_out_unit(const Frame& F_, const Args& a, int u) {
    Frame F = F_; { int tz = F_.tid; asm volatile("" : "+v"(tz)); F.tid = tz; F.lane = tz & 63; }
    const int b = u >> 6, c = (u >> 1) & 31, g = u & 1, w = F.wave;
    const size_t row0 = (size_t)(b * SEQ + c * 128);
    const bf16_t* P = (const bf16_t*)(F.ws + WS_PROJ) + row0 * PLD; const bf16_t* XC = (const bf16_t*)(F.ws + WS_XC) + row0 * 1536;
    const float* DTV = (const float*)(F.ws + WS_ROWS) + row0 * 16 + g * 8; const float* ACUM = DTV + 262144;
    constexpr int PXS = 144;
    ldsp CM = F.lds, BM = F.lds + 34816, XS = F.lds + 34816, Pm = F.lds + 69632, SS = F.lds + 104448;
    LAS float* acum = (LAS float*)(F.lds + 121856); LAS float* dts = (LAS float*)(F.lds + 125952);
#pragma unroll
    for (int i = 0; i < 2; ++i) { const int idx = F.tid + 512 * i, s = idx >> 3, r = idx & 7; acum[r * 128 + s] = ACUM[s * 16 + r]; dts[r * 128 + s] = DTV[s * 16 + r]; }
#pragma unroll
    for (int i = 0; i < 4; ++i) { const int item = F.tid + 512 * i, s = item >> 4, n0 = (item & 15) * 8;
        *(LAS u32x4*)(CM + s * PT + n0 * 2) = *(const u32x4*)(XC + (size_t)s * 1536 + 1280 + g * 128 + n0); *(LAS u32x4*)(BM + s * PT + n0 * 2) = *(const u32x4*)(XC + (size_t)s * 1536 + 1024 + g * 128 + n0); }
    const bf16_t* Sg = (const bf16_t*)(F.ws + WS_SSD_S) + ((size_t)(b * 32 + c) * 16 + g * 8) * 8192;
    u32x4 xr[2], sr[2];
#define SSD_LOAD(r) do { _Pragma("unroll") for (int i = 0; i < 2; ++i) { const int item = F.tid + 512 * i; xr[i] = *(const u32x4*)(XC + (size_t)(item >> 3) * 1536 + (g * 8 + (r)) * 64 + (item & 7) * 8); \
        sr[i] = *(const u32x4*)(Sg + (size_t)(r) * 8192 + (item >> 4) * 128 + (item & 15) * 8); } } while (0)
    SSD_LOAD(0);
    __syncthreads();
    const int fr = F.lane & 15, fq = F.lane >> 4, l = 16 * w + fr;
    f32x4 cbm[8]; zero_acc(cbm);
    mma16<8, 4>(cbm, CM + (16 * w) * PT, PT, BM, PT, fr, fq);
    __syncthreads();
    float ssq = 0.f;
    const f32x4 dsk0 = *(const f32x4*)(a.in[I_SSD_D] + g * 8), dsk1 = *(const f32x4*)(a.in[I_SSD_D] + g * 8 + 4);
    bf16_t* orow = (bf16_t*)(F.ws + WS_MIX) + (row0 + l) * 2048 + 1024 + g * 512; const float* ng = a.in[I_SSD_NORM] + g * 512;
    ldsp xtr = XS + tr_lane_off_p(F.lane, PXS);
#pragma unroll 1
    for (int r = 0; r < 8; ++r) {
        const int hd = g * 8 + r;
#pragma unroll
        for (int i = 0; i < 2; ++i) { const int item = F.tid + 512 * i; *(LAS u32x4*)(XS + (item >> 3) * PXS + (item & 7) * 16) = xr[i]; *(LAS u32x4*)(SS + (item >> 4) * PT + (item & 15) * 16) = sr[i]; }
        __syncthreads();
        if (r < 7) SSD_LOAD(r + 1);
        const u32x4 zra = *(const u32x4*)(P + (size_t)l * PLD + P0_Z + hd * 64 + 16 * fq), zrb = *(const u32x4*)(P + (size_t)l * PLD + P0_Z + hd * 64 + 16 * fq + 8);
        f32x4 acc[4]; zero_acc(acc);
        mma16<4, 4, true>(acc, CM + (16 * w) * PT, PT, SS, PT, fr, fq);
        const float al = acum[r * 128 + l];
        { const float ea = __expf(al);
#pragma unroll
          for (int nt = 0; nt < 4; ++nt) acc[nt] = acc[nt] * ea; }
#pragma unroll
        for (int nt = 0; nt < 8; ++nt) if (nt <= (w | 1)) { float pv[4]; const f32x4 a4 = *(const LAS f32x4*)(acum + r * 128 + nt * 16 + fq * 4), d4 = *(const LAS f32x4*)(dts + r * 128 + nt * 16 + fq * 4);
#pragma unroll
            for (int j = 0; j < 4; ++j) { const int s = nt * 16 + fq * 4 + j; pv[j] = (nt <= w && s <= l) ? cbm[nt][j] * __expf(al - a4[j]) * d4[j] : 0.f; }
            u32x2 pw; pw.x = pk2(pv[0], pv[1]); pw.y = pk2(pv[2], pv[3]); *(LAS u32x2*)(Pm + l * PT + (nt * 16 + fq * 4) * 2) = pw; }
        LDS_WAIT();
#pragma unroll
        for (int ks = 0; ks < 4; ++ks) if (ks <= (w >> 1)) { const bf16x8 av = *(const LAS bf16x8*)(Pm + l * PT + (ks * 32 + fq * 8) * 2); bf16x8 bv[4];
#pragma unroll
            for (int nt = 0; nt < 4; ++nt) bv[nt] = tr_frag(xtr, ks * 32 * PXS + permb_off(nt), PXS);
#pragma unroll
            for (int nt = 0; nt < 4; ++nt) acc[nt] = __builtin_amdgcn_mfma_f32_16x16x32_bf16(bv[nt], av, acc[nt], 0, 0, 0); }
        const float dsk = (r < 4) ? ((r & 2) ? ((r & 1) ? dsk0[3] : dsk0[2]) : ((r & 1) ? dsk0[1] : dsk0[0])) : ((r & 2) ? ((r & 1) ? dsk1[3] : dsk1[2]) : ((r & 1) ? dsk1[1] : dsk1[0]));
        { const int p = 16 * fq; float xs[16], zz[16], y[16];
            { float t0[8], t1[8]; unpack8(*(const LAS u32x4*)(XS + l * PXS + p * 2), t0); unpack8(*(const LAS u32x4*)(XS + l * PXS + p * 2 + 16), t1);
#pragma unroll
              for (int q = 0; q < 8; ++q) { xs[q] = t0[q]; xs[8 + q] = t1[q]; }
              unpack8(zra, t0); unpack8(zrb, t1);
#pragma unroll
              for (int q = 0; q < 8; ++q) { zz[q] = t0[q]; zz[8 + q] = t1[q]; } }
#pragma unroll
            for (int t = 0; t < 4; ++t)
#pragma unroll
                for (int j = 0; j < 4; ++j) { const float v = (acc[t][j] + dsk * xs[4 * t + j]) * silu_(zz[4 * t + j]); y[4 * t + j] = v; ssq += v * v; }
            u32x4 o0, o1; o0.x = pk2(y[0], y[1]); o0.y = pk2(y[2], y[3]); o0.z = pk2(y[4], y[5]); o0.w = pk2(y[6], y[7]); o1.x = pk2(y[8], y[9]); o1.y = pk2(y[10], y[11]); o1.z = pk2(y[12], y[13]); o1.w = pk2(y[14], y[15]);
            *(u32x4*)(orow + r * 64 + p) = o0; *(u32x4*)(orow + r * 64 + p + 8) = o1; }
        __syncthreads();
    }
#undef SSD_LOAD
    ssq += __shfl_xor(ssq, 16); ssq += __shfl_xor(ssq, 32);
    const float rstd = rsqrtf(ssq * (1.f / 512.f) + EPS);
    asm volatile("s_waitcnt vmcnt(0)" ::: "memory");
#pragma unroll
    for (int r = 0; r < 8; ++r)
#pragma unroll
        for (int hf = 0; hf < 2; ++hf) { const int p = r * 64 + 16 * fq + 8 * hf; float y[8]; unpack8(*(const u32x4*)(orow + p), y); const f32x4 n0 = *(const f32x4*)(ng + p), n1 = *(const f32x4*)(ng + p + 4);
            u32x4 o; o.x = pk2(y[0] * rstd * n0[0], y[1] * rstd * n0[1]); o.y = pk2(y[2] * rstd * n0[2], y[3] * rstd * n0[3]); o.z = pk2(y[4] * rstd * n1[0], y[5] * rstd * n1[1]); o.w = pk2(y[6] * rstd * n1[2], y[7] * rstd * n1[3]);
            *(u32x4*)(orow + p) = o; }
    __syncthreads();
}

constexpr size_t WS_RSTD = WS_SMALL + 131072;
DI void phase_router(const Frame& F, const Args& a, int layer) {
    const bf16_t* H = (const bf16_t*)(F.ws + WS_H); const bf16_t* RTH = (const bf16_t*)(F.ws + WS_RT) + (size_t)layer * 48 * 2048; const bf16_t* RTL = (const bf16_t*)(F.ws + WS_RT + 512 * 1024) + (size_t)layer * 48 * 2048;
    unsigned* cnt = (unsigned*)(F.ws + WS_CTL) + CW_CNT + layer * 32 * 64;
    int* LIST = (int*)(F.ws + WS_LIST); int* SLOT = (int*)(F.ws + WS_SLOT); float* RSTD = (float*)(F.ws + WS_RSTD);
    const int fr = F.lane & 15, fq = F.lane >> 4, t = F.wave & 3, kh = F.wave >> 2;
    constexpr int PR_ = 1040;
    ldsp TH = F.lds, TL = F.lds + 49920;
    LAS float* part = (LAS float*)(F.lds + 102400 + (size_t)t * 4096);
    for (int tg = F.bx; tg < 256; tg += F.G) {
        const int row0 = (tg * 4 + t) * 16;
        const bf16_t* ap = H + (size_t)(row0 + fr) * 2048 + kh * 256 + fq * 8;
        u32x4 ab[2][8];
#pragma unroll
        for (int i = 0; i < 8; ++i) ab[0][i] = *(const u32x4*)(ap + i * 32);
        f32x4 acc[3]; zero_acc(acc); float ss = 0.f;
#pragma unroll
        for (int kc = 0; kc < 4; ++kc) {
            __syncthreads();
#pragma unroll
            for (int hb = 0; hb < 2; ++hb) { u32x4 th[3], tl[3];
#pragma unroll
                for (int i = 0; i < 3; ++i) { const int item = F.tid + 512 * (3 * hb + i), col = item >> 6, c8 = (item & 63) * 8; th[i] = *(const u32x4*)(RTH + (size_t)col * 2048 + kc * 512 + c8); tl[i] = *(const u32x4*)(RTL + (size_t)col * 2048 + kc * 512 + c8); }
#pragma unroll
                for (int i = 0; i < 3; ++i) { const int item = F.tid + 512 * (3 * hb + i), col = item >> 6, c8 = (item & 63) * 8; *(LAS u32x4*)(TH + col * PR_ + c8 * 2) = th[i]; *(LAS u32x4*)(TL + col * PR_ + c8 * 2) = tl[i]; }
                asm volatile("" ::: "memory"); }
            __syncthreads();
            if (kc < 3) {
#pragma unroll
                for (int i = 0; i < 8; ++i) ab[(kc + 1) & 1][i] = *(const u32x4*)(ap + (kc + 1) * 512 + i * 32); }
#pragma unroll
            for (int ks = 0; ks < 8; ++ks) { const u32x4 av = ab[kc & 1][ks];
                float x[8]; unpack8(av, x);
                ss += (x[0] * x[0] + x[1] * x[1]) + (x[2] * x[2] + x[3] * x[3]) + (x[4] * x[4] + x[5] * x[5]) + (x[6] * x[6] + x[7] * x[7]);
                const bf16x8 ah = __builtin_bit_cast(bf16x8, av);
#pragma unroll
                for (int ct = 0; ct < 3; ++ct) { const int bo = (ct * 16 + fr) * PR_ + (kh * 256 + ks * 32 + fq * 8) * 2;
                    const bf16x8 bhv = *(const LAS bf16x8*)(TH + bo), blv = *(const LAS bf16x8*)(TL + bo);
                    acc[ct] = __builtin_amdgcn_mfma_f32_16x16x32_bf16(ah, bhv, acc[ct], 0, 0, 0);
                    acc[ct] = __builtin_amdgcn_mfma_f32_16x16x32_bf16(ah, blv, acc[ct], 0, 0, 0); }
                if (ks & 1) asm volatile("" : "+v"(ss) :: "memory"); }
        }
        ss += __shfl_xor(ss, 16); ss += __shfl_xor(ss, 32);
        if (kh == 1) {
#pragma unroll
            for (int ct = 0; ct < 3; ++ct)
#pragma unroll
                for (int j = 0; j < 4; ++j) part[(4 * fq + j) * 48 + ct * 16 + fr] = acc[ct][j];
            if (fq == 0) part[768 + fr] = ss;
        }
        __syncthreads();
        if (kh == 0) {
            ss += part[768 + fr];
            const float rstd = rsqrtf(ss * (1.f / D) + EPS);
#pragma unroll
            for (int ct = 0; ct < 3; ++ct)
#pragma unroll
                for (int j = 0; j < 4; ++j) part[(4 * fq + j) * 48 + ct * 16 + fr] += acc[ct][j];
            LDS_WAIT();
            if (fq == 0) part[768 + fr] = rstd;
            LDS_WAIT();
            if (F.lane < 16) {
                const int r = F.lane, tok = row0 + r; const float rr = part[768 + r];
                float gl[4]; float mx = -INFINITY; int gi = 0;
#pragma unroll
                for (int j = 0; j < 4; ++j) { gl[j] = part[r * 48 + j] * rr + a.in[I_MOE_RGB][layer * 4 + j]; if (gl[j] > mx) { mx = gl[j]; gi = j; } }
                float se = 0.f;
#pragma unroll
                for (int j = 0; j < 4; ++j) se += __expf(gl[j] - mx);
                const float gw = 1.f / se;
                float v1 = -INFINITY, v2 = -INFINITY; int i1 = 0, i2 = 0;
                for (int k = 0; k < 8; ++k) { const float v = part[r * 48 + 4 + gi * 8 + k] * rr + a.in[I_MOE_REB][layer * 32 + gi * 8 + k];
                    if (v > v1) { v2 = v1; i2 = i1; v1 = v; i1 = k; } else if (v > v2) { v2 = v; i2 = k; } }
                const float e2 = __expf(v2 - v1), w1 = gw / (1.f + e2), w2 = gw * e2 / (1.f + e2);
                const int e0 = gi * 8 + i1, e1 = gi * 8 + i2;
                const int r0 = (int)__hip_atomic_fetch_add(cnt + e0 * 64, 1u, __ATOMIC_RELAXED, __HIP_MEMORY_SCOPE_AGENT);
                const int r1 = (int)__hip_atomic_fetch_add(cnt + e1 * 64, 1u, __ATOMIC_RELAXED, __HIP_MEMORY_SCOPE_AGENT);
                LIST[e0 * T + r0] = tok; LIST[e1 * T + r1] = tok; RSTD[tok] = rr;
                int* sp = SLOT + (size_t)tok * 8; sp[0] = e0; sp[1] = r0; sp[2] = __float_as_int(w1); sp[3] = e1; sp[4] = r1; sp[5] = __float_as_int(w2);
            }
        }
        __syncthreads();
    }
}
DI int moe_tables(const Frame& F, int layer) {
    const unsigned* cnt = (const unsigned*)(F.ws + WS_CTL) + CW_CNT + layer * 32 * 64;
    LAS int* tile_e = (LAS int*)(F.lds + LDS_TAB); LAS int* tstart = tile_e + 192; LAS int* ecnt = tile_e + 224;
    if (F.tid < 32) ecnt[F.tid] = (int)__hip_atomic_load(cnt + F.tid * 64, __ATOMIC_RELAXED, __HIP_MEMORY_SCOPE_AGENT);
    __syncthreads();
    if (F.tid == 0) { int acc = 0;
        for (int e = 0; e < 32; ++e) { const int mt = (ecnt[e] + 255) >> 8; tstart[e] = acc;
            for (int k = 0; k < mt; ++k) tile_e[acc + k] = e; acc += mt; }
        tile_e[191] = acc; }
    __syncthreads();
    return tile_e[191];
}
DI void phase_moe_gateup(const Frame& F, const Args& a, int layer) {
    const int ntiles = moe_tables(F, layer);
    LAS int* tile_e = (LAS int*)(F.lds + LDS_TAB); LAS int* tstart = tile_e + 192; LAS int* ecnt = tile_e + 224; LAS int* gtab = (LAS int*)(F.lds + LDS_TAB + 1024);
    const int* LIST = (const int*)(F.ws + WS_LIST);
    for (int i = 0; i < 4; ++i) { const int L = i * F.G + F.bx; if (L >= ntiles * 4) break;
        const int gm = L >> 2, e = tile_e[gm], rbase = (gm - tstart[e]) * 256;
        if (F.tid < 256) { const int rank = rbase + F.tid; gtab[i * 256 + F.tid] = (rank < ecnt[e]) ? LIST[e * T + rank] : 0; } }
    __syncthreads();
    pg8::MoeGU S; S.XN = (const char*)(F.ws + WS_H); S.W = (const char*)(F.ws + WS_WGU); S.tile_e = tile_e; S.gtab = gtab; S.nunits = ntiles * 4; S.G = F.G; S.c = F.bx;
    pg8::EpiGateUp E{(bf16_t*)(F.ws + WS_HID), 512, gtab, (const float*)(F.ws + WS_RSTD)};
    pg8::gemm_phase<pg8::EpiGateUp, pg8::MoeGU, true>(F.lds, 2048, 2048, 2048, S, E);
    { const int rem = (ntiles * 4) % F.G; __syncthreads();
      if (rem == 0) moe_convert(F, a, layer, 32768, 49152, F.bx, F.G); else if (F.bx >= rem) moe_convert(F, a, layer, 32768, 49152, F.bx - rem, F.G - rem); }
}
DI void phase_moe_down(const Frame& F, const Args& a, int layer) {
    const int ntiles = moe_tables(F, layer);
    LAS int* tile_e = (LAS int*)(F.lds + LDS_TAB);
    pg8::MoeDown S; S.HID = (const char*)(F.ws + WS_HID); S.W = (const char*)(F.ws + WS_WD); S.tile_e = tile_e; S.nunits = ntiles * 8; S.G = F.G; S.c = F.bx;
    pg8::EpiBf16 E{(bf16_t*)(F.ws + WS_Y), 2048};
    pg8::gemm_phase<pg8::EpiBf16, pg8::MoeDown, false>(F.lds, 512, 512, 512, S, E);
}
template <bool LAST>
DI void phase_combine(const Frame& F, const Args& a, int layer) {
    (void)moe_tables(F, layer);
    LAS int* tstart = (LAS int*)(F.lds + LDS_TAB) + 192;
    const int* SLOT = (const int*)(F.ws + WS_SLOT); const bf16_t* Y = (const bf16_t*)(F.ws + WS_Y); bf16_t* H = (bf16_t*)(F.ws + WS_H); float* RS1 = (float*)(F.ws + WS_RSTD1);
    const float* gn = a.in[I_FINAL_NORM];
    const int gw = F.bx * 8 + F.wave, NGW = F.G * 8;
    u32x4 hn[4], p0n[4], p1n[4]; float w0n = 0.f, w1n = 0.f; int sa[6] = {0, 0, 0, 0, 0, 0};
#define CMB_SLOT(m) do { if ((m) < T) { const int* sp = SLOT + (size_t)(m) * 8; sa[0] = sp[0]; sa[1] = sp[1]; sa[2] = sp[2]; sa[3] = sp[3]; sa[4] = sp[4]; sa[5] = sp[5]; } } while (0)
#define CMB_LOAD(m) do { if ((m) < T) { const bf16_t* y0 = Y + (size_t)(tstart[sa[0]] * 256 + sa[1]) * 2048; const bf16_t* y1 = Y + (size_t)(tstart[sa[3]] * 256 + sa[4]) * 2048; const bf16_t* hr_ = H + (size_t)(m) * 2048; \
        w0n = __int_as_float(sa[2]); w1n = __int_as_float(sa[5]); \
        _Pragma("unroll") for (int j = 0; j < 4; ++j) { const int o = (F.lane + 64 * j) * 8; hn[j] = *(const u32x4*)(hr_ + o); p0n[j] = *(const u32x4*)(y0 + o); p1n[j] = *(const u32x4*)(y1 + o); } } } while (0)
    CMB_SLOT(gw); CMB_LOAD(gw); CMB_SLOT(gw + NGW);
    for (int m = gw; m < T; m += NGW) {
        u32x4 hv[4], p0[4], p1[4]; const float w0 = w0n, w1 = w1n;
#pragma unroll
        for (int j = 0; j < 4; ++j) { hv[j] = hn[j]; p0[j] = p0n[j]; p1[j] = p1n[j]; }
        CMB_LOAD(m + NGW); CMB_SLOT(m + 2 * NGW);
        bf16_t* hr = H + (size_t)m * 2048;
        float v[4][8]; float ss = 0.f;
#pragma unroll
        for (int j = 0; j < 4; ++j) { const int o = (F.lane + 64 * j) * 8; float hf[8], y0f[8], y1f[8]; unpack8(hv[j], hf); unpack8(p0[j], y0f); unpack8(p1[j], y1f);
#pragma unroll
            for (int q = 0; q < 8; ++q) v[j][q] = hf[q] + w0 * y0f[q] + w1 * y1f[q];
            if (!LAST) { const u32x4 wv = pack8(v[j]); *(u32x4*)(hr + o) = wv; unpack8(wv, v[j]); }
#pragma unroll
            for (int q = 0; q < 8; ++q) ss += v[j][q] * v[j][q]; }
        const float rstd = rsqrtf(wsum(ss) * (1.f / D) + EPS);
        if (LAST) {
            float* orow = a.out + (size_t)m * 2048;
#pragma unroll
            for (int j = 0; j < 4; ++j) { const int o = (F.lane + 64 * j) * 8; const f32x4 g0 = *(const f32x4*)(gn + o), g1 = *(const f32x4*)(gn + o + 4);
                *(f32x4*)(orow + o) = (f32x4){v[j][0] * rstd * g0[0], v[j][1] * rstd * g0[1], v[j][2] * rstd * g0[2], v[j][3] * rstd * g0[3]};
                *(f32x4*)(orow + o + 4) = (f32x4){v[j][4] * rstd * g1[0], v[j][5] * rstd * g1[1], v[j][6] * rstd * g1[2], v[j][7] * rstd * g1[3]}; }
        } else if (F.lane == 0) RS1[m] = rstd;
    }
#undef CMB_SLOT
#undef CMB_LOAD
}

DI void phase_pre1(const Frame& F, const Args& a) {
    const bf16_t* PR = (const bf16_t*)(F.ws + WS_PROJ);
    float* BCUM = (float*)(F.ws + WS_ROWS); float* GMB = BCUM + 65536; float* PMAX = BCUM + 131072; float* WV = BCUM + 196608;
    const int gw = F.bx * 8 + F.wave, NGW = F.G * 8;
    for (int task = gw; task < 512; task += NGW) { const int h = task & 3, c = (task >> 2) & 31, b = task >> 7, bh = b * 4 + h; const size_t row0 = (size_t)(b * SEQ + c * 128);
        const bf16_t* P = PR + row0 * PLD; const int s0 = 2 * F.lane, s1 = s0 + 1; const float fb = a.in[I_ML_FB][h], ib = a.in[I_ML_IB][h];
        const float lf0 = logsigmoid_(bf2f(P[(size_t)s0 * PLD + P1_F + h]) + fb), lf1 = logsigmoid_(bf2f(P[(size_t)s1 * PLD + P1_F + h]) + fb);
        const float ig0 = bf2f(P[(size_t)s0 * PLD + P1_I + h]) + ib, ig1 = bf2f(P[(size_t)s1 * PLD + P1_I + h]) + ib;
        float bc0, bc1; wscan_sum(lf0, lf1, F.lane, bc0, bc1);
        const float g0 = ig0 - bc0, g1 = ig1 - bc1; float pm0, pm1; wscan_max(g0, g1, F.lane, pm0, pm1);
        const float blast = __shfl(bc1, 63); const float wl0 = blast + g0, wl1 = blast + g1; const float mloc = wmax(fmaxf(wl0, wl1));
        BCUM[(row0 + s0) * 4 + h] = bc0; BCUM[(row0 + s1) * 4 + h] = bc1; GMB[(row0 + s0) * 4 + h] = g0; GMB[(row0 + s1) * 4 + h] = g1;
        PMAX[(row0 + s0) * 4 + h] = pm0; PMAX[(row0 + s1) * 4 + h] = pm1; WV[(row0 + s0) * 4 + h] = __expf(wl0 - mloc); WV[(row0 + s1) * 4 + h] = __expf(wl1 - mloc);
        if (F.lane == 0) { float* MS = (float*)(F.ws + WS_SMALL + 16384); MS[(bh * 32 + c) * 2] = blast; MS[(bh * 32 + c) * 2 + 1] = mloc; } }
    const int gt = F.bx * 512 + F.tid, NT_ = F.G * 512;
    const float* cw = a.in[I_ML_CONVW]; const float* cb = a.in[I_ML_CONVB];
    bf16_t* QC = (bf16_t*)(F.ws + WS_QC); bf16_t* KC = (bf16_t*)(F.ws + WS_KC);
    for (int task = F.bx * 384 + F.tid; F.tid < 384 && task < 256 * 384; task += F.G * 384) { const int ch = (task % 384) * 8, r0 = (task / 384) * 64;
        float w[4][8], bs[8];
#pragma unroll
        for (int tp = 0; tp < 4; ++tp) { const f32x4 w0 = *(const f32x4*)(cw + tp * 3072 + ch), w1 = *(const f32x4*)(cw + tp * 3072 + ch + 4); w[tp][0] = w0[0]; w[tp][1] = w0[1]; w[tp][2] = w0[2]; w[tp][3] = w0[3]; w[tp][4] = w1[0]; w[tp][5] = w1[1]; w[tp][6] = w1[2]; w[tp][7] = w1[3]; }
        { const f32x4 b0 = *(const f32x4*)(cb + ch), b1 = *(const f32x4*)(cb + ch + 4); bs[0] = b0[0]; bs[1] = b0[1]; bs[2] = b0[2]; bs[3] = b0[3]; bs[4] = b1[0]; bs[5] = b1[1]; bs[6] = b1[2]; bs[7] = b1[3]; }
        const bf16_t* src = PR + (size_t)r0 * PLD + ch; const float sc = ch < 1536 ? 0.05103103630798288f : 1.f;
        bf16_t* dst = (ch < 1536 ? QC + ch : KC + (ch - 1536)) + (size_t)r0 * 1536;
        float x1[8], x2[8], x3[8];
        if ((r0 & (SEQ - 1)) != 0) { unpack8(*(const u32x4*)(src - PLD), x1); unpack8(*(const u32x4*)(src - 2 * PLD), x2); unpack8(*(const u32x4*)(src - 3 * PLD), x3); }
        else {
#pragma unroll
            for (int j = 0; j < 8; ++j) { x1[j] = 0.f; x2[j] = 0.f; x3[j] = 0.f; } }
#pragma unroll 8
        for (int i = 0; i < 64; ++i) { float x0[8], y[8]; unpack8(*(const u32x4*)(src + (size_t)i * PLD), x0);
#pragma unroll
            for (int j = 0; j < 8; ++j) { y[j] = silu_(bs[j] + w[0][j] * x3[j] + w[1][j] * x2[j] + w[2][j] * x1[j] + w[3][j] * x0[j]) * sc; x3[j] = x2[j]; x2[j] = x1[j]; x1[j] = x0[j]; }
            *(u32x4*)(dst + (size_t)i * 1536) = pack8(y); }
    }
}

DI void mlstm_local_unit(const Frame& F_, const Args& a, int u) {
    Frame F = F_; { int tz = F_.tid; asm volatile("" : "+v"(tz)); F.tid = tz; F.lane = tz & 63; }
    const int h = u & 3, c = (u >> 2) & 31, b = u >> 7, bh = b * 4 + h, w = F.wave;
    const size_t row0 = (size_t)(b * SEQ + c * 128);
    const bf16_t* P = (const bf16_t*)(F.ws + WS_PROJ) + row0 * PLD;
    constexpr int PK = 784;
    ldsp KI = F.lds, VI = F.lds + 100352;
    const bf16_t* KC = (const bf16_t*)(F.ws + WS_KC) + row0 * 1536 + h * 384; const float* WV = (const float*)(F.ws + WS_ROWS) + 196608 + row0 * 4 + h;
    u32x4 kr[12];
#pragma unroll
    for (int i = 0; i < 12; ++i) { const int item = F.tid + 512 * i, s = item / 48, d0 = (item % 48) * 8; kr[i] = *(const u32x4*)(KC + (size_t)s * 1536 + d0); }
    u32x4 vr[4];
#pragma unroll
    for (int i = 0; i < 4; ++i) { const int item = F.tid + 512 * i, s = item >> 4, e0 = (item & 15) * 8; vr[i] = *(const u32x4*)(P + (size_t)s * PLD + P1_V + h * 384 + e0); }
#pragma unroll
    for (int i = 0; i < 12; ++i) { const int item = F.tid + 512 * i, s = item / 48, d0 = (item % 48) * 8; const float ws_ = WV[s * 4]; float y[8]; unpack8(kr[i], y);
#pragma unroll
        for (int j = 0; j < 8; ++j) y[j] *= ws_;
        *(LAS u32x4*)(KI + s * PK + d0 * 2) = pack8(y); }
    const int fr = F.lane & 15, fq = F.lane >> 4;
    ldsp ktr = KI + (8 * (F.lane >> 4) + ((F.lane & 15) >> 2)) * PK + (F.lane & 3) * 32, vtr = VI + tr_lane_off(F.lane, PT) + (16 * w) * 2;
    const bf16x8 ones = {0x3F80, 0x3F80, 0x3F80, 0x3F80, 0x3F80, 0x3F80, 0x3F80, 0x3F80};
#pragma unroll 1
    for (int et = 0; et < 3; ++et) {
#pragma unroll
        for (int i = 0; i < 4; ++i) { const int item = F.tid + 512 * i, s = item >> 4, e0 = (item & 15) * 8; *(LAS u32x4*)(VI + s * PT + e0 * 2) = vr[i]; }
        __syncthreads();
        if (et < 2) {
#pragma unroll
            for (int i = 0; i < 4; ++i) { const int item = F.tid + 512 * i, s = item >> 4, e0 = (item & 15) * 8; vr[i] = *(const u32x4*)(P + (size_t)s * PLD + P1_V + h * 384 + (et + 1) * 128 + e0); } }
        f32x4 acc[24]; zero_acc(acc); f32x4 an[3]; zero_acc(an);
        {
#pragma unroll
        for (int ks = 0; ks < 4; ++ks) { const bf16x8 av = tr_frag(vtr, ks * 32 * PT, PT);
#pragma unroll
            for (int n0 = 0; n0 < 24; n0 += 8) { bf16x8 bv[8];
#pragma unroll
                for (int i = 0; i < 8; ++i) bv[i] = tr_frag(ktr, ks * 32 * PK + ((n0 + i) >> 2) * 128 + ((n0 + i) & 3) * 8, PK);
#pragma unroll
                for (int i = 0; i < 8; ++i) acc[n0 + i] = __builtin_amdgcn_mfma_f32_16x16x32_bf16(bv[i], av, acc[n0 + i], 0, 0, 0); } }
        asm volatile("" ::: "memory"); }
        if (et == 0) {
#pragma unroll
            for (int ks = 0; ks < 4; ++ks)
#pragma unroll
                for (int q = 0; q < 3; ++q) { const int nt = 3 * w + q; const bf16x8 bv = tr_frag(ktr, ks * 32 * PK + (nt >> 2) * 128 + (nt & 3) * 8, PK); an[q] = __builtin_amdgcn_mfma_f32_16x16x32_bf16(bv, ones, an[q], 0, 0, 0); }
            if (fr == 0) { float* MN = (float*)(F.ws + WS_MN) + (size_t)(bh * 32 + c) * 384 + fq * 16;
#pragma unroll
                for (int q = 0; q < 3; ++q) { const int nt = 3 * w + q; *(f32x4*)(MN + (nt >> 2) * 64 + (nt & 3) * 4) = an[q]; } } }
        bf16_t* dst = (bf16_t*)(F.ws + WS_MC) + ((size_t)(bh * 32 + c) * 384 + et * 128 + 16 * w + fr) * 384 + fq * 16;
#pragma unroll
        for (int p = 0; p < 6; ++p) { u32x4 o0, o1; o0.x = pk2(acc[4 * p][0], acc[4 * p][1]); o0.y = pk2(acc[4 * p][2], acc[4 * p][3]); o0.z = pk2(acc[4 * p + 1][0], acc[4 * p + 1][1]); o0.w = pk2(acc[4 * p + 1][2], acc[4 * p + 1][3]);
            o1.x = pk2(acc[4 * p + 2][0], acc[4 * p + 2][1]); o1.y = pk2(acc[4 * p + 2][2], acc[4 * p + 2][3]); o1.z = pk2(acc[4 * p + 3][0], acc[4 * p + 3][1]); o1.w = pk2(acc[4 * p + 3][2], acc[4 * p + 3][3]);
            *(u32x4*)(dst + p * 64) = o0; *(u32x4*)(dst + p * 64 + 8) = o1; }
        __syncthreads();
    }
}

DI void s5_local_unit(const Frame& F_, const Args& a, int u) {
    Frame F = F_; { int tz = F_.tid; asm volatile("" : "+v"(tz)); F.tid = tz; F.lane = tz & 63; }
    const int g = u >> 3, cb = u & 7, w = F.wave, fr = F.lane & 15, fq = F.lane >> 4;
    ldsp PL = F.lds, BL = F.lds + 34816, UL = F.lds + 45056 + w * 4096;
    { const bf16_t* PW = (const bf16_t*)(F.ws + WS_S5G) + (size_t)g * 128 * 128; const bf16_t* BB = (const bf16_t*)(F.ws + WS_S5G) + (size_t)32 * 128 * 128 + (size_t)g * 128 * 32;
#pragma unroll
      for (int i = 0; i < 4; ++i) { const int item = F.tid + 512 * i, j = item >> 4, c0 = (item & 15) * 8; *(LAS u32x4*)(PL + j * PT + c0 * 2) = *(const u32x4*)(PW + (size_t)j * 128 + c0); }
      { const int r = F.tid >> 2, c0 = (F.tid & 3) * 8; *(LAS u32x4*)(BL + r * 80 + c0 * 2) = *(const u32x4*)(BB + (size_t)r * 32 + c0); } }
    __syncthreads();
    bf16x8 bb[8];
#pragma unroll
    for (int nt = 0; nt < 8; ++nt) bb[nt] = *(const LAS bf16x8*)(BL + (nt * 16 + fr) * 80 + fq * 16);
#pragma unroll 1
    for (int rnd = 0; rnd < 2; ++rnd) {
        const int mi = cb * 16 + rnd * 8 + w, b = mi >> 5, c = mi & 31; const size_t row0 = (size_t)(b * SEQ + c * 128);
        { const bf16_t* P = (const bf16_t*)(F.ws + WS_PROJ) + row0 * PLD + P1_U + g * 16 + (F.lane & 1) * 8;
#pragma unroll
          for (int i = 0; i < 4; ++i) { const int t = (F.lane >> 1) + 32 * i; *(LAS u32x4*)(UL + t * 32 + (F.lane & 1) * 16) = *(const u32x4*)(P + (size_t)t * PLD); } }
        LDS_WAIT();
        f32x4 es[8]; zero_acc(es);
#pragma unroll 1
        for (int rt = 0; rt < 8; ++rt) {
            bf16x8 av = *(const LAS bf16x8*)(UL + (16 * rt + fr) * 32 + (fq & 1) * 16); if (fq >= 2) av = (bf16x8){0, 0, 0, 0, 0, 0, 0, 0};
#pragma unroll
            for (int nt = 0; nt < 8; ++nt) { const f32x4 bu = __builtin_amdgcn_mfma_f32_16x16x32_bf16(bb[nt], av, (f32x4){0.f, 0.f, 0.f, 0.f}, 0, 0, 0);
                const u32x2 pw = *(const LAS u32x2*)(PL + (16 * rt + fr) * PT + (nt * 16 + fq * 4) * 2); const float p0r = bflo(pw.x), p0i = bfhi(pw.x), p1r = bflo(pw.y), p1i = bfhi(pw.y);
                es[nt][0] += p0r * bu[0] - p0i * bu[1]; es[nt][1] += p0r * bu[1] + p0i * bu[0]; es[nt][2] += p1r * bu[2] - p1i * bu[3]; es[nt][3] += p1r * bu[3] + p1i * bu[2]; }
        }
#pragma unroll
        for (int nt = 0; nt < 8; ++nt)
#pragma unroll
            for (int j = 0; j < 4; ++j) { float v = es[nt][j]; v += __shfl_xor(v, 1); v += __shfl_xor(v, 2); v += __shfl_xor(v, 4); v += __shfl_xor(v, 8); es[nt][j] = v; }
        if (fr == 0) { float* E = (float*)(F.ws + WS_S5E) + (size_t)((b * 32 + g) * 32 + c) * 128 + fq * 4;
#pragma unroll
            for (int nt = 0; nt < 8; ++nt) *(f32x4*)(E + nt * 16) = es[nt]; }
        LDS_WAIT();
    }
    __syncthreads();
}

template <int NS> DI void c_scan(bf16_t* (&p)[NS], const int (&sb)[NS], const LAS float* scp, const LAS float* scn) {
    float run[NS][8];
#pragma unroll
    for (int s_ = 0; s_ < NS; ++s_)
#pragma unroll
        for (int j = 0; j < 8; ++j) run[s_][j] = 0.f;
#pragma unroll 8
    for (int c = 0; c < 32; ++c) { float x[NS][8];
#pragma unroll
        for (int s_ = 0; s_ < NS; ++s_) unpack8(*(const u32x4*)(p[s_] + (size_t)c * 147456), x[s_]);
#pragma unroll
        for (int s_ = 0; s_ < NS; ++s_) *(u32x4*)(p[s_] + (size_t)c * 147456) = pack8(run[s_]);
#pragma unroll
        for (int s_ = 0; s_ < NS; ++s_) { const float sp = scp[sb[s_] + c], sn = scn[sb[s_] + c];
#pragma unroll
            for (int j = 0; j < 8; ++j) run[s_][j] = sp * run[s_][j] + sn * x[s_][j]; } }
}
DI void phase_odd_scan(const Frame& F, const Args& a) {
    LAS float* scp = (LAS float*)F.lds; LAS float* scn = scp + 512; LAS float* msl = scp + 1024;
    { const float* MSg = (const float*)(F.ws + WS_SMALL + 16384); msl[F.tid] = MSg[F.tid]; msl[512 + F.tid] = MSg[512 + F.tid]; }
    __syncthreads();
    if (F.tid < 16) { const int bh = F.tid; float* MST = (float*)(F.ws + WS_SMALL + 32768); float m = -INFINITY;
        for (int c = 0; c < 32; ++c) { const float bl = msl[(bh * 32 + c) * 2], ml = msl[(bh * 32 + c) * 2 + 1]; const float mn = fmaxf(bl + m, ml);
            scp[bh * 32 + c] = __expf(bl + m - mn); scn[bh * 32 + c] = __expf(ml - mn); if (F.bx == 0) MST[bh * 32 + c] = m; m = mn; } }
    __syncthreads();
    const int gt = F.bx * 512 + F.tid, NT_ = F.G * 512;
    { const int q = (8192 + F.G - 1) / F.G, qm = (1536 + F.G - 1) / F.G, t = 511 - F.tid;
      if (t < q) { const int it = F.bx * q + t;
          if (it < 8192) { const int b = it >> 11, g = (it >> 6) & 31, n = it & 63; const f32x2 a128 = ((const f32x2*)(F.ws + WS_S5T))[2048 + g * 64 + n];
              f32x2* p = (f32x2*)(F.ws + WS_S5E) + (size_t)((b * 32 + g) * 32) * 64 + n; float sr = 0.f, si = 0.f;
#pragma unroll
              for (int c = 0; c < 32; ++c) { const f32x2 e = p[c * 64]; p[c * 64] = (f32x2){sr, si}; const float nr = a128.x * sr - a128.y * si + e.x, ni = a128.x * si + a128.y * sr + e.y; sr = nr; si = ni; } } }
      else if (t < q + qm) { const int it = F.bx * qm + (t - q);
          if (it < 1536) { const int bh = it / 96, v = it % 96; float* p = (float*)(F.ws + WS_MN) + (size_t)bh * 32 * 384 + v * 4;
              f32x4 run = (f32x4){0.f, 0.f, 0.f, 0.f};
#pragma unroll
              for (int c = 0; c < 32; ++c) { const f32x4 x = *(const f32x4*)(p + c * 384); *(f32x4*)(p + c * 384) = run; run = run * scp[bh * 32 + c] + x * scn[bh * 32 + c]; } } } }
    constexpr int TOT = 16 * 18432;
    auto colp = [&](int it) { const int bh = it / 18432, v = it % 18432; return (bf16_t*)(F.ws + WS_MC) + (size_t)bh * 32 * 147456 + (size_t)v * 8; };
    if (2 * NT_ <= TOT && TOT < 3 * NT_) {
        const int L = TOT - 2 * NT_, per = (L + F.G - 1) / F.G, i2 = 2 * NT_ + F.bx * per + F.tid;
        if (F.tid < per && i2 < TOT) { bf16_t* p[3] = {colp(gt), colp(gt + NT_), colp(i2)}; const int sb[3] = {(gt / 18432) * 32, ((gt + NT_) / 18432) * 32, (i2 / 18432) * 32}; c_scan<3>(p, sb, scp, scn); }
        else { bf16_t* p[2] = {colp(gt), colp(gt + NT_)}; const int sb[2] = {(gt / 18432) * 32, ((gt + NT_) / 18432) * 32}; c_scan<2>(p, sb, scp, scn); }
    } else {
        for (int it = gt; it < TOT; it += NT_) { bf16_t* p[1] = {colp(it)}; const int sb[1] = {(it / 18432) * 32}; c_scan<1>(p, sb, scp, scn); }
    }
}

struct MlCtx { const bf16_t* P; const bf16_t* Cg; const bf16_t* Kc; int h; };
template <int I> DI void ml_load(const MlCtx& m, int tidz, u32x4 (&r)[4]) {
#pragma unroll
    for (int i = 0; i < 4; ++i) { const int item = tidz + 512 * i, s = item >> 4, c0 = (item & 15) * 8;
        if constexpr (I < 3) r[i] = *(const u32x4*)(m.Kc + (size_t)s * 1536 + I * 128 + c0);
        else if constexpr (((I - 3) & 3) < 3) r[i] = *(const u32x4*)(m.Cg + (size_t)(((I - 3) >> 2) * 128 + s) * 384 + ((I - 3) & 3) * 128 + c0);
        else r[i] = *(const u32x4*)(m.P + (size_t)s * PLD + P1_V + m.h * 384 + ((I - 3) >> 2) * 128 + c0); }
}
DI void ml_store(int tidz, ldsp buf, const u32x4 (&r)[4]) {
#pragma unroll
    for (int i = 0; i < 4; ++i) { const int item = tidz + 512 * i, s = item >> 4, c0 = (item & 15) * 8; *(LAS u32x4*)(buf + s * PT + c0 * 2) = r[i]; }
}
template <int I> DI void ml_compute(const Frame& F, ldsp buf, ldsp Pm, const bf16x8 (&qf)[12], f32x4 (&as)[8], f32x4 (&ao)[8], int fr, int fq) {
    const int w = F.wave;
    if constexpr (I < 3) {
#pragma unroll
        for (int ks = 0; ks < 4; ++ks) { bf16x8 bv[8];
#pragma unroll
            for (int nt = 0; nt < 8; ++nt) bv[nt] = *(const LAS bf16x8*)(buf + (nt * 16 + fr) * PT + (ks * 32 + fq * 8) * 2);
#pragma unroll
            for (int nt = 0; nt < 8; ++nt) as[nt] = __builtin_amdgcn_mfma_f32_16x16x32_bf16(bv[nt], qf[I * 4 + ks], as[nt], 0, 0, 0); }
    } else if constexpr (((I - 3) & 3) < 3) {
        constexpr int j = (I - 3) & 3;
#pragma unroll
        for (int ks = 0; ks < 4; ++ks) { bf16x8 bv[8];
#pragma unroll
            for (int nt = 0; nt < 8; ++nt) bv[nt] = *(const LAS bf16x8*)(buf + permb_row(nt, fr) * PT + (ks * 32 + fq * 8) * 2);
#pragma unroll
            for (int nt = 0; nt < 8; ++nt) ao[nt] = __builtin_amdgcn_mfma_f32_16x16x32_bf16(bv[nt], qf[j * 4 + ks], ao[nt], 0, 0, 0); }
    } else {
        ldsp vtr = buf + tr_lane_off_p(F.lane, PT);
#pragma unroll
        for (int ks = 0; ks < 4; ++ks) if (ks <= (w >> 1)) { const bf16x8 av = *(const LAS bf16x8*)(Pm + (16 * w + fr) * PT + (ks * 32 + fq * 8) * 2); bf16x8 bv[8];
#pragma unroll
            for (int nt = 0; nt < 8; ++nt) bv[nt] = tr_frag(vtr, ks * 32 * PT + permb_off(nt), PT);
#pragma unroll
            for (int nt = 0; nt < 8; ++nt) ao[nt] = __builtin_amdgcn_mfma_f32_16x16x32_bf16(bv[nt], av, ao[nt], 0, 0, 0); }
    }
}
DI void mlstm_out_unit(const Frame& F_, const Args& a, int u) {
    Frame F = F_; { int tz = F_.tid; asm volatile("" : "+v"(tz)); F.tid = tz; F.lane = tz & 63; }
    const int h = u & 3, c = (u >> 2) & 31, b = u >> 7, bh = b * 4 + h, w = F.wave;
    const size_t row0 = (size_t)(b * SEQ + c * 128);
    MlCtx m; m.P = (const bf16_t*)(F.ws + WS_PROJ) + row0 * PLD; m.Cg = (const bf16_t*)(F.ws + WS_MC) + (size_t)(bh * 32 + c) * 147456; m.Kc = (const bf16_t*)(F.ws + WS_KC) + row0 * 1536 + h * 384; m.h = h;
    ldsp X0 = F.lds, X1 = F.lds + 34816, Pm = F.lds + 69632;
    LAS float* gmb = (LAS float*)(F.lds + 104448); LAS float* nst = gmb + 128;
    u32x4 ra[4], rb[4];
    ml_load<0>(m, F.tid, ra); ml_load<1>(m, F.tid, rb);
    const float* ROWS = (const float*)(F.ws + WS_ROWS) + row0 * 4 + h;
    if (F.tid < 128) gmb[F.tid] = ROWS[65536 + F.tid * 4]; else nst[F.tid - 128] = ((const float*)(F.ws + WS_MN))[(size_t)(bh * 32 + c) * 384 + F.tid - 128];
    const int fr = F.lane & 15, fq = F.lane >> 4, l = 16 * w + fr;
    const float bl = ROWS[l * 4], pml = ROWS[131072 + l * 4], mst = ((const float*)(F.ws + WS_SMALL + 32768))[bh * 32 + c];
    const float mil = bl + mst, mtl = fmaxf(bl + pml, mil), iscl = __expf(mil - mtl);
    bf16x8 qf[12]; float qn = 0.f;
    { const bf16_t* qrow = (const bf16_t*)(F.ws + WS_QC) + (row0 + l) * 1536 + h * 384 + fq * 8;
#pragma unroll
      for (int ks = 0; ks < 12; ++ks) qf[ks] = __builtin_bit_cast(bf16x8, *(const u32x4*)(qrow + ks * 32)); }
    ml_store(F.tid, X0, ra);
    __syncthreads();
#pragma unroll
    for (int ks = 0; ks < 12; ++ks) { float y[8]; unpack8(__builtin_bit_cast(u32x4, qf[ks]), y);
#pragma unroll
        for (int j = 0; j < 8; ++j) qn += y[j] * nst[ks * 32 + fq * 8 + j]; }
    qn += __shfl_xor(qn, 16); qn += __shfl_xor(qn, 32);
    f32x4 as[8]; zero_acc(as); f32x4 ao[8]; zero_acc(ao);
    float den = 0.f, dn = 0.f, sm = 0.f, sq = 0.f;
    bf16_t* orow = (bf16_t*)(F.ws + WS_MIX) + (row0 + l) * 2048 + h * 384;
    ldsp S0 = F.lds + 106496 + l * PT + 32 * fq; u32x4 h1[4], h2[4], og[12];
    const bf16_t* orow_g = m.P + (size_t)l * PLD + P1_O + h * 384;
#define ML_STEP(I) do { int tidz = F.tid; asm volatile("" : "+v"(tidz)); \
        if constexpr ((I) == 14) { _Pragma("unroll") for (int k = 0; k < 12; ++k) og[k] = *(const u32x4*)(orow_g + (k >> 1) * 64 + 16 * fq + 8 * (k & 1)); __builtin_amdgcn_sched_barrier(0); } \
        if constexpr ((I) + 1 < 15) ml_store(tidz, (((I) + 1) & 1) ? X1 : X0, (((I) + 1) & 1) ? rb : ra); \
        if constexpr ((I) + 2 < 15) { if constexpr ((I) & 1) ml_load<(I) + 2>(m, tidz, rb); else ml_load<(I) + 2>(m, tidz, ra); } \
        ml_compute<I>(F, ((I) & 1) ? X1 : X0, Pm, qf, as, ao, fr, fq); \
        if constexpr ((I) == 2) { \
            _Pragma("unroll") for (int nt = 0; nt < 8; ++nt) if (nt <= (w | 1)) { float pv[4]; \
                _Pragma("unroll") for (int j = 0; j < 4; ++j) { const int s = nt * 16 + fq * 4 + j; pv[j] = (nt <= w && s <= l) ? as[nt][j] * __expf(bl + gmb[s] - mtl) : 0.f; den += pv[j]; } \
                u32x2 pw; pw.x = pk2(pv[0], pv[1]); pw.y = pk2(pv[2], pv[3]); *(LAS u32x2*)(Pm + l * PT + (nt * 16 + fq * 4) * 2) = pw; } \
            den += __shfl_xor(den, 16); den += __shfl_xor(den, 32); den += iscl * qn; dn = __builtin_amdgcn_rcpf(fmaxf(fabsf(den), __expf(-mtl))); } \
        if constexpr ((I) >= 3 && (((I) - 3) & 3) == 2) { _Pragma("unroll") for (int nt = 0; nt < 8; ++nt) ao[nt] = ao[nt] * iscl; } \
        if constexpr ((I) >= 3 && (((I) - 3) & 3) == 3) { constexpr int et_ = ((I) - 3) >> 2; \
            _Pragma("unroll") for (int p_ = 0; p_ < 2; ++p_) { u32x4 o0, o1; \
                { const f32x4 h0 = ao[4 * p_] * dn, h1 = ao[4 * p_ + 1] * dn, h2 = ao[4 * p_ + 2] * dn, h3 = ao[4 * p_ + 3] * dn; \
                  sm += ((h0[0] + h0[1]) + (h0[2] + h0[3])) + ((h1[0] + h1[1]) + (h1[2] + h1[3])) + ((h2[0] + h2[1]) + (h2[2] + h2[3])) + ((h3[0] + h3[1]) + (h3[2] + h3[3])); \
                  sq += ((h0[0] * h0[0] + h0[1] * h0[1]) + (h0[2] * h0[2] + h0[3] * h0[3])) + ((h1[0] * h1[0] + h1[1] * h1[1]) + (h1[2] * h1[2] + h1[3] * h1[3])) + ((h2[0] * h2[0] + h2[1] * h2[1]) + (h2[2] * h2[2] + h2[3] * h2[3])) + ((h3[0] * h3[0] + h3[1] * h3[1]) + (h3[2] * h3[2] + h3[3] * h3[3])); \
                  o0.x = pk2(h0[0], h0[1]); o0.y = pk2(h0[2], h0[3]); o0.z = pk2(h1[0], h1[1]); o0.w = pk2(h1[2], h1[3]); o1.x = pk2(h2[0], h2[1]); o1.y = pk2(h2[2], h2[3]); o1.z = pk2(h3[0], h3[1]); o1.w = pk2(h3[2], h3[3]); } \
                if constexpr (et_ == 0) { *(LAS u32x4*)(S0 + 128 * p_) = o0; *(LAS u32x4*)(S0 + 128 * p_ + 16) = o1; } \
                else if constexpr (et_ == 1) { h1[2 * p_] = o0; h1[2 * p_ + 1] = o1; } else { h2[2 * p_] = o0; h2[2 * p_ + 1] = o1; } } \
            _Pragma("unroll") for (int nt = 0; nt < 8; ++nt) ao[nt] = (f32x4){0.f, 0.f, 0.f, 0.f}; } \
        __syncthreads(); } while (0)
    ML_STEP(0); ML_STEP(1); ML_STEP(2); ML_STEP(3); ML_STEP(4); ML_STEP(5); ML_STEP(6); ML_STEP(7); ML_STEP(8); ML_STEP(9); ML_STEP(10); ML_STEP(11); ML_STEP(12); ML_STEP(13); ML_STEP(14);
#undef ML_STEP
    sm += __shfl_xor(sm, 16); sm += __shfl_xor(sm, 32); sq += __shfl_xor(sq, 16); sq += __shfl_xor(sq, 32);
    const float mean = sm * (1.f / 384.f); const float var = fmaxf(sq * (1.f / 384.f) - mean * mean, 0.f);
    const float rstd = rsqrtf(var + EPS);
    const float* ng = a.in[I_ML_NORM] + h * 384;
#pragma unroll
    for (int k = 0; k < 12; ++k) { const int e = (k >> 1) * 64 + 16 * fq + 8 * (k & 1), p_ = (k >> 1) & 1, hf = k & 1; float hv[8], ov[8];
        const u32x4 hq = (k < 4) ? *(const LAS u32x4*)(S0 + 128 * p_ + 16 * hf) : ((k < 8) ? h1[2 * p_ + hf] : h2[2 * p_ + hf]);
        unpack8(hq, hv); unpack8(og[k], ov);
        const f32x4 n0 = *(const f32x4*)(ng + e), n1 = *(const f32x4*)(ng + e + 4); const float nn[8] = {n0[0], n0[1], n0[2], n0[3], n1[0], n1[1], n1[2], n1[3]}; float o[8];
#pragma unroll
        for (int q = 0; q < 8; ++q) o[q] = (hv[q] - mean) * rstd * nn[q] * sigmoid_(ov[q]);
        *(u32x4*)(orow + e) = pack8(o); }
    __syncthreads();
}

DI void s5_out_unit(const Frame& F_, const Args& a, int u) {
    Frame F = F_; { int tz = F_.tid; asm volatile("" : "+v"(tz)); F.tid = tz; F.lane = tz & 63; }
    const int g = u >> 3, cb = u & 7, w = F.wave;
    constexpr int PKN = 4112;
    ldsp KN = F.lds, WL = F.lds + 65792, CL = F.lds + 100608, UL = F.lds + 104960 + w * 4096;
    { const bf16_t* Kg = (const bf16_t*)(F.ws + WS_S5K) + (size_t)g * 16 * 2048;
#pragma unroll
      for (int i = 0; i < 8; ++i) { const int item = F.tid + 512 * i, r = item >> 8, c0 = (item & 255) * 8; *(LAS u32x4*)(KN + r * PKN + c0 * 2) = *(const u32x4*)(Kg + (size_t)r * 2048 + c0); }
      const float* Wg = (const float*)(F.ws + WS_S5W) + (size_t)g * 128 * 128;
#pragma unroll
      for (int i = 0; i < 4; ++i) { const int item = F.tid + 512 * i, t = item >> 4, c0 = (item & 15) * 8; const f32x4 w0 = *(const f32x4*)(Wg + (size_t)t * 128 + c0), w1 = *(const f32x4*)(Wg + (size_t)t * 128 + c0 + 4);
          *(LAS u32x4*)(WL + t * PT + c0 * 2) = (u32x4){pk2(w0[0], w0[1]), pk2(w0[2], w0[3]), pk2(w1[0], w1[1]), pk2(w1[2], w1[3])}; }
      if (F.tid < 256) { const int r = F.tid >> 4, c0 = (F.tid & 15) * 8; *(LAS u32x4*)(CL + r * PT + c0 * 2) = *(const u32x4*)((const bf16_t*)(F.ws + WS_S5C) + (size_t)(g * 16 + r) * 128 + c0); } }
    __syncthreads();
    const int fr = F.lane & 15, fq = F.lane >> 4;
    const f32x4 dk = *(const f32x4*)(a.in[I_S5_D] + g * 16 + fq * 4);
    bf16x8 cf[4];
#pragma unroll
    for (int k2 = 0; k2 < 4; ++k2) cf[k2] = *(const LAS bf16x8*)(CL + fr * PT + (k2 * 32 + fq * 8) * 2);
#pragma unroll 1
    for (int rnd = 0; rnd < 2; ++rnd) {
        const int mi = cb * 16 + rnd * 8 + w, b = mi >> 5, c = mi & 31; const size_t row0 = (size_t)(b * SEQ + c * 128);
        { const bf16_t* P = (const bf16_t*)(F.ws + WS_PROJ) + row0 * PLD + P1_U + g * 16 + (F.lane & 1) * 8;
#pragma unroll
          for (int i = 0; i < 4; ++i) { const int t = (F.lane >> 1) + 32 * i; *(LAS u32x4*)(UL + t * 32 + (((F.lane & 1) ^ ((F.lane >> 4) & 1)) * 16)) = *(const u32x4*)(P + (size_t)t * PLD); } }
        f32x4 acc[8]; zero_acc(acc);
        {
            const float* Sin = (const float*)(F.ws + WS_S5E) + (size_t)((b * 32 + g) * 32 + c) * 128 + fq * 8;
#pragma unroll
            for (int k2 = 0; k2 < 4; ++k2) { const f32x4 s0 = *(const f32x4*)(Sin + k2 * 32), s1 = *(const f32x4*)(Sin + k2 * 32 + 4);
#pragma unroll
                for (int rt = 0; rt < 8; ++rt) { float wv_[8]; unpack8(*(const LAS u32x4*)(WL + (16 * rt + fr) * PT + (k2 * 32 + fq * 8) * 2), wv_);
                    u32x4 z; z.x = pk2(wv_[0] * s0[0] - wv_[1] * s0[1], wv_[0] * s0[1] + wv_[1] * s0[0]); z.y = pk2(wv_[2] * s0[2] - wv_[3] * s0[3], wv_[2] * s0[3] + wv_[3] * s0[2]);
                    z.z = pk2(wv_[4] * s1[0] - wv_[5] * s1[1], wv_[4] * s1[1] + wv_[5] * s1[0]); z.w = pk2(wv_[6] * s1[2] - wv_[7] * s1[3], wv_[6] * s1[3] + wv_[7] * s1[2]);
                    acc[rt] = __builtin_amdgcn_mfma_f32_16x16x32_bf16(cf[k2], __builtin_bit_cast(bf16x8, z), acc[rt], 0, 0, 0); } }
        }
        LDS_WAIT();
        {
            ldsp kb = KN + fr * PKN + fq * 16; const int tl = fr - (fq >> 1);
#pragma unroll 1
            for (int k8 = 0; k8 < 8; ++k8) {
                const int tb_ = tl - 2 * k8; ldsp up = UL + tb_ * 32 + (((fq & 1) ^ ((tb_ >> 3) & 1)) * 16);
                ldsp kp = kb + k8 * 64; bf16x8 fv[8], kf[8];
#pragma unroll
                for (int d = 0; d < 8; ++d) fv[d] = *(const LAS bf16x8*)(up + d * 512);
#pragma unroll
                for (int sg = 0; sg < 8; ++sg) kf[sg] = *(const LAS bf16x8*)(kp + sg * 512);
                if (tb_ < 0) fv[0] = (bf16x8){0, 0, 0, 0, 0, 0, 0, 0};
#pragma unroll
                for (int sg = 0; sg < 8; ++sg)
#pragma unroll
                    for (int d = 0; d + sg < 8; ++d) acc[sg + d] = __builtin_amdgcn_mfma_f32_16x16x32_bf16(kf[sg], fv[d], acc[sg + d], 0, 0, 0);
            }
        }
        bf16_t* Y5 = (bf16_t*)(F.ws + WS_Y5) + row0 * 512 + g * 16 + fq * 4;
#pragma unroll
        for (int rt = 0; rt < 8; ++rt) { const int t = 16 * rt + fr; const u32x2 uv = *(const LAS u32x2*)(UL + t * 32 + ((((fq >> 1) ^ (fr >> 3)) & 1) * 16) + (fq & 1) * 8);
            u32x2 o; o.x = pk2(gelu_(acc[rt][0] + dk[0] * bflo(uv.x)), gelu_(acc[rt][1] + dk[1] * bfhi(uv.x))); o.y = pk2(gelu_(acc[rt][2] + dk[2] * bflo(uv.y)), gelu_(acc[rt][3] + dk[3] * bfhi(uv.y)));
            *(u32x2*)(Y5 + (size_t)t * 512) = o; }
        LDS_WAIT();
    }
    __syncthreads();
}

__global__ void __launch_bounds__(512, 2) fwd(Args a) {
    extern __shared__ __attribute__((aligned(16))) unsigned char shm[];
    Frame F; F.lds = (ldsp)shm; F.tid = threadIdx.x; F.lane = F.tid & 63; F.wave = __builtin_amdgcn_readfirstlane(F.tid >> 6); F.G = gridDim.x; F.bx = blockIdx.x; F.ws = a.ws;
    volatile LAS unsigned* LC = (volatile LAS unsigned*)(F.lds + LDS_CTL);
    if (F.tid < 128) LC[F.tid] = 0u;
    __syncthreads();
#if MK_SINGLE
    XcdBarrier bar = xcd_barrier_post((unsigned*)(F.ws + WS_CTL) + CW_BAR, LC + 8);
#define GRID_BAR() xcd_barrier(bar)
#else
#define GRID_BAR() do {} while (0)
#endif
    const int lo = a.ph_lo, hi = a.ph_hi;
#ifdef ONLY_PHASE
#define IN(k) ((k) == ONLY_PHASE && lo <= (k) && (k) < hi)
#else
#define IN(k) (lo <= (k) && (k) < hi)
#endif
#define SEAM(k) do { if (IN(k) && IN((k) + 1)) GRID_BAR(); } while (0)
    bf16_t* XN = (bf16_t*)(F.ws + WS_XN); bf16_t* MIX = (bf16_t*)(F.ws + WS_MIX); bf16_t* PROJ = (bf16_t*)(F.ws + WS_PROJ);

    if (IN(PH_PRO)) { phase_prologue(F, a); } SEAM(PH_PRO);
    if (IN(PH_INPROJ0)) { pg8::Tile2D S; S.init(F.ws + WS_H, F.ws + WS_WIN0, T, PLD, 2048, 2048, F.G, F.bx); pg8::EpiBf16S E{PROJ, PLD, (const float*)(F.ws + WS_RSTD0)};
        pg8::gemm_phase<pg8::EpiBf16S, pg8::Tile2D, false>(F.lds, 2048, 2048, 2048, S, E); inproj_tail_convert(F, a, 0); } SEAM(PH_INPROJ0);
    if (IN(PH_PRE0)) { phase_pre0(F, a); } SEAM(PH_PRE0);
    if (IN(PH_LOCAL0)) { for (int u = F.bx; u < 1536; u += F.G) { if (u < 512) ssd_local_unit(F, a, u); else ret_local_unit(F, a, u - 512); } } SEAM(PH_LOCAL0);
    if (IN(PH_SCAN0)) { phase_even_scan(F, a); } SEAM(PH_SCAN0);
    if (IN(PH_OUT0)) { for (int u = F.bx; u < 1280; u += F.G) { if (u < 256) ssd_out_unit(F, a, u); else ret_out_unit(F, a, u - 256); } } SEAM(PH_OUT0);
    if (IN(PH_OUTPROJ0)) { pg8::Tile2D S; S.init(MIX, F.ws + WS_WOUT0, T, 2048, 2048, 2048, F.G, F.bx); pg8::EpiResBf16<true> E{F.ws + WS_H, (bf16_t*)(F.ws + WS_H), 2048};
        pg8::gemm_phase<pg8::EpiResBf16<true>, pg8::Tile2D, false>(F.lds, 2048, 2048, 2048, S, E); } SEAM(PH_OUTPROJ0);
    if (IN(PH_ROUTER0)) { phase_router(F, a, 0); } SEAM(PH_ROUTER0);
    if (IN(PH_GATEUP0)) { phase_moe_gateup(F, a, 0); } SEAM(PH_GATEUP0);
    if (IN(PH_DOWN0)) { phase_moe_down(F, a, 0); } SEAM(PH_DOWN0);
    if (IN(PH_COMBINE0)) { phase_combine<false>(F, a, 0); __syncthreads(); moe_convert(F, a, 1, 0, MOE_CV_SPLIT, F.bx, F.G); } SEAM(PH_COMBINE0);
    if (IN(PH_INPROJ1)) { pg8::Tile2D S; S.init(F.ws + WS_H, F.ws + WS_WIN1, T, PLD, 2048, 2048, F.G, F.bx); pg8::EpiBf16S E{PROJ, PLD, (const float*)(F.ws + WS_RSTD1)};
        pg8::gemm_phase<pg8::EpiBf16S, pg8::Tile2D, false>(F.lds, 2048, 2048, 2048, S, E); inproj_tail_convert(F, a, 1); } SEAM(PH_INPROJ1);
    if (IN(PH_PRE1)) { phase_pre1(F, a); } SEAM(PH_PRE1);
    if (IN(PH_LOCAL1)) { TSTAMP(0); for (int u = F.bx; u < 768; u += F.G) { if (u < 256) { for (int r_ = 0; r_ < S5_REP; ++r_) s5_local_unit(F, a, u); } else { for (int r_ = 0; r_ < ML_REP; ++r_) mlstm_local_unit(F, a, u - 256); } TSTAMP(1 + (u >> 8)); } } SEAM(PH_LOCAL1);
    if (IN(PH_SCAN1)) { phase_odd_scan(F, a); } SEAM(PH_SCAN1);
    if (IN(PH_OUT1)) { TSTAMP(4); for (int u = F.bx; u < 768; u += F.G) { if (u < 256) { for (int r_ = 0; r_ < S5_REP; ++r_) s5_out_unit(F, a, u); } else { for (int r_ = 0; r_ < ML_REP; ++r_) mlstm_out_unit(F, a, u - 256); } TSTAMP(5 + (u >> 8)); } } SEAM(PH_OUT1);
    if (IN(PH_GLU)) { pg8::Tile2D S; S.init(F.ws + WS_Y5, F.ws + WS_WGLU, T, 1024, 512, 512, F.G, F.bx); pg8::EpiGlu E{MIX + 1536, 2048, a.in[I_S5_BGLU]};
        pg8::GluOrder GS{S};
        pg8::gemm_phase<pg8::EpiGlu, pg8::GluOrder, false>(F.lds, 512, 512, 512, GS, E); } SEAM(PH_GLU);
    if (IN(PH_OUTPROJ1)) { pg8::Tile2D S; S.init(MIX, F.ws + WS_WOUT1, T, 2048, 2048, 2048, F.G, F.bx); pg8::EpiResBf16<true> E{F.ws + WS_H, (bf16_t*)(F.ws + WS_H), 2048};
        pg8::gemm_phase<pg8::EpiResBf16<true>, pg8::Tile2D, false>(F.lds, 2048, 2048, 2048, S, E); } SEAM(PH_OUTPROJ1);
    if (IN(PH_ROUTER1)) { phase_router(F, a, 1); } SEAM(PH_ROUTER1);
    if (IN(PH_GATEUP1)) { phase_moe_gateup(F, a, 1); } SEAM(PH_GATEUP1);
    if (IN(PH_DOWN1)) { phase_moe_down(F, a, 1); } SEAM(PH_DOWN1);
    if (IN(PH_COMBINE1)) { phase_combine<true>(F, a, 1); }
#undef IN
#undef SEAM
}


#if DBG
constexpr size_t WS_DBG = WS_SMALL + 65536;
__device__ __forceinline__ void dbg_pub(float err, unsigned char* ws) {
    __shared__ unsigned red_;
    if (threadIdx.x == 0) red_ = 0u; __syncthreads();
    if (!(err >= 0.f)) err = __builtin_nanf("");
    atomicMax(&red_, __float_as_uint(err)); __syncthreads();
    if (threadIdx.x == 0) atomicMax((unsigned*)(ws + WS_DBG), red_);
    __syncthreads();
}
__device__ __forceinline__ float dbg_bsum(float v, float* sh) {
    __syncthreads(); sh[threadIdx.x] = v; __syncthreads();
    float t = 0.f; for (int i = 0; i < (int)blockDim.x; ++i) t += sh[i];
    __syncthreads(); return t;
}
__global__ void dbg_dump(float* out, const unsigned char* ws) {
    const size_t i = (size_t)blockIdx.x * blockDim.x + threadIdx.x; const size_t N = (size_t)T * D;
    if (i < N) { float v = 0.f; if (i == 0) { const float E = *(const float*)(ws + WS_DBG); float t = 10.f + log10f(fmaxf(E, 1e-12f)); t = fminf(fmaxf(t, 0.5f), 30.f); if (!(E == E)) t = 25.f; v = sqrtf((float)N * t); } out[i] = v; }
}
#define PRJ(row, col) bf2f(((const bf16_t*)(a.ws + WS_PROJ))[(size_t)(row) * PLD + (col)])
#define MIXV(row, col) bf2f(((const bf16_t*)(a.ws + WS_MIX))[(size_t)(row) * 2048 + (col)])
__device__ __forceinline__ float dbg_conv_(const bf16_t* prj, const float* cw, const float* cb, int C, size_t row, int pos, int col0, int ch) {
    float y = cb[ch];
    for (int tap = 0; tap < 4; ++tap) if (pos - 3 + tap >= 0) y += cw[tap * C + ch] * bf2f(prj[(size_t)(row - 3 + tap) * PLD + col0 + ch]);
    return y / (1.f + expf(-y));
}
#define dbg_conv(a, layer1, row, pos, col0, ch) dbg_conv_((const bf16_t*)((a).ws + WS_PROJ), (a).in[(layer1) ? I_ML_CONVW : I_SSD_CONVW], (a).in[(layer1) ? I_ML_CONVB : I_SSD_CONVB], (layer1) ? 3072 : 1536, row, pos, col0, ch)
__global__ void dbg_check_proj(Args a, int layer1) {
    const int tid = threadIdx.x + blockIdx.x * blockDim.x; const int NN = layer1 ? N1 : N0; const int row = (tid * 7919 + 13) % T, col = (tid * 104729 + 7) % NN;
    const float* x = (layer1 ? a.out : a.in[I_X]) + (size_t)row * D; const float* g = a.in[layer1 ? I_ODD_NORM : I_EVEN_NORM]; const float* W = a.in[layer1 ? I_ODD_WIN : I_EVEN_WIN];
    float ss = 0.f; for (int k = 0; k < D; ++k) ss += x[k] * x[k];
    const float rstd = rsqrtf(ss / D + EPS); float ref = 0.f;
    for (int k = 0; k < D; ++k) ref += x[k] * rstd * g[k] * W[(size_t)k * NN + col];
    dbg_pub(fabsf(PRJ(row, col) - ref) / (fabsf(ref) + 0.25f), a.ws);
}
__global__ void dbg_check_outproj(Args a, int layer1, const float* hprev) {
    const int tid = threadIdx.x + blockIdx.x * blockDim.x; const int row = (tid * 7919 + 13) % T, col = (tid * 104729 + 7) % D;
    const float* W = a.in[layer1 ? I_ODD_WOUT : I_EVEN_WOUT]; float ref = 0.f;
    for (int k = 0; k < 2048; ++k) ref += MIXV(row, k) * W[(size_t)k * D + col];
    const float r0 = hprev[(size_t)row * D + col];
    dbg_pub(fabsf(a.out[(size_t)row * D + col] - (r0 + ref)) / (fabsf(ref) + 0.25f), a.ws);
}
__global__ void dbg_check_ret(Args a) {
    __shared__ float qs[128], ks[128], sh[128];
    const int i = blockIdx.x, b = i & 3, h = (i >> 2) & 7, pos = (i * 977 + 131 + (i & 1) * 60) % SEQ, e = threadIdx.x; const size_t rb = (size_t)b * SEQ;
    const float lg = log1pf(-exp2f(-5.f - (float)h)); const int dd = e & 63; const float inv = 1.0f / powf(10000.f, (float)(2 * dd) / 128.f);
    { const float ang = (float)pos * inv, c = cosf(ang), sn = sinf(ang); const float t1 = PRJ(rb + pos, h * 128 + dd), t2 = PRJ(rb + pos, h * 128 + dd + 64); qs[e] = e < 64 ? t1 * c - t2 * sn : t1 * sn + t2 * c; }
    float o = 0.f;
    for (int s = 0; s <= pos; ++s) {
        __syncthreads();
        { const float ang = (float)s * inv, c = cosf(ang), sn = sinf(ang); const float t1 = PRJ(rb + s, P0_K + h * 128 + dd), t2 = PRJ(rb + s, P0_K + h * 128 + dd + 64); ks[e] = (e < 64 ? t1 * c - t2 * sn : t1 * sn + t2 * c) * 0.08838834764831845f; }
        __syncthreads();
        float sc = 0.f;
#pragma unroll 4
        for (int d = 0; d < 128; ++d) sc += qs[d] * ks[d];
        o += sc * expf(lg * (float)(pos - s)) * PRJ(rb + s, P0_V + h * 128 + e);
    }
    const float mean = dbg_bsum(o, sh) / 128.f; const float var = dbg_bsum((o - mean) * (o - mean), sh) / 128.f;
    const float gg = PRJ(rb + pos, P0_G + h * 128 + e);
    const float ref = (o - mean) * rsqrtf(var + EPS) * a.in[I_RET_NORM][h * 128 + e] * (gg / (1.f + expf(-gg)));
    dbg_pub(fabsf(MIXV(rb + pos, h * 128 + e) - ref) / (fabsf(ref) + 0.25f), a.ws);
}
__global__ void __launch_bounds__(512) dbg_check_ssd(Args a) {
    __shared__ float bms[128], cms[128], sh[512];
    const int i = blockIdx.x, b = i & 3, g = (i >> 2) & 1, pos = (i * 977 + 131 + (i & 1) * 60) % SEQ, ch = threadIdx.x, r = ch >> 6, hd = g * 8 + r; const size_t rb = (size_t)b * SEQ;
    const float A = -expf(a.in[I_SSD_ALOG][hd]), dtb = a.in[I_SSD_DTB][hd];
    float Apos = 0.f;
    for (int s = 0; s <= pos; ++s) { const float v = PRJ(rb + s, P0_DT + hd) + dtb; const float dt = v > 20.f ? v : log1pf(expf(v)); Apos += dt * A; }
    if (ch < 128) cms[ch] = dbg_conv(a, 0, rb + pos, pos, P0_XBC, 1280 + g * 128 + ch);
    float y = 0.f, As = 0.f;
    for (int s = 0; s <= pos; ++s) {
        __syncthreads();
        if (ch < 128) bms[ch] = dbg_conv(a, 0, rb + s, s, P0_XBC, 1024 + g * 128 + ch);
        __syncthreads();
        float cb = 0.f;
#pragma unroll 4
        for (int n = 0; n < 128; ++n) cb += cms[n] * bms[n];
        const float v = PRJ(rb + s, P0_DT + hd) + dtb; const float dt = v > 20.f ? v : log1pf(expf(v)); As += dt * A;
        y += cb * expf(Apos - As) * dbg_conv(a, 0, rb + s, s, P0_XBC, g * 512 + ch) * dt;
    }
    const float xs = dbg_conv(a, 0, rb + pos, pos, P0_XBC, g * 512 + ch), z = PRJ(rb + pos, P0_Z + g * 512 + ch);
    y = (y + a.in[I_SSD_D][hd] * xs) * (z / (1.f + expf(-z)));
    const float ms = dbg_bsum(y * y, sh) / 512.f;
    const float ref = y * rsqrtf(ms + EPS) * a.in[I_SSD_NORM][g * 512 + ch];
    dbg_pub(fabsf(MIXV(rb + pos, 1024 + g * 512 + ch) - ref) / (fabsf(ref) + 0.25f), a.ws);
}
__global__ void __launch_bounds__(384) dbg_check_mlstm(Args a) {
    __shared__ float qs[384], ks[384], sh[384];
    const int i = blockIdx.x, b = i & 3, h = (i >> 2) & 3, pos = (i * 977 + 131 + (i & 1) * 60) % SEQ, e = threadIdx.x; const size_t rb = (size_t)b * SEQ;
    const float fb = a.in[I_ML_FB][h], ib = a.in[I_ML_IB][h];
    float Fpos = 0.f; for (int s = 0; s <= pos; ++s) { const float f = PRJ(rb + s, P1_F + h) + fb; Fpos += -(-f > 20.f ? -f : log1pf(expf(-f))); }
    float m = -INFINITY, Fs = 0.f; for (int s = 0; s <= pos; ++s) { const float f = PRJ(rb + s, P1_F + h) + fb; Fs += -(-f > 20.f ? -f : log1pf(expf(-f))); m = fmaxf(m, Fpos - Fs + PRJ(rb + s, P1_I + h) + ib); }
    qs[e] = dbg_conv(a, 1, rb + pos, pos, 0, h * 384 + e) * 0.05103103630798288f;
    float N = 0.f, Dn = 0.f; Fs = 0.f;
    for (int s = 0; s <= pos; ++s) {
        __syncthreads();
        ks[e] = dbg_conv(a, 1, rb + s, s, 0, 1536 + h * 384 + e);
        __syncthreads();
        float qk = 0.f;
#pragma unroll 4
        for (int d = 0; d < 384; ++d) qk += qs[d] * ks[d];
        const float f = PRJ(rb + s, P1_F + h) + fb; Fs += -(-f > 20.f ? -f : log1pf(expf(-f)));
        const float w = expf(Fpos - Fs + PRJ(rb + s, P1_I + h) + ib - m);
        N += w * qk * PRJ(rb + s, P1_V + h * 384 + e); Dn += w * qk;
    }
    const float hv = N / fmaxf(fabsf(Dn), expf(-m));
    const float mean = dbg_bsum(hv, sh) / 384.f; const float var = dbg_bsum((hv - mean) * (hv - mean), sh) / 384.f;
    const float o = PRJ(rb + pos, P1_O + h * 384 + e);
    const float ref = (hv - mean) * rsqrtf(var + EPS) * a.in[I_ML_NORM][h * 384 + e] / (1.f + expf(-o));
    dbg_pub(fabsf(MIXV(rb + pos, h * 384 + e) - ref) / (fabsf(ref) + 0.25f), a.ws);
}
__global__ void dbg_check_s5(Args a) {
    __shared__ float yr[16][64];
    const int i = blockIdx.x, b = i & 3, g = (i >> 2) & 31, pos = (i * 977 + 131 + (i & 1) * 60) % SEQ, n = threadIdx.x; const size_t rb = (size_t)b * SEQ;
    const float dt = expf(a.in[I_S5_LOGDT][g]), are = a.in[I_S5_ARE][g * 64 + n], aim = a.in[I_S5_AIM][g * 64 + n];
    const float mag = expf(are * dt), abr = mag * cosf(aim * dt), abi = mag * sinf(aim * dt), den = are * are + aim * aim, nr = abr - 1.f;
    const float cr = (nr * are + abi * aim) / den, ci = (abi * are - nr * aim) / den;
    float bbr[16], bbi[16];
#pragma unroll
    for (int c = 0; c < 16; ++c) { const float br = a.in[I_S5_BRE][(size_t)(g * 64 + n) * 16 + c], bi = a.in[I_S5_BIM][(size_t)(g * 64 + n) * 16 + c]; bbr[c] = cr * br - ci * bi; bbi[c] = cr * bi + ci * br; }
    float sr = 0.f, si = 0.f;
    for (int t = 0; t <= pos; ++t) { float ur = 0.f, ui = 0.f;
#pragma unroll
        for (int c = 0; c < 16; ++c) { const float u = PRJ(rb + t, P1_U + g * 16 + c); ur += bbr[c] * u; ui += bbi[c] * u; }
        const float nr2 = abr * sr - abi * si + ur, ni2 = abr * si + abi * sr + ui; sr = nr2; si = ni2; }
    for (int c = 0; c < 16; ++c) yr[c][n] = a.in[I_S5_CRE][(size_t)(g * 16 + c) * 64 + n] * sr - a.in[I_S5_CIM][(size_t)(g * 16 + c) * 64 + n] * si;
    __syncthreads();
    float err = 0.f;
    if (n < 16) { float y = 0.f; for (int k = 0; k < 64; ++k) y += yr[n][k]; y += a.in[I_S5_D][g * 16 + n] * PRJ(rb + pos, P1_U + g * 16 + n);
        const float u = 0.7978845608f * (y + 0.044715f * y * y * y); const float ref = 0.5f * y * (1.f + tanhf(u));
        const float got = bf2f(((const bf16_t*)(a.ws + WS_Y5))[(rb + pos) * 512 + g * 16 + n]); err = fabsf(got - ref) / (fabsf(ref) + 0.25f); }
    dbg_pub(err, a.ws);
}
__global__ void dbg_check_glu(Args a) {
    const int tid = threadIdx.x + blockIdx.x * blockDim.x; const int row = (tid * 7919 + 13) % T, col = (tid * 104729 + 7) % 512;
    float v = a.in[I_S5_BGLU][col], gt = a.in[I_S5_BGLU][512 + col];
    for (int k = 0; k < 512; ++k) { const float y = bf2f(((const bf16_t*)(a.ws + WS_Y5))[(size_t)row * 512 + k]); v += y * a.in[I_S5_WGLU][(size_t)k * 1024 + col]; gt += y * a.in[I_S5_WGLU][(size_t)k * 1024 + 512 + col]; }
    const float ref = v / (1.f + expf(-gt));
    dbg_pub(fabsf(MIXV(row, 1536 + col) - ref) / (fabsf(ref) + 0.25f), a.ws);
}
__global__ void dbg_check_router(Args a, int layer) {
    const int tid = threadIdx.x + blockIdx.x * blockDim.x; const int tok = (tid * 7919 + 13) % T; const float* x = a.out + (size_t)tok * D;
    float ss = 0.f; for (int k = 0; k < D; ++k) ss += x[k] * x[k];
    const float rstd = rsqrtf(ss / D + EPS); float gmax = -INFINITY, gsec = -INFINITY; int gi = 0; float se = 0.f;
    for (int j = 0; j < 4; ++j) { float l = 0.f; for (int k = 0; k < D; ++k) l += x[k] * rstd * a.in[I_MOE_NORM][layer * D + k] * a.in[I_MOE_RG][(size_t)(layer * D + k) * 4 + j]; l += a.in[I_MOE_RGB][layer * 4 + j];
        if (l > gmax) { se = se * expf(gmax - l) + 1.f; gsec = gmax; gmax = l; gi = j; } else { se += expf(l - gmax); gsec = fmaxf(gsec, l); } }
    float v1 = -INFINITY, v2 = -INFINITY, v3 = -INFINITY; int i1 = 0, i2 = 0;
    for (int j = 0; j < 8; ++j) { float l = 0.f; for (int k = 0; k < D; ++k) l += x[k] * rstd * a.in[I_MOE_NORM][layer * D + k] * a.in[I_MOE_RE][(size_t)(layer * D + k) * 32 + gi * 8 + j]; l += a.in[I_MOE_REB][layer * 32 + gi * 8 + j];
        if (l > v1) { v3 = v2; v2 = v1; i2 = i1; v1 = l; i1 = j; } else if (l > v2) { v3 = v2; v2 = l; i2 = j; } else v3 = fmaxf(v3, l); }
    const float e2 = expf(v2 - v1), w1 = (1.f / se) / (1.f + e2), w2 = (1.f / se) * e2 / (1.f + e2);
    const int* sp = (const int*)(a.ws + WS_SLOT) + (size_t)tok * 8;
    float err = 0.f;
    if (sp[0] != gi * 8 + i1 || sp[3] != gi * 8 + i2) err += (v2 - v3 > 1e-3f && v1 - v2 > 1e-3f && gmax - gsec > 1e-3f) ? 1.f : 0.f;
    else err = fabsf(__int_as_float(sp[2]) - w1) + fabsf(__int_as_float(sp[5]) - w2);
    const unsigned* cnt = (const unsigned*)(a.ws + WS_CTL) + CW_CNT + layer * 32 * 64; unsigned tot = 0; for (int e = 0; e < 32; ++e) tot += cnt[e * 64];
    if (tot != 2u * T) err += 2.f;
    if (sp[1] < 0 || sp[1] >= (int)cnt[sp[0] * 64] || ((const int*)(a.ws + WS_LIST))[sp[0] * T + sp[1]] != tok) err += 4.f;
    dbg_pub(err, a.ws);
}
__device__ __forceinline__ bool dbg_bad(float v) { return !(v - v == 0.f); }
__global__ void dbg_scan_odd(Args a) {
    const size_t gt = (size_t)blockIdx.x * blockDim.x + threadIdx.x, NT_ = (size_t)gridDim.x * blockDim.x; unsigned fl = 0u;
    const float* MS = (const float*)(a.ws + WS_SMALL + 16384); const float* MST = (const float*)(a.ws + WS_SMALL + 32768);
    for (size_t i = gt; i < 1024; i += NT_) if (dbg_bad(MS[i])) fl |= 1u;
    for (size_t i = gt; i < 512; i += NT_) { const float v = MST[i]; if ((i & 31) == 0 ? !(v == -INFINITY) : dbg_bad(v)) fl |= 2u; }
    const bf16_t* MC = (const bf16_t*)(a.ws + WS_MC); for (size_t i = gt; i < (size_t)16 * 32 * 147456; i += NT_) if (dbg_bad(bf2f(MC[i]))) fl |= 4u;
    const float* MN = (const float*)(a.ws + WS_MN); for (size_t i = gt; i < (size_t)16 * 32 * 384; i += NT_) if (dbg_bad(MN[i])) fl |= 8u;
    const bf16_t* MX = (const bf16_t*)(a.ws + WS_MIX); for (size_t i = gt; i < (size_t)T * 1536; i += NT_) if (dbg_bad(bf2f(MX[(i / 1536) * 2048 + (i % 1536)]))) fl |= 16u;
    const bf16_t* PJ = (const bf16_t*)(a.ws + WS_PROJ); for (size_t i = gt; i < (size_t)T * N1; i += NT_) if (dbg_bad(bf2f(PJ[(i / N1) * PLD + (i % N1)]))) fl |= 32u;
    if (fl) atomicOr((unsigned*)(a.ws + WS_DBG + 4), fl);
}
__global__ void dbg_count_mc(Args a) {
    const size_t gt = (size_t)blockIdx.x * blockDim.x + threadIdx.x, NT_ = (size_t)gridDim.x * blockDim.x; unsigned n = 0;
    const bf16_t* MC = (const bf16_t*)(a.ws + WS_MC); for (size_t i = gt; i < (size_t)16 * 32 * 147456; i += NT_) if (dbg_bad(bf2f(MC[i]))) ++n;
    if (n) atomicAdd((unsigned*)(a.ws + WS_DBG + 4), n);
}
__global__ void dbg_count_fin(Args a) { const unsigned n = *(const unsigned*)(a.ws + WS_DBG + 4); *(float*)(a.ws + WS_DBG) = exp10f(log10f((float)n + 1.f) - 9.f); }
__global__ void dbg_ts_fin(Args a) { const unsigned long long* ts = (const unsigned long long*)(a.ws + WS_TS); const float us = (float)(ts[TS_SEL + 1] - ts[TS_SEL]) * 0.01f; *(float*)(a.ws + WS_DBG) = exp10f(us / TS_SCALE - 10.f); }
__global__ void dbg_scan_fin(Args a) { const unsigned fl = *(const unsigned*)(a.ws + WS_DBG + 4); *(float*)(a.ws + WS_DBG) = exp10f(0.1f * (float)fl - 9.f); }
__global__ void __launch_bounds__(512) dbg_check_moe(Args a, int layer) {
    __shared__ float xs[2048], hid[512]; __shared__ int ts[33];
    const int i = blockIdx.x, tok = (i * 7919 + 13) % T, slot = i & 1, f = threadIdx.x;
    const int* sp = (const int*)(a.ws + WS_SLOT) + (size_t)tok * 8; const int e = sp[slot * 3], r = sp[slot * 3 + 1];
    if (f == 0) { const unsigned* cnt = (const unsigned*)(a.ws + WS_CTL) + CW_CNT + layer * 32 * 64; int acc = 0; for (int q = 0; q < 32; ++q) { ts[q] = acc; acc += ((int)cnt[q * 64] + 255) >> 8; } }
    for (int k = f; k < 2048; k += 512) xs[k] = bf2f(((const bf16_t*)(a.ws + WS_XN))[(size_t)tok * D + k]) * ((const float*)(a.ws + WS_RSTD))[tok];
    __syncthreads();
    const float* wg = a.in[I_MOE_WG] + (size_t)(layer * 32 + e) * 2048 * 512; const float* wu = a.in[I_MOE_WU] + (size_t)(layer * 32 + e) * 2048 * 512; const float* wd = a.in[I_MOE_WD] + (size_t)(layer * 32 + e) * 512 * 2048;
    float gg = 0.f, uu = 0.f; for (int k = 0; k < 2048; ++k) { gg += xs[k] * wg[(size_t)k * 512 + f]; uu += xs[k] * wu[(size_t)k * 512 + f]; }
    hid[f] = gg / (1.f + expf(-gg)) * uu;
    __syncthreads();
    const int col = (f * 37 + 5) % D; float ref = 0.f; for (int k = 0; k < 512; ++k) ref += hid[k] * wd[(size_t)k * D + col];
    const float got = bf2f(((const bf16_t*)(a.ws + WS_Y))[(size_t)(ts[e] * 256 + r) * D + col]);
    dbg_pub(fabsf(got - ref) / (fabsf(ref) + 0.25f), a.ws);
}
#endif

extern "C" void kernel_launch(void* const* d_in, const int* in_sizes, int n_in, void* d_out, int out_size, void* d_ws, size_t ws_size, hipStream_t stream) {
    static int grid = 0;
    if (grid == 0) {
        if (n_in != 38 || out_size != T * D || ws_size < WS_END) { fprintf(stderr, "kernel_launch: unexpected problem (n_in %d, out %d, ws %zu)\n", n_in, out_size, ws_size); grid = -1; return; }
        int dev = 0, cus = 0, per_cu = 0;
        if (hipGetDevice(&dev) != hipSuccess || hipDeviceGetAttribute(&cus, hipDeviceAttributeMultiprocessorCount, dev) != hipSuccess) { grid = -1; return; }
        if (hipFuncSetAttribute((const void*)fwd, hipFuncAttributeMaxDynamicSharedMemorySize, LDS_BYTES) != hipSuccess) { fprintf(stderr, "kernel_launch: hipFuncSetAttribute failed\n"); grid = -1; return; }
        if (hipOccupancyMaxActiveBlocksPerMultiprocessor(&per_cu, (const void*)fwd, 512, LDS_BYTES) != hipSuccess || per_cu < 1) fprintf(stderr, "kernel_launch: occupancy query reports %d\n", per_cu);
        (void)hipGetLastError();
        grid = cus;
    }
    if (grid < 0) return;
    (void)hipMemsetAsync((char*)d_ws + WS_CTL, 0, CTL_BYTES, stream);
    Args a{};
    for (int i = 0; i < 38; ++i) a.in[i] = (const float*)d_in[i];
    a.out = (float*)d_out; a.ws = (unsigned char*)d_ws;
#if DBG
    constexpr int dbg_last = (DBG == 1) ? PH_INPROJ0 : (DBG == 2 || DBG == 3) ? PH_OUT0 : (DBG == 4) ? PH_OUTPROJ0 : (DBG == 5) ? PH_ROUTER0 : (DBG == 6 || DBG == 20) ? PH_DOWN0 : (DBG == 7) ? PH_INPROJ1 : (DBG == 8 || DBG == 9 || DBG == 30) ? PH_OUT1 : (DBG == 10) ? PH_GLU : (DBG == 11) ? PH_OUTPROJ1 : (DBG == 12) ? PH_ROUTER1 : (DBG == 40) ? PH_OUT1 : PH_DOWN1;
    (void)hipMemsetAsync((char*)d_ws + WS_DBG, 0, 8, stream);
    float* hsave = (float*)((char*)d_ws + WS_PROJ);
#define DBG_ON(k) (DBG == (k) || (DBG == 20 && (k) <= 6) || (DBG == 21 && (k) >= 7))
    for (int p = 0; p <= dbg_last; ++p) {
        if (p == PH_OUTPROJ1 && DBG_ON(11)) (void)hipMemcpyAsync(hsave, d_out, (size_t)T * D * 4, hipMemcpyDeviceToDevice, stream);
        a.ph_lo = p; a.ph_hi = p + 1; hipLaunchKernelGGL(fwd, dim3(grid), dim3(512), LDS_BYTES, stream, a);
        a.ph_lo = 0; a.ph_hi = 0;
        if (p == PH_INPROJ0 && DBG_ON(1)) hipLaunchKernelGGL(dbg_check_proj, dim3(4), dim3(256), 0, stream, a, 0);
        if (p == PH_OUT0 && DBG_ON(2)) hipLaunchKernelGGL(dbg_check_ret, dim3(32), dim3(128), 0, stream, a);
        if (p == PH_OUT0 && DBG_ON(3)) hipLaunchKernelGGL(dbg_check_ssd, dim3(16), dim3(512), 0, stream, a);
        if (p == PH_OUTPROJ0 && DBG_ON(4)) hipLaunchKernelGGL(dbg_check_outproj, dim3(4), dim3(256), 0, stream, a, 0, (const float*)d_in[0]);
        if (p == PH_ROUTER0 && DBG_ON(5)) hipLaunchKernelGGL(dbg_check_router, dim3(4), dim3(128), 0, stream, a, 0);
        if (p == PH_DOWN0 && DBG_ON(6)) hipLaunchKernelGGL(dbg_check_moe, dim3(32), dim3(512), 0, stream, a, 0);
        if (p == PH_INPROJ1 && DBG_ON(7)) hipLaunchKernelGGL(dbg_check_proj, dim3(4), dim3(256), 0, stream, a, 1);
        if (p == PH_OUT1 && DBG_ON(8)) hipLaunchKernelGGL(dbg_check_mlstm, dim3(16), dim3(384), 0, stream, a);
        if (p == PH_OUT1 && DBG_ON(9)) hipLaunchKernelGGL(dbg_check_s5, dim3(64), dim3(64), 0, stream, a);
        if (p == PH_OUT1 && DBG == 30) { hipLaunchKernelGGL(dbg_scan_odd, dim3(1024), dim3(256), 0, stream, a); hipLaunchKernelGGL(dbg_scan_fin, dim3(1), dim3(1), 0, stream, a); }
        if (p == PH_OUT1 && DBG == 40) hipLaunchKernelGGL(dbg_ts_fin, dim3(1), dim3(1), 0, stream, a);
        if (p == PH_GLU && DBG_ON(10)) hipLaunchKernelGGL(dbg_check_glu, dim3(4), dim3(256), 0, stream, a);
        if (p == PH_OUTPROJ1 && DBG_ON(11)) hipLaunchKernelGGL(dbg_check_outproj, dim3(4), dim3(256), 0, stream, a, 1, (const float*)hsave);
        if (p == PH_ROUTER1 && DBG_ON(12)) hipLaunchKernelGGL(dbg_check_router, dim3(4), dim3(128), 0, stream, a, 1);
        if (p == PH_DOWN1 && DBG_ON(13)) hipLaunchKernelGGL(dbg_check_moe, dim3(32), dim3(512), 0, stream, a, 1);
    }
    hipLaunchKernelGGL(dbg_dump, dim3((T * D + 255) / 256), dim3(256), 0, stream, (float*)d_out, (const unsigned char*)d_ws);
#elif MK_SINGLE
    a.ph_lo = 0; a.ph_hi = NPHASE;
    hipLaunchKernelGGL(fwd, dim3(grid), dim3(512), LDS_BYTES, stream, a);
#else
    for (int p = 0; p < NPHASE; ++p) { a.ph_lo = p; a.ph_hi = p + 1;
        const int reps = 1 + (((REP_MASK >> p) & 1) ? REP_N : 0);
        for (int r = 0; r < reps; ++r) { if (r > 0 && (p == PH_ROUTER0 || p == PH_ROUTER1)) (void)hipMemsetAsync((char*)d_ws + WS_CTL + (size_t)CW_CNT * 4, 0, 2 * 32 * 64 * 4, stream);
            hipLaunchKernelGGL(fwd, dim3(grid), dim3(512), LDS_BYTES, stream, a); } }
#endif
}
```
